# Optimizing an MI355X kernel written in HIP

```python
import jax, jax.numpy as jnp
from jax import lax
import numpy as np

D_MODEL = 1024
BATCH = 16
SEQ = 2048
DEPTH = 2

CHUNK = 64
EPS = 1e-6

A_HEADS = 8
A_WIDTH = D_MODEL // 2
A_HEAD_DIM = A_WIDTH // A_HEADS
A_LEFT_CHUNKS = 8
A_BAND = (A_LEFT_CHUNKS + 1) * CHUNK
REL_CLIP = 2 * CHUNK

B_HEADS = 4
B_V_WIDTH = D_MODEL // 2
B_QK_WIDTH = B_V_WIDTH // 2
B_KEY_DIM = B_QK_WIDTH // B_HEADS
B_VAL_DIM = B_V_WIDTH // B_HEADS
B_GATE_RANK = 16
B_GATE_TEMP = 16.0

N_BRANCH = 2
IN_SPLIT = (A_WIDTH, A_WIDTH, A_WIDTH,
            B_QK_WIDTH, B_QK_WIDTH, B_V_WIDTH,
            B_V_WIDTH, B_GATE_RANK,
            N_BRANCH * D_MODEL)
IN_COLS = sum(IN_SPLIT)
SPLIT_POINTS = tuple(sum(IN_SPLIT[:i + 1]) for i in range(len(IN_SPLIT) - 1))

N_GROUPS = 4
EXPERTS_PER_GROUP = 8
N_EXPERTS = N_GROUPS * EXPERTS_PER_GROUP
TOP_K = 2
D_EXPERT = D_MODEL // 4

kernel_name = "hybrid_chunkattn_gla_hiermoe"


def rms_norm(x, gain):
    xf = x.astype(jnp.float32)
    y = xf * lax.rsqrt(jnp.mean(xf * xf, axis=-1, keepdims=True) + EPS)
    return (y * gain.astype(jnp.float32)).astype(x.dtype)


def chunk_band_attention(q, k, v, q_gain, k_gain, rel_bias):
    b_, s_, h_, dh = q.shape
    nc = s_ // CHUNK
    pad = A_LEFT_CHUNKS * CHUNK
    q = rms_norm(q, q_gain) * (dh ** -0.5)
    k = rms_norm(k, k_gain)
    k_pad = jnp.pad(k, ((0, 0), (pad, 0), (0, 0), (0, 0)))
    v_pad = jnp.pad(v, ((0, 0), (pad, 0), (0, 0), (0, 0)))
    q_pos = jnp.arange(CHUNK)[:, None] + pad
    k_pos = jnp.arange(A_BAND)[None, :]
    rel = jnp.clip(q_pos - k_pos, -REL_CLIP, REL_CLIP) + REL_CLIP
    bias = jnp.transpose(rel_bias[rel], (2, 0, 1)).astype(jnp.float32)
    q_chunks = jnp.transpose(q.reshape(b_, nc, CHUNK, h_, dh), (1, 0, 2, 3, 4))

    def one_chunk(args):
        c, q_c = args
        start = c * CHUNK
        k_band = lax.dynamic_slice_in_dim(k_pad, start, A_BAND, axis=1)
        v_band = lax.dynamic_slice_in_dim(v_pad, start, A_BAND, axis=1)
        s = jnp.einsum('bqhd,bkhd->bhqk', q_c, k_band).astype(jnp.float32) + bias
        valid = (start + jnp.arange(A_BAND)) >= pad
        s = jnp.where(valid[None, None, None, :], s, -jnp.inf)
        p = jax.nn.softmax(s, axis=-1).astype(v.dtype)
        return jnp.einsum('bhqk,bkhd->bqhd', p, v_band)

    out = lax.map(one_chunk, (jnp.arange(nc), q_chunks))
    return jnp.transpose(out, (1, 0, 2, 3, 4)).reshape(b_, s_, h_ * dh)


def gla_chunked(q, k, v, log_a):
    b_, s_, h_, dk = q.shape
    dv = v.shape[-1]
    nc = s_ // CHUNK
    out_dtype = v.dtype

    def to_chunks(t):
        t = t.astype(jnp.float32).reshape(b_, nc, CHUNK, h_, t.shape[-1])
        return jnp.transpose(t, (1, 0, 3, 2, 4))

    qc = to_chunks(q) * (dk ** -0.5)
    kc, vc, gc = to_chunks(k), to_chunks(v), to_chunks(log_a)
    causal = jnp.tril(jnp.ones((CHUNK, CHUNK), dtype=bool))

    def step(state, inp):
        q_c, k_c, v_c, g_c = inp
        b = jnp.cumsum(g_c, axis=2)
        o_inter = jnp.einsum('bhck,bhkv->bhcv', q_c * jnp.exp(b), state)
        diff = b[:, :, :, None, :] - b[:, :, None, :, :]
        decay = jnp.exp(jnp.where(causal[:, :, None], diff, -jnp.inf))
        attn = jnp.einsum('bhik,bhjk,bhijk->bhij', q_c, k_c, decay)
        o_intra = jnp.einsum('bhij,bhjv->bhiv', attn, v_c)
        b_last = b[:, :, -1:, :]
        new_state = (jnp.exp(b_last[:, :, 0, :])[..., None] * state
                     + jnp.einsum('bhck,bhcv->bhkv', k_c * jnp.exp(b_last - b), v_c))
        return new_state, o_inter + o_intra

    state0 = jnp.zeros((b_, h_, dk, dv), jnp.float32)
    _, o = lax.scan(step, state0, (qc, kc, vc, gc))
    o = jnp.transpose(o, (1, 0, 3, 2, 4)).reshape(b_, s_, h_, dv)
    return o.astype(out_dtype)


def hier_moe(h, w_group, b_group, w_router, b_router, w_gate, w_up, w_down):
    shape = h.shape
    hf = h.reshape(-1, shape[-1])
    t_ = hf.shape[0]
    g_prob = jax.nn.softmax((hf @ w_group).astype(jnp.float32) + b_group, axis=-1)
    g_top, g_idx = lax.top_k(g_prob, 1)
    e_logits = ((hf @ w_router).astype(jnp.float32) + b_router).reshape(t_, N_GROUPS, EXPERTS_PER_GROUP)
    e_in_group = jnp.take_along_axis(e_logits, g_idx[:, :, None], axis=1)[:, 0]
    e_top, e_idx = lax.top_k(e_in_group, TOP_K)
    e_w = jax.nn.softmax(e_top, axis=-1) * g_top
    expert_id = g_idx * EXPERTS_PER_GROUP + e_idx
    gates = jnp.sum(jax.nn.one_hot(expert_id, N_EXPERTS, dtype=jnp.float32) * e_w[..., None], axis=1)
    gates = gates.astype(h.dtype)
    y = jnp.zeros_like(hf)
    for e in range(N_EXPERTS):
        a = jax.nn.silu(hf @ w_gate[e]) * (hf @ w_up[e])
        y = y + gates[:, e:e + 1] * (a @ w_down[e])
    return y.reshape(shape)


def setup_inputs(seed: int = 0) -> dict:
    key = jax.random.key(seed)
    ks = jax.random.split(key, 20)
    f32 = jnp.float32

    def nrm(k, shape, scale):
        return jax.random.normal(k, shape, f32) * scale

    return {
        "x": nrm(ks[0], (BATCH, SEQ, D_MODEL), 1.0),
        "norm_mix_gain": 1.0 + nrm(ks[1], (DEPTH, D_MODEL), 0.02),
        "w_in": nrm(ks[2], (DEPTH, D_MODEL, IN_COLS), D_MODEL ** -0.5),
        "a_q_gain": 1.0 + nrm(ks[3], (DEPTH, A_HEADS, A_HEAD_DIM), 0.02),
        "a_k_gain": 1.0 + nrm(ks[4], (DEPTH, A_HEADS, A_HEAD_DIM), 0.02),
        "rel_bias": nrm(ks[5], (2 * REL_CLIP + 1, A_HEADS), 0.2),
        "b_gate_up": nrm(ks[6], (DEPTH, B_GATE_RANK, B_QK_WIDTH), B_GATE_RANK ** -0.5),
        "b_gate_bias": nrm(ks[7], (DEPTH, B_QK_WIDTH), 0.1),
        "b_out_gain": 1.0 + nrm(ks[8], (DEPTH, B_HEADS, B_VAL_DIM), 0.02),
        "proj_a": nrm(ks[9], (DEPTH, A_WIDTH, D_MODEL), A_WIDTH ** -0.5),
        "proj_b": nrm(ks[10], (DEPTH, B_V_WIDTH, D_MODEL), B_V_WIDTH ** -0.5),
        "w_out": nrm(ks[11], (DEPTH, D_MODEL, D_MODEL), D_MODEL ** -0.5),
        "norm_ffn_gain": 1.0 + nrm(ks[12], (DEPTH, D_MODEL), 0.02),
        "w_group": nrm(ks[13], (DEPTH, D_MODEL, N_GROUPS), D_MODEL ** -0.5),
        "b_group": nrm(ks[14], (DEPTH, N_GROUPS), 0.01),
        "w_router": nrm(ks[15], (DEPTH, D_MODEL, N_EXPERTS), D_MODEL ** -0.5),
        "b_router": nrm(ks[16], (DEPTH, N_EXPERTS), 0.01),
        "w_gate": nrm(ks[17], (DEPTH, N_EXPERTS, D_MODEL, D_EXPERT), D_MODEL ** -0.5),
        "w_up": nrm(ks[18], (DEPTH, N_EXPERTS, D_MODEL, D_EXPERT), D_MODEL ** -0.5),
        "w_down": nrm(ks[19], (DEPTH, N_EXPERTS, D_EXPERT, D_MODEL), D_EXPERT ** -0.5),
    }


def reference(x, norm_mix_gain, w_in, a_q_gain, a_k_gain, rel_bias, b_gate_up, b_gate_bias,
              b_out_gain, proj_a, proj_b, w_out, norm_ffn_gain, w_group, b_group, w_router,
              b_router, w_gate, w_up, w_down):
    b_, s_, _ = x.shape
    for l in range(DEPTH):
        h = rms_norm(x, norm_mix_gain[l])
        u = h @ w_in[l]
        a_q, a_k, a_v, b_q, b_k, b_v, b_r, b_lr, gate_cols = jnp.split(u, SPLIT_POINTS, axis=-1)

        y_a = chunk_band_attention(a_q.reshape(b_, s_, A_HEADS, A_HEAD_DIM),
                                   a_k.reshape(b_, s_, A_HEADS, A_HEAD_DIM),
                                   a_v.reshape(b_, s_, A_HEADS, A_HEAD_DIM),
                                   a_q_gain[l], a_k_gain[l], rel_bias)

        log_a = jax.nn.log_sigmoid((b_lr @ b_gate_up[l]).astype(jnp.float32)
                                   + b_gate_bias[l].astype(jnp.float32)) / B_GATE_TEMP
        o_b = gla_chunked(b_q.reshape(b_, s_, B_HEADS, B_KEY_DIM),
                          b_k.reshape(b_, s_, B_HEADS, B_KEY_DIM),
                          b_v.reshape(b_, s_, B_HEADS, B_VAL_DIM),
                          log_a.reshape(b_, s_, B_HEADS, B_KEY_DIM))
        y_b = rms_norm(o_b, b_out_gain[l]).reshape(b_, s_, B_V_WIDTH) * jax.nn.silu(b_r)

        g_a, g_b = jnp.split(jax.nn.sigmoid(gate_cols), N_BRANCH, axis=-1)
        merged = g_a * (y_a @ proj_a[l]) + g_b * (y_b @ proj_b[l])
        x = x + merged @ w_out[l]

        h = rms_norm(x, norm_ffn_gain[l])
        x = x + hier_moe(h, w_group[l], b_group[l], w_router[l], b_router[l],
                         w_gate[l], w_up[l], w_down[l])
    return x
```

```cpp
#include <hip/hip_runtime.h>
#include <cstdio>
#include <cstdint>

#ifndef MK_ONE_LAUNCH
#define MK_ONE_LAUNCH 0
#endif

#define LAS __attribute__((address_space(3)))
#define GAS __attribute__((address_space(1)))
typedef unsigned short bf16;
typedef short bf16x8 __attribute__((ext_vector_type(8)));
typedef float f32x4 __attribute__((ext_vector_type(4)));
typedef float f32x2 __attribute__((ext_vector_type(2)));
typedef unsigned u32x4 __attribute__((ext_vector_type(4)));
typedef unsigned u32x2 __attribute__((ext_vector_type(2)));

constexpr int T = 32768, D = 1024, SEQ = 2048, DEPTH = 2;
constexpr int IN_COLS = 5136, NIN = 5376;
constexpr int NE = 32, DE = 256;
constexpr int MAXTILES = 288;
constexpr float EPS = 1e-6f, LOG2E = 1.4426950408889634f;

namespace pg8 {
constexpr int BM = 256, BK = 64, HALF = 128, HTB = HALF * BK * 2  , STAGE_BYTES = 8 * HTB, NXCD = 8, WGM = 8;
__host__ __device__ __forceinline__ int lds_byte(int r, int c) { const int st = (r >> 4) * 2 + (c >> 5), rr = r & 15, cc = c & 31, ob = rr * 64 + cc * 2; return st * 1024 + (ob ^ (((ob >> 9) & 1) << 5)); }
__host__ __device__ __forceinline__ void stage_rc(int b, int& R, int& C) { const int st = b / 1024, sb = b % 1024, swz = sb ^ (((sb >> 9) & 1) << 5); R = (st >> 1) * 16 + swz / 64; C = (st & 1) * 32 + (swz % 64) / 2; }
__host__ __device__ __forceinline__ int perm32(int rho) { const int n = rho >> 4, i = rho & 15; return 8 * (i >> 2) + 4 * n + (i & 3); }

struct Unit { int pm, pn; const char* A; const char* B; };

struct DenseOrder {
    int nM, nN, nwg, G, c; const char* A; const char* Bt; size_t tstep;
    __device__ void init(int M, int N, int K, int G_, int c_, const void* A_, const void* Bt_) { nM = M / BM; nN = N / BM; nwg = nM * nN; G = G_; c = c_; A = (const char*)A_; Bt = (const char*)Bt_; tstep = (size_t)BM * K * 2; }
    __device__ bool next(int i, Unit& u) const {
        const long L = (long)i * G + c; if (L >= nwg) return false;
        int wgid = (int)L; { const int q = nwg / NXCD, r = nwg % NXCD, xcd = wgid % NXCD, off = wgid / NXCD; wgid = (xcd < r ? xcd * (q + 1) : r * (q + 1) + (xcd - r) * q) + off; }
        const int nig = WGM * nN, gid = wgid / nig, fm = gid * WGM, gsz = (nM - fm) < WGM ? (nM - fm) : WGM;
        u.pm = fm + ((wgid % nig) % gsz); u.pn = (wgid % nig) / gsz; u.A = A + (size_t)u.pm * tstep; u.B = Bt + (size_t)u.pn * tstep; return true;
    }
    __device__ __forceinline__ void a_ready(const Unit&) const {}
    __device__ __forceinline__ void done(const Unit&) const {}
};
struct ExpertOrder {
    const LAS int* tile_e; int ntiles, NPN, G, c; const char* A; const char* B; size_t a_tile, b_exp, b_pn;
    __device__ bool next(int i, Unit& u) const {
        const long L = (long)i * G + c; if (L >= (long)ntiles * NPN) return false;
        const int tile = (int)(L / NPN), pn = (int)(L % NPN); const int e = __builtin_amdgcn_readfirstlane(tile_e[tile]);
        u.pm = tile; u.pn = pn; u.A = A + (size_t)tile * a_tile; u.B = B + (size_t)e * b_exp + (size_t)pn * b_pn; return true;
    }
    __device__ __forceinline__ void a_ready(const Unit&) const {}
    __device__ __forceinline__ void done(const Unit&) const {}
};

__device__ __forceinline__ unsigned cvt_pk_bf16(float lo, float hi) { unsigned r; asm volatile("v_cvt_pk_bf16_f32 %0, %1, %2" : "=v"(r) : "v"(lo), "v"(hi)); return r; }

template <class Epi, class Sched, bool ALIGN_EPI = false, bool SP2 = false>
__device__ __forceinline__ void gemm_phase(LAS unsigned char* lds, const int K, const Sched& S, const Epi& E, int tid_) {
    asm volatile("" : "+v"(tid_));
    const int tid = tid_, wid = __builtin_amdgcn_readfirstlane(tid >> 6), lane = tid & 63, wr = wid >> 2, wc = wid & 3, fr = lane & 15, fq = lane >> 4;
    const int nt = K / BK;
    unsigned voffA[2], voffB[2];
#pragma unroll
    for (int i = 0; i < 2; ++i) { int R, C; stage_rc(tid * 16 + i * 8192, R, C); const int Rb = Epi::PERM ? ((R & ~31) + perm32(R & 31)) : R;
        voffA[i] = (unsigned)(R * K + C) * 2u; voffB[i] = (unsigned)(Rb * K + C) * 2u; }
    const size_t kstep = (size_t)(BK * 2);
    const size_t hstep = (size_t)HALF * K * 2;
    const unsigned ldsw = (unsigned)wid * 1024u;
    const int aoff = lds_byte(wr * 64 + fr, fq * 8), boff = lds_byte(wc * 32 + fr, fq * 8);
#define PG8_SA(b, h) (((b) * 2 + (h)) * HTB)
#define PG8_SB(b, h) ((4 + (b) * 2 + (h)) * HTB)
#define PG8_STAGE(bufoff, gbase, voff) do { _Pragma("unroll") for (int _i = 0; _i < 2; ++_i) \
        __builtin_amdgcn_global_load_lds((const unsigned*)((const char*)(gbase) + (voff)[_i]), (LAS unsigned*)(lds + (bufoff) + ldsw + _i * 8192), 16, 0, 0); } while (0)
#define PG8_LDA(dst, b, h) do { _Pragma("unroll") for (int m = 0; m < 4; ++m) _Pragma("unroll") for (int k = 0; k < 2; ++k) dst[m][k] = *(const LAS bf16x8*)(lds + PG8_SA(b, h) + aoff + m * 2048 + k * 1024); } while (0)
#define PG8_LDB(dst, b, h) do { _Pragma("unroll") for (int n = 0; n < 2; ++n) _Pragma("unroll") for (int k = 0; k < 2; ++k) dst[n][k] = *(const LAS bf16x8*)(lds + PG8_SB(b, h) + boff + n * 2048 + k * 1024); } while (0)
#define PG8_MMA(ai, bj, At, Bt) do { __builtin_amdgcn_s_setprio(1); _Pragma("unroll") for (int m = 0; m < 4; ++m) _Pragma("unroll") for (int n = 0; n < 2; ++n) _Pragma("unroll") for (int k = 0; k < 2; ++k) \
        acc[ai][bj][m][n] = __builtin_amdgcn_mfma_f32_16x16x32_bf16(Bt[n][k], At[m][k], acc[ai][bj][m][n], 0, 0, 0); __builtin_amdgcn_s_setprio(0); } while (0)
#define PG8_WAIT_V(n) asm volatile("s_waitcnt vmcnt(" #n ")" ::: "memory")
#define PG8_WAIT_L(n) asm volatile("s_waitcnt lgkmcnt(" #n ")" ::: "memory")
#define PG8_BAR __builtin_amdgcn_s_barrier()
#define PG8_SCHED __builtin_amdgcn_sched_barrier(0)
    Unit cur, nxt; int ui = 0;
    if (!S.next(0, cur)) return;
    f32x4 acc[2][2][4][2];
#pragma unroll
    for (int a = 0; a < 2; ++a)
#pragma unroll
        for (int b = 0; b < 2; ++b)
#pragma unroll
            for (int m = 0; m < 4; ++m)
#pragma unroll
                for (int n = 0; n < 2; ++n) acc[a][b][m][n] = (f32x4){0.f, 0.f, 0.f, 0.f};
    bf16x8 At[4][2], B0[2][2], B1[2][2];
    const char* cA = cur.A; const char* cB = cur.B;
    S.a_ready(cur);
    if constexpr (SP2) {
        PG8_STAGE(PG8_SB(0, 0), cB, voffB); PG8_STAGE(PG8_SB(0, 1), cB + hstep, voffB); PG8_STAGE(PG8_SA(0, 0), cA, voffA); PG8_STAGE(PG8_SA(0, 1), cA + hstep, voffA);
        if (wr == 1) PG8_BAR;
        PG8_WAIT_V(2); PG8_BAR;
        PG8_STAGE(PG8_SB(1, 0), cB + kstep, voffB); PG8_STAGE(PG8_SA(1, 0), cA + kstep, voffA); PG8_STAGE(PG8_SB(1, 1), cB + hstep + kstep, voffB);
        PG8_WAIT_V(6); PG8_BAR;
    } else {
        PG8_STAGE(PG8_SB(0, 0), cB, voffB); PG8_STAGE(PG8_SA(0, 0), cA, voffA); PG8_STAGE(PG8_SB(0, 1), cB + hstep, voffB); PG8_STAGE(PG8_SA(0, 1), cA + hstep, voffA);
        if (wr == 1) PG8_BAR;
        PG8_WAIT_V(4); PG8_BAR;
        PG8_STAGE(PG8_SB(1, 0), cB + kstep, voffB); PG8_STAGE(PG8_SA(1, 0), cA + kstep, voffA); PG8_STAGE(PG8_SB(1, 1), cB + hstep + kstep, voffB);
        PG8_WAIT_V(6); PG8_BAR;
    }
    for (;;) {
        const bool has_next = S.next(ui + 1, nxt);
        const char* nA = has_next ? nxt.A : cA; const char* nB = has_next ? nxt.B : cB;
        for (int t = 0; t < nt; t += 2) {
            const bool last = (t == nt - 2);
            const char* a1 = cA + (size_t)(t + 1) * kstep;
            const char* a2 = last ? nA : cA + (size_t)(t + 2) * kstep; const char* b2 = last ? nB : cB + (size_t)(t + 2) * kstep;
            const char* a3 = a2 + kstep; const char* b3 = b2 + kstep;
            if (last && has_next) S.a_ready(nxt);
            if constexpr (SP2) {
            PG8_LDB(B0, 0, 0); PG8_LDB(B1, 0, 1); PG8_SCHED; PG8_LDA(At, 0, 0); PG8_STAGE(PG8_SA(1, 1), a1 + hstep, voffA);
            PG8_WAIT_V(8); PG8_WAIT_L(0); PG8_BAR; PG8_MMA(0, 0, At, B0); PG8_MMA(0, 1, At, B1); PG8_BAR; PG8_SCHED;
            PG8_LDA(At, 0, 1); PG8_STAGE(PG8_SB(0, 0), b2, voffB); PG8_STAGE(PG8_SB(0, 1), b2 + hstep, voffB); PG8_STAGE(PG8_SA(0, 0), a2, voffA);
            PG8_WAIT_V(8); PG8_WAIT_L(0); PG8_BAR; PG8_MMA(1, 0, At, B0); PG8_MMA(1, 1, At, B1); PG8_BAR; PG8_SCHED;
            PG8_LDB(B0, 1, 0); PG8_LDB(B1, 1, 1); PG8_SCHED; PG8_LDA(At, 1, 0); PG8_STAGE(PG8_SA(0, 1), a2 + hstep, voffA);
            PG8_WAIT_V(8); PG8_WAIT_L(0); PG8_BAR; PG8_MMA(0, 0, At, B0); PG8_MMA(0, 1, At, B1); PG8_BAR; PG8_SCHED;
            PG8_LDA(At, 1, 1); PG8_STAGE(PG8_SB(1, 0), b3, voffB); PG8_STAGE(PG8_SB(1, 1), b3 + hstep, voffB); PG8_STAGE(PG8_SA(1, 0), a3, voffA);
            PG8_WAIT_V(8); PG8_WAIT_L(0); PG8_BAR; PG8_MMA(1, 0, At, B0); PG8_MMA(1, 1, At, B1); PG8_BAR; PG8_SCHED;
            } else {
            PG8_LDB(B0, 0, 0); PG8_SCHED; PG8_LDA(At, 0, 0); PG8_STAGE(PG8_SA(1, 1), a1 + hstep, voffA);
            PG8_WAIT_L(8); PG8_BAR; PG8_WAIT_L(0); PG8_MMA(0, 0, At, B0); PG8_BAR; PG8_SCHED;
            PG8_LDB(B1, 0, 1); PG8_STAGE(PG8_SB(0, 0), b2, voffB);
            PG8_BAR; PG8_WAIT_L(0); PG8_MMA(0, 1, At, B1); PG8_BAR;
            PG8_LDA(At, 0, 1); PG8_STAGE(PG8_SA(0, 0), a2, voffA);
            PG8_BAR; PG8_WAIT_L(0); PG8_MMA(1, 0, At, B0); PG8_BAR; PG8_SCHED;
            PG8_STAGE(PG8_SB(0, 1), b2 + hstep, voffB);
            PG8_WAIT_V(6); PG8_BAR; PG8_MMA(1, 1, At, B1); PG8_BAR;
            PG8_LDB(B0, 1, 0); PG8_SCHED; PG8_LDA(At, 1, 0); PG8_STAGE(PG8_SA(0, 1), a2 + hstep, voffA);
            PG8_WAIT_L(8); PG8_BAR; PG8_WAIT_L(0); PG8_MMA(0, 0, At, B0); PG8_BAR; PG8_SCHED;
            PG8_LDB(B1, 1, 1); PG8_STAGE(PG8_SB(1, 0), b3, voffB);
            PG8_BAR; PG8_WAIT_L(0); PG8_MMA(0, 1, At, B1); PG8_BAR;
            PG8_LDA(At, 1, 1); PG8_STAGE(PG8_SA(1, 0), a3, voffA);
            PG8_BAR; PG8_WAIT_L(0); PG8_MMA(1, 0, At, B0); PG8_BAR; PG8_SCHED;
            PG8_STAGE(PG8_SB(1, 1), b3 + hstep, voffB);
            PG8_WAIT_V(6); PG8_BAR; PG8_MMA(1, 1, At, B1); PG8_BAR;
            }
        }
        if constexpr (ALIGN_EPI) { if (wr == 0) PG8_BAR; }
        E(acc, cur, wr, wc, fr, fq); S.done(cur);
        if (!has_next) break;
#pragma unroll
        for (int a = 0; a < 2; ++a)
#pragma unroll
            for (int b = 0; b < 2; ++b)
#pragma unroll
                for (int m = 0; m < 4; ++m)
#pragma unroll
                    for (int n = 0; n < 2; ++n) acc[a][b][m][n] = (f32x4){0.f, 0.f, 0.f, 0.f};
        cur = nxt; cA = nA; cB = nB; ++ui;
        if constexpr (ALIGN_EPI) { if (wr == 1) PG8_BAR; }
    }
    PG8_WAIT_V(0);
    if constexpr (!ALIGN_EPI) { if (wr == 0) PG8_BAR; }
    PG8_BAR;
#undef PG8_SA
#undef PG8_SB
#undef PG8_STAGE
#undef PG8_LDA
#undef PG8_LDB
#undef PG8_MMA
#undef PG8_WAIT_V
#undef PG8_WAIT_L
#undef PG8_BAR
#undef PG8_SCHED
}
}

#define PG8_SP2 true
#define PG8_ALIGN true

constexpr size_t MiB = 1u << 20;
constexpr size_t WS_CTL = 0, CTL_ZERO_BYTES = 1 * MiB;
constexpr size_t WS_WIN = 1 * MiB;
constexpr size_t WS_WR = WS_WIN + (size_t)NIN * D * 2;
constexpr size_t WS_PA = 12 * MiB, WS_PB = 13 * MiB, WS_WOUT = 14 * MiB, WS_WGU = 16 * MiB, WS_WD = 48 * MiB;
constexpr size_t WS_XB = 64 * MiB;
constexpr size_t WS_YA = 64 * MiB, WS_YB = 96 * MiB;
constexpr size_t WS_SMALL = 128 * MiB;
constexpr size_t WS_RS1 = WS_SMALL, WS_RS2 = WS_SMALL + 128 * 1024, WS_TREC = WS_SMALL + 256 * 1024, WS_TW = WS_SMALL + 512 * 1024, WS_TSLOT = WS_SMALL + 768 * 1024, WS_SW = WS_SMALL + 1024 * 1024;
constexpr size_t WS_Q = 130 * MiB, WS_K = 162 * MiB, WS_V = 194 * MiB, WS_BQ = 226 * MiB, WS_BK = 242 * MiB, WS_BV = 258 * MiB, WS_BR = 290 * MiB, WS_LA = 322 * MiB, WS_R = 354 * MiB, WS_GB = 418 * MiB;
constexpr size_t WS_TMP = 130 * MiB, WS_MRG = 194 * MiB;
constexpr size_t WS_XS = 130 * MiB, WS_H = 274 * MiB, WS_Y = 310 * MiB;
constexpr size_t WS_END = 482 * MiB;
constexpr int CW_TMO = 0, CW_CODE = 1, CW_BAR = 4096, CW_GCNT = 8192;

constexpr int SCR_BYTES = 155648;
constexpr int LC_OFF = SCR_BYTES;
constexpr int LC_MISC = LC_OFF, LC_TBASE = LC_OFF + 128, LC_TILEE = LC_OFF + 512, LC_LCNT = LC_OFF + 1792, LC_LBASE = LC_OFF + 1920, LC_REC = LC_OFF + 2048, LC_RECW = LC_OFF + 3072;
constexpr int LDS_BYTES = 163840;

#define RLX_AGENT __ATOMIC_RELAXED, __HIP_MEMORY_SCOPE_AGENT
#define LDS_WAIT() asm volatile("s_waitcnt lgkmcnt(0)" ::: "memory")
__device__ __forceinline__ unsigned f2bf(float f) { unsigned u = __builtin_bit_cast(unsigned, f); return (u + 0x7fffu + ((u >> 16) & 1u)) >> 16; }
__device__ __forceinline__ unsigned pk2(float lo, float hi) { return f2bf(lo) | (f2bf(hi) << 16); }
__device__ __forceinline__ float bflo(unsigned w) { return __uint_as_float(w << 16); }
__device__ __forceinline__ float bfhi(unsigned w) { return __uint_as_float(w & 0xffff0000u); }
__device__ __forceinline__ float bf2f(bf16 b) { return __uint_as_float(((unsigned)b) << 16); }
__device__ __forceinline__ float wave_sum(float v) {
#pragma unroll
    for (int o = 1; o < 64; o <<= 1) v += __shfl_xor(v, o);
    return v;
}
__device__ __forceinline__ float rdlane(float v, int i) { return __uint_as_float((unsigned)__builtin_amdgcn_readlane((int)__float_as_uint(v), i)); }
__device__ __forceinline__ float wave_max(float v) {
#pragma unroll
    for (int o = 1; o < 64; o <<= 1) v = fmaxf(v, __shfl_xor(v, o));
    return v;
}

#define XB_TMO      128
#define XB_XCNT(j)  (256  + 64 * (j))
#define XB_XSUB(j)  (1280 + 64 * (j))
#define XB_XGEN(j)  (2304 + 64 * (j))
#define XB_TOP      3328
#define XB_TOPGEN   3392
#define XCD_BAR_WORDS 3456
#define XB_SPIN_CAP (1u << 18)
__device__ __forceinline__ unsigned xb_ld(unsigned* p)              { return __hip_atomic_load(p, __ATOMIC_RELAXED, __HIP_MEMORY_SCOPE_AGENT); }
__device__ __forceinline__ unsigned xb_add(unsigned* p, unsigned v) { return __hip_atomic_fetch_add(p, v, __ATOMIC_RELAXED, __HIP_MEMORY_SCOPE_AGENT); }
__device__ __forceinline__ unsigned xb_xcc_id() { return (unsigned)__builtin_amdgcn_s_getreg((3 << 11) | 20) & 0xFu; }
#define XB_SPIN(cond, bar) do { unsigned _sp = 0; while (cond) { __builtin_amdgcn_s_sleep(1); \
    if ((++_sp & 255u) == 0u) { if (xb_ld(&(bar)[XB_TMO])) break; if (_sp > XB_SPIN_CAP) { atomicAdd(&(bar)[XB_TMO], 1u); break; } } } } while (0)
struct XcdBarrier { unsigned* bar; unsigned x; volatile LAS unsigned* st; };
__device__ __forceinline__ XcdBarrier xcd_barrier_post(unsigned* bar, volatile LAS unsigned* st) {
    XcdBarrier b; b.bar = bar; b.x = xb_xcc_id(); b.st = st;
    if (threadIdx.x == 0) (void)xb_add(&bar[XB_XCNT(b.x)], 1u);
    return b;
}
__device__ __forceinline__ void xcd_barrier_complete(unsigned* bar, unsigned x, unsigned& nloc, unsigned& nx) {
    const unsigned G = gridDim.x * gridDim.y * gridDim.z;
    unsigned sum, cnt, mine, sp = 0u;
    for (;;) {
        sum = 0u; cnt = 0u; mine = 0u;
#pragma unroll
        for (unsigned j = 0; j < 16; ++j) { const unsigned c = xb_ld(&bar[XB_XCNT(j)]); sum += c; cnt += (c > 0u) ? 1u : 0u; mine = (j == x) ? c : mine; }
        if (sum == G) break;
        __builtin_amdgcn_s_sleep(1);
        if ((++sp & 255u) == 0u) { if (xb_ld(&bar[XB_TMO])) break; if (sp > XB_SPIN_CAP) { atomicAdd(&bar[XB_TMO], 1u); break; } }
    }
    nloc = mine > 0u ? mine : 1u; nx = cnt > 0u ? cnt : 1u;
}
__device__ __forceinline__ void xcd_barrier(const XcdBarrier& b) {
    asm volatile("s_waitcnt vmcnt(0)" ::: "memory");
    __syncthreads();
    if (threadIdx.x == 0) {
        unsigned* bar = b.bar;
        __builtin_amdgcn_s_waitcnt(0);
        unsigned nloc = b.st[0], nx = b.st[1];
        if (nloc == 0u) { xcd_barrier_complete(bar, b.x, nloc, nx); b.st[0] = nloc; b.st[1] = nx; }
        const unsigned old = xb_add(&bar[XB_XSUB(b.x)], 1u);
        const unsigned gen = old / nloc;
        if (old + 1u == (gen + 1u) * nloc) {
            __builtin_amdgcn_fence(__ATOMIC_RELEASE, "agent");
            asm volatile("s_waitcnt vmcnt(0)" ::: "memory");
            const unsigned og = xb_add(&bar[XB_TOP], 1u);
            const unsigned tg = og / nx;
            if (og + 1u == (tg + 1u) * nx) xb_add(&bar[XB_TOPGEN], 1u);
            else XB_SPIN(xb_ld(&bar[XB_TOPGEN]) == tg, bar);
            __builtin_amdgcn_fence(__ATOMIC_ACQUIRE, "agent");
            xb_add(&bar[XB_XGEN(b.x)], 1u);
            asm volatile("s_waitcnt vmcnt(0)" ::: "memory");
        } else {
            XB_SPIN(xb_ld(&bar[XB_XGEN(b.x)]) == gen, bar);
            __builtin_amdgcn_fence(__ATOMIC_ACQUIRE, "agent");
            asm volatile("s_waitcnt vmcnt(0)" ::: "memory");
        }
    }
    __syncthreads();
}

struct Args { const float* in[20]; float* out; unsigned char* ws; int ph_lo, ph_hi; };
typedef const __attribute__((address_space(4))) Args* ArgsP;
struct Frame {
    LAS unsigned char* lds; unsigned* ctl; unsigned char* ws;
    int tid, lane, wave, vcu, G;
};
__device__ __forceinline__ ArgsP get_args() { ArgsP p = (ArgsP)__builtin_amdgcn_kernarg_segment_ptr(); asm volatile("" : "+s"(p)); return p; }
__device__ __forceinline__ Frame make_frame(ArgsP ap, int wave0) {
    extern __shared__ __attribute__((aligned(16))) unsigned char lds_raw[];
    Frame F; F.lds = (LAS unsigned char*)lds_raw; F.ws = ap->ws; F.ctl = (unsigned*)(F.ws + WS_CTL);
    unsigned z = 0u; asm volatile("" : "+v"(z));
    int t = wave0 * 64 + (int)__builtin_amdgcn_mbcnt_hi(~0u, __builtin_amdgcn_mbcnt_lo(~0u, z)); asm volatile("" : "+v"(t));
    F.tid = t; F.lane = t & 63; F.wave = __builtin_amdgcn_readfirstlane(t >> 6);
    F.G = gridDim.x; { const int bx = blockIdx.x; F.vcu = (F.G % 8 == 0) ? (bx % 8) * (F.G / 8) + bx / 8 : bx; }
    return F;
}

using pg8::cvt_pk_bf16;
__device__ __forceinline__ u32x4 pack8(f32x4 a, f32x4 b) { u32x4 w; w.x = cvt_pk_bf16(a[0], a[1]); w.y = cvt_pk_bf16(a[2], a[3]); w.z = cvt_pk_bf16(b[0], b[1]); w.w = cvt_pk_bf16(b[2], b[3]); return w; }
__device__ __forceinline__ void unpack8(u32x4 w, f32x4& a, f32x4& b) { a = (f32x4){bflo(w.x), bfhi(w.x), bflo(w.y), bfhi(w.y)}; b = (f32x4){bflo(w.z), bfhi(w.z), bflo(w.w), bfhi(w.w)}; }
__device__ __forceinline__ float sigmoidf_(float z) { return 1.0f / (1.0f + __expf(-z)); }

struct EpiIn {
    static constexpr bool PERM = true;
    const float* rowscale; bf16 *Q, *K, *V, *BQ, *BK, *BV, *BR, *R, *GB; float* LOGA; const float *qg, *kg, *lbias;
    __device__ __forceinline__ void operator()(const f32x4 (&acc)[2][2][4][2], const pg8::Unit& u, int wr, int wc, int fr, int fq) const {
        const int pn = u.pn, row0 = u.pm * 256 + wr * 64 + fr;
        if (pn < 4) {
            const bool isq = pn < 2; const int hh = 4 * (pn & 1) + wc;
            const float* g = (isq ? qg : kg) + hh * 64 + 8 * fq;
            f32x4 g0[2], g1[2];
#pragma unroll
            for (int bj = 0; bj < 2; ++bj) { g0[bj] = *(const f32x4*)(g + 32 * bj); g1[bj] = *(const f32x4*)(g + 32 * bj + 4); }
            const float sc = isq ? 0.125f * LOG2E : 1.0f; bf16* O = isq ? Q : K;
#pragma unroll
            for (int ai = 0; ai < 2; ++ai)
#pragma unroll
                for (int m = 0; m < 4; ++m) {
                    const int row = row0 + ai * 128 + m * 16; const float rs = rowscale[row];
                    f32x4 v[2][2]; float ss = 0.f;
#pragma unroll
                    for (int bj = 0; bj < 2; ++bj)
#pragma unroll
                        for (int n = 0; n < 2; ++n) { v[bj][n] = acc[ai][bj][m][n] * rs; const f32x4 q = v[bj][n] * v[bj][n]; ss += (q[0] + q[1]) + (q[2] + q[3]); }
                    ss += __shfl_xor(ss, 16); ss += __shfl_xor(ss, 32);
                    const float rn = rsqrtf(ss * (1.0f / 64.0f) + EPS) * sc;
#pragma unroll
                    for (int bj = 0; bj < 2; ++bj) *(u32x4*)(O + (size_t)row * 512 + hh * 64 + 32 * bj + 8 * fq) = pack8(v[bj][0] * g0[bj] * rn, v[bj][1] * g1[bj] * rn);
                }
        } else if (pn < 12) {
            bf16* O; int ld, cb; float sc = 1.0f; bool act = false;
            if (pn < 6) { O = V; ld = 512; cb = 256 * (pn - 4); }
            else if (pn == 6) { O = BQ; ld = 256; cb = 0; sc = 0.125f; }
            else if (pn == 7) { O = BK; ld = 256; cb = 0; }
            else if (pn < 10) { O = BV; ld = 512; cb = 256 * (pn - 8); }
            else { O = BR; ld = 512; cb = 256 * (pn - 10); act = true; }
#pragma unroll
            for (int ai = 0; ai < 2; ++ai)
#pragma unroll
                for (int m = 0; m < 4; ++m) {
                    const int row = row0 + ai * 128 + m * 16; const float rs = rowscale[row] * sc;
#pragma unroll
                    for (int bj = 0; bj < 2; ++bj) {
                        f32x4 a = acc[ai][bj][m][0] * rs, b = acc[ai][bj][m][1] * rs;
                        if (act) {
#pragma unroll
                            for (int e = 0; e < 4; ++e) { a[e] = a[e] * sigmoidf_(a[e]); b[e] = b[e] * sigmoidf_(b[e]); }
                        }
                        *(u32x4*)(O + (size_t)row * ld + cb + 64 * wc + 32 * bj + 8 * fq) = pack8(a, b);
                    }
                }
        } else if (pn == 12) {
            f32x4 b0[2], b1[2];
#pragma unroll
            for (int bj = 0; bj < 2; ++bj) { b0[bj] = *(const f32x4*)(lbias + 64 * wc + 32 * bj + 8 * fq); b1[bj] = *(const f32x4*)(lbias + 64 * wc + 32 * bj + 8 * fq + 4); }
#pragma unroll
            for (int ai = 0; ai < 2; ++ai)
#pragma unroll
                for (int m = 0; m < 4; ++m) {
                    const int row = row0 + ai * 128 + m * 16; const float rs = rowscale[row];
#pragma unroll
                    for (int bj = 0; bj < 2; ++bj) {
                        f32x4 a = acc[ai][bj][m][0] * rs + b0[bj], b = acc[ai][bj][m][1] * rs + b1[bj];
#pragma unroll
                        for (int e = 0; e < 4; ++e) { a[e] = (fminf(a[e], 0.f) - __logf(1.0f + __expf(-fabsf(a[e])))) * 0.0625f; b[e] = (fminf(b[e], 0.f) - __logf(1.0f + __expf(-fabsf(b[e])))) * 0.0625f; }
                        float* o = LOGA + (size_t)row * 256 + 64 * wc + 32 * bj + 8 * fq;
                        *(f32x4*)o = a; *(f32x4*)(o + 4) = b;
                    }
                }
        } else {
            const int cb = 128 * (pn - 13) + 32 * wc + 8 * fq;
#pragma unroll
            for (int ai = 0; ai < 2; ++ai)
#pragma unroll
                for (int m = 0; m < 4; ++m) {
                    const int row = row0 + ai * 128 + m * 16; const float rs = rowscale[row];
                    f32x4 ra, rb_, ga, gb_;
#pragma unroll
                    for (int e = 0; e < 4; ++e) {
                        float za = fminf(fmaxf(acc[ai][0][m][0][e] * rs, -30.f), 30.f), zb = fminf(fmaxf(acc[ai][1][m][0][e] * rs, -30.f), 30.f);
                        float ea = __expf(-za), eb = __expf(-zb); ga[e] = 1.0f / (1.0f + eb); ra[e] = (1.0f + eb) / (1.0f + ea);
                        za = fminf(fmaxf(acc[ai][0][m][1][e] * rs, -30.f), 30.f); zb = fminf(fmaxf(acc[ai][1][m][1][e] * rs, -30.f), 30.f);
                        ea = __expf(-za); eb = __expf(-zb); gb_[e] = 1.0f / (1.0f + eb); rb_[e] = (1.0f + eb) / (1.0f + ea);
                    }
                    *(u32x4*)(R + (size_t)row * 1024 + cb) = pack8(ra, rb_);
                    *(u32x4*)(GB + (size_t)row * 1024 + cb) = pack8(ga, gb_);
                }
        }
    }
};
struct EpiTmp {
    static constexpr bool PERM = true;
    const bf16* R; bf16* TMP;
    __device__ __forceinline__ void operator()(const f32x4 (&acc)[2][2][4][2], const pg8::Unit& u, int wr, int wc, int fr, int fq) const {
        const int row0 = u.pm * 256 + wr * 64 + fr, col0 = u.pn * 256 + wc * 32 + 8 * fq;
#pragma unroll
        for (int ai = 0; ai < 2; ++ai)
#pragma unroll
            for (int m = 0; m < 4; ++m)
#pragma unroll
                for (int bj = 0; bj < 2; ++bj) {
                    const size_t off = (size_t)(row0 + ai * 128 + m * 16) * 1024 + col0 + bj * 128;
                    f32x4 ra, rb_; unpack8(*(const u32x4*)(R + off), ra, rb_);
                    *(u32x4*)(TMP + off) = pack8(acc[ai][bj][m][0] * ra, acc[ai][bj][m][1] * rb_);
                }
    }
};
struct EpiMrg {
    static constexpr bool PERM = true;
    const bf16* GB; const bf16* TMP; bf16* MRG;
    __device__ __forceinline__ void operator()(const f32x4 (&acc)[2][2][4][2], const pg8::Unit& u, int wr, int wc, int fr, int fq) const {
        const int row0 = u.pm * 256 + wr * 64 + fr, col0 = u.pn * 256 + wc * 32 + 8 * fq;
#pragma unroll
        for (int ai = 0; ai < 2; ++ai)
#pragma unroll
            for (int m = 0; m < 4; ++m)
#pragma unroll
                for (int bj = 0; bj < 2; ++bj) {
                    const size_t off = (size_t)(row0 + ai * 128 + m * 16) * 1024 + col0 + bj * 128;
                    f32x4 ga, gb_, ta, tb; unpack8(*(const u32x4*)(GB + off), ga, gb_); unpack8(*(const u32x4*)(TMP + off), ta, tb);
                    *(u32x4*)(MRG + off) = pack8((acc[ai][bj][m][0] + ta) * ga, (acc[ai][bj][m][1] + tb) * gb_);
                }
    }
};
struct EpiOut {
    static constexpr bool PERM = false;
    const float* xres; float* xnew;
    __device__ __forceinline__ void operator()(const f32x4 (&acc)[2][2][4][2], const pg8::Unit& u, int wr, int wc, int fr, int fq) const {
        const int row0 = u.pm * 256 + wr * 64 + fr, col0 = u.pn * 256 + wc * 32 + 4 * fq;
#pragma unroll
        for (int ai = 0; ai < 2; ++ai)
#pragma unroll
            for (int m = 0; m < 4; ++m) {
                const size_t off = (size_t)(row0 + ai * 128 + m * 16) * 1024 + col0;
#pragma unroll
                for (int bj = 0; bj < 2; ++bj)
#pragma unroll
                    for (int n = 0; n < 2; ++n) { const f32x4 xr = *(const f32x4*)(xres + off + bj * 128 + n * 16); *(f32x4*)(xnew + off + bj * 128 + n * 16) = xr + acc[ai][bj][m][n]; }
            }
    }
};
struct EpiGU {
    static constexpr bool PERM = true;
    bf16* H;
    __device__ __forceinline__ void operator()(const f32x4 (&acc)[2][2][4][2], const pg8::Unit& u, int wr, int wc, int fr, int fq) const {
        const int row0 = u.pm * 256 + wr * 64 + fr, col0 = u.pn * 128 + wc * 32 + 8 * fq;
#pragma unroll
        for (int ai = 0; ai < 2; ++ai)
#pragma unroll
            for (int m = 0; m < 4; ++m) {
                f32x4 a, b;
#pragma unroll
                for (int e = 0; e < 4; ++e) { const float g0 = acc[ai][0][m][0][e], g1 = acc[ai][0][m][1][e]; a[e] = g0 * sigmoidf_(g0) * acc[ai][1][m][0][e]; b[e] = g1 * sigmoidf_(g1) * acc[ai][1][m][1][e]; }
                *(u32x4*)(H + (size_t)(row0 + ai * 128 + m * 16) * 256 + col0) = pack8(a, b);
            }
    }
};
struct EpiDown {
    static constexpr bool PERM = true;
    const float* sw; bf16* Y;
    __device__ __forceinline__ void operator()(const f32x4 (&acc)[2][2][4][2], const pg8::Unit& u, int wr, int wc, int fr, int fq) const {
        const int row0 = u.pm * 256 + wr * 64 + fr, col0 = u.pn * 256 + wc * 32 + 8 * fq;
#pragma unroll
        for (int ai = 0; ai < 2; ++ai)
#pragma unroll
            for (int m = 0; m < 4; ++m) {
                const int row = row0 + ai * 128 + m * 16; const float w = sw[row];
#pragma unroll
                for (int bj = 0; bj < 2; ++bj) *(u32x4*)(Y + (size_t)row * 1024 + col0 + bj * 128) = pack8(acc[ai][bj][m][0] * w, acc[ai][bj][m][1] * w);
            }
    }
};

__device__ __forceinline__ void cvt_item(const float* src, int ldn, const float* kscale, bf16* dst, int Kd, int drow0, int k0, LAS float* scr, int lane) {
#pragma unroll 8
    for (int i = 0; i < 32; ++i) { const int kk = 2 * i + (lane >> 5); float v = src[(size_t)(k0 + kk) * ldn + (lane & 31)]; if (kscale) v *= kscale[k0 + kk]; scr[kk * 33 + (lane & 31)] = v; }
    LDS_WAIT(); asm volatile("" ::: "memory");
    const int c = lane & 7;
#pragma unroll
    for (int j = 0; j < 4; ++j) { const int n = (lane >> 3) + 8 * j; const LAS float* s = scr + (8 * c) * 33 + n;
        u32x4 o; o.x = pk2(s[0 * 33], s[1 * 33]); o.y = pk2(s[2 * 33], s[3 * 33]); o.z = pk2(s[4 * 33], s[5 * 33]); o.w = pk2(s[6 * 33], s[7 * 33]);
        *(u32x4*)(dst + (size_t)(drow0 + n) * Kd + k0 + 8 * c) = o; }
    LDS_WAIT(); asm volatile("" ::: "memory");
}
__device__ __forceinline__ void cvt_item_lr(const float* win, const float* gup, int c0, const float* kscale, bf16* dst, int drow0, int k0, LAS float* scr, int lane) {
    float gu[16];
#pragma unroll
    for (int r = 0; r < 16; ++r) gu[r] = gup[r * 256 + c0 + (lane & 31)];
#pragma unroll 4
    for (int i = 0; i < 32; ++i) { const int kk = 2 * i + (lane >> 5); const float* wr_ = win + (size_t)(k0 + kk) * IN_COLS + 3072; float v = 0.f;
#pragma unroll
        for (int r = 0; r < 16; ++r) v += wr_[r] * gu[r];
        scr[kk * 33 + (lane & 31)] = v * kscale[k0 + kk]; }
    LDS_WAIT(); asm volatile("" ::: "memory");
    const int c = lane & 7;
#pragma unroll
    for (int j = 0; j < 4; ++j) { const int n = (lane >> 3) + 8 * j; const LAS float* s = scr + (8 * c) * 33 + n;
        u32x4 o; o.x = pk2(s[0 * 33], s[1 * 33]); o.y = pk2(s[2 * 33], s[3 * 33]); o.z = pk2(s[4 * 33], s[5 * 33]); o.w = pk2(s[6 * 33], s[7 * 33]);
        *(u32x4*)(dst + (size_t)(drow0 + n) * D + k0 + 8 * c) = o; }
    LDS_WAIT(); asm volatile("" ::: "memory");
}
__device__ __forceinline__ void phase_weights(const Frame& F, ArgsP a, int l) {
    LAS float* scr = (LAS float*)(F.lds + F.wave * 16384);
    const int gw = F.vcu * 8 + F.wave, NGW = F.G * 8, lane = F.lane;
    const float* win = a->in[2] + (size_t)l * D * IN_COLS; const float* gmix = a->in[1] + l * D; const float* gup = a->in[6] + l * 16 * 256;
    bf16* WIN = (bf16*)(F.ws + WS_WIN); bf16* PA = (bf16*)(F.ws + WS_PA); bf16* PB = (bf16*)(F.ws + WS_PB); bf16* WOUT = (bf16*)(F.ws + WS_WOUT); bf16* WGU = (bf16*)(F.ws + WS_WGU); bf16* WD = (bf16*)(F.ws + WS_WD);
    constexpr int I0 = (NIN / 32) * 16, I1 = 32 * 8, I2 = 32 * 8, I3 = 32 * 16, I4 = NE * 16 * 16, I5 = NE * 32 * 4;
    for (int it = gw; it < I0 + I1 + I2 + I3 + I4 + I5; it += NGW) {
        int r = it;
        if (r < I0) { const int nb = r >> 4, kb = r & 15, P = nb * 32, pn = P >> 8, p = P & 255;
            if (pn == 12) { const int c0 = 64 * ((p >> 5) & 3) + 32 * (p >> 7); cvt_item_lr(win, gup, c0, gmix, WIN, P, kb * 64, scr, lane); }
            else { const int src = pn < 12 ? 256 * pn + 64 * ((p >> 5) & 3) + 32 * (p >> 7) : 3088 + 1024 * (p >> 7) + 128 * (pn - 13) + (p & 127);
                   cvt_item(win + src, IN_COLS, gmix, WIN, D, P, kb * 64, scr, lane); }
            continue; } r -= I0;
        if (r < I1) { const int nb = r >> 3, kb = r & 7; cvt_item(a->in[9] + (size_t)l * 512 * D + nb * 32, D, nullptr, PA, 512, nb * 32, kb * 64, scr, lane); continue; } r -= I1;
        if (r < I2) { const int nb = r >> 3, kb = r & 7; cvt_item(a->in[10] + (size_t)l * 512 * D + nb * 32, D, nullptr, PB, 512, nb * 32, kb * 64, scr, lane); continue; } r -= I2;
        if (r < I3) { const int nb = r >> 4, kb = r & 15; cvt_item(a->in[11] + (size_t)l * D * D + nb * 32, D, nullptr, WOUT, D, nb * 32, kb * 64, scr, lane); continue; } r -= I3;
        if (r < I4) { const int e = r >> 8, nb = (r >> 4) & 15, kb = r & 15, p0 = nb * 32; const int j0 = 128 * (p0 >> 8) + (p0 & 127);
            const float* src = ((p0 >> 7) & 1 ? a->in[18] : a->in[17]) + ((size_t)(l * NE + e) * D) * DE + j0;
            cvt_item(src, DE, nullptr, WGU + (size_t)e * 512 * D, D, p0, kb * 64, scr, lane); continue; } r -= I4;
        { const int e = r >> 7, nb = (r >> 2) & 31, kb = r & 3;
            cvt_item(a->in[19] + ((size_t)(l * NE + e) * DE) * D + nb * 32, D, nullptr, WD + (size_t)e * D * DE, DE, nb * 32, kb * 64, scr, lane); }
    }
    float* WR = (float*)(F.ws + WS_WR); const float* gf = a->in[12] + l * D; const float* wg = a->in[13] + (size_t)l * D * 4; const float* wrt = a->in[15] + (size_t)l * D * 32;
    for (int i = (F.vcu * 512 + F.tid); i < D * 36; i += F.G * 512) { const int k = i / 36, j = i % 36; WR[i] = gf[k] * (j < 4 ? wg[k * 4 + j] : wrt[k * 32 + j - 4]); }
}
__device__ __forceinline__ void phase_x_to_xb(const Frame& F, const float* x) {
    bf16* XB = (bf16*)(F.ws + WS_XB); float* RS = (float*)(F.ws + WS_RS1);
    const int gw = F.vcu * 8 + F.wave, NGW = F.G * 8;
    for (int m = gw; m < T; m += NGW) {
        const f32x4* xr = (const f32x4*)(x + (size_t)m * D) + F.lane; f32x4 v[4]; float s = 0.f;
#pragma unroll
        for (int j = 0; j < 4; ++j) { v[j] = xr[64 * j]; s += (v[j][0] * v[j][0] + v[j][1] * v[j][1]) + (v[j][2] * v[j][2] + v[j][3] * v[j][3]); }
        s = wave_sum(s);
        u32x2* o = (u32x2*)(XB + (size_t)m * D) + F.lane;
#pragma unroll
        for (int j = 0; j < 4; ++j) { u32x2 w; w.x = pk2(v[j][0], v[j][1]); w.y = pk2(v[j][2], v[j][3]); o[64 * j] = w; }
        if (F.lane == 0) RS[m] = rsqrtf(s * (1.0f / D) + EPS);
    }
}

__device__ __forceinline__ void phase_attn_naive(const Frame& F, ArgsP a, int l) {
    constexpr int KP = 136, VP = 128;
    LAS unsigned char* Ks = F.lds; LAS unsigned char* Vs = F.lds + 576 * KP;
    const bf16* Qb = (const bf16*)(F.ws + WS_Q); const bf16* Kb = (const bf16*)(F.ws + WS_K); const bf16* Vb = (const bf16*)(F.ws + WS_V); bf16* YA = (bf16*)(F.ws + WS_YA);
    const float* rb = a->in[5]; const int lane = F.lane;
    for (int u = F.vcu; u < 4096; u += F.G) {
        const int c = u & 31, h = (u >> 5) & 7, b = u >> 8, t0 = b * SEQ + c * 64;
        __syncthreads();
        for (int i = F.tid; i < 576 * 8; i += 512) { const int kk = i >> 3, ch = i & 7, jb = kk >> 6; u32x4 kv = (u32x4){0u, 0u, 0u, 0u}, vv = kv;
            if (c - 8 + jb >= 0) { const size_t off = (size_t)(t0 - 512 + kk) * 512 + h * 64 + ch * 8; kv = *(const u32x4*)(Kb + off); vv = *(const u32x4*)(Vb + off); }
            *(LAS u32x2*)(Ks + kk * KP + ch * 16) = (u32x2){kv.x, kv.y}; *(LAS u32x2*)(Ks + kk * KP + ch * 16 + 8) = (u32x2){kv.z, kv.w};
            *(LAS u32x4*)(Vs + kk * VP + ch * 16) = vv; }
        __syncthreads();
        const float mq = wave_max(fabsf(a->in[3][(l * 8 + h) * 64 + lane])), mk = wave_max(fabsf(a->in[4][(l * 8 + h) * 64 + lane]));
        float mb = 0.f; for (int i = lane; i < 257; i += 64) mb = fmaxf(mb, fabsf(rb[i * 8 + h])); mb = wave_max(mb);
        const float M2 = LOG2E * (8.0f * mq * mk + mb);
        for (int qq = 0; qq < 8; ++qq) {
            const int qi = 8 * F.wave + qq, t = t0 + qi;
            const float qv = bf2f(Qb[(size_t)t * 512 + h * 64 + lane]);
            float p[9]; float lsum = 0.f;
#pragma unroll
            for (int j = 0; j < 9; ++j) {
                float s = 0.f; const LAS unsigned char* kr = Ks + (64 * j + lane) * KP;
#pragma unroll
                for (int d4 = 0; d4 < 16; ++d4) { const u32x2 w = *(const LAS u32x2*)(kr + d4 * 8);
                    s += rdlane(qv, 4 * d4) * bflo(w.x) + rdlane(qv, 4 * d4 + 1) * bfhi(w.x) + rdlane(qv, 4 * d4 + 2) * bflo(w.y) + rdlane(qv, 4 * d4 + 3) * bfhi(w.y); }
                int idx = 64 * (8 - j) + qi - lane; idx = (idx > 128 ? 128 : idx) + 128;
                const float bias = rb[idx * 8 + h] * LOG2E;
                p[j] = (c - 8 + j >= 0) ? exp2f(s + bias - M2) : 0.f; lsum += p[j];
            }
            lsum = wave_sum(lsum);
            float o = 0.f;
#pragma unroll
            for (int j = 0; j < 9; ++j)
                for (int i = 0; i < 64; ++i) o += rdlane(p[j], i) * bf2f(*(const LAS bf16*)(Vs + (64 * j + i) * VP + lane * 2));
            YA[(size_t)t * 512 + h * 64 + lane] = (bf16)f2bf(o / lsum);
        }
    }
}

__device__ __forceinline__ void phase_gla_naive(const Frame& F, ArgsP a, int l) {
    LAS float* qs = (LAS float*)F.lds; LAS float* ks = qs + 4096; LAS float* as = ks + 4096; LAS float* vs = as + 4096; LAS float* os = vs + 8192;
    const bf16* BQ = (const bf16*)(F.ws + WS_BQ); const bf16* BK = (const bf16*)(F.ws + WS_BK); const bf16* BV = (const bf16*)(F.ws + WS_BV); const bf16* BR = (const bf16*)(F.ws + WS_BR);
    const float* LA = (const float*)(F.ws + WS_LA); bf16* YB = (bf16*)(F.ws + WS_YB); const float* og = a->in[8] + l * 512;
    const int j = F.tid >> 2, kq = F.tid & 3;
    for (int u = F.vcu; u < 64; u += F.G) {
        const int h = u & 3, b = u >> 2;
        float S[16];
#pragma unroll
        for (int i = 0; i < 16; ++i) S[i] = 0.f;
        for (int c = 0; c < 32; ++c) {
            const int tb = b * SEQ + c * 64;
            __syncthreads();
            for (int i = F.tid; i < 4096; i += 512) { const int t = i >> 6, dk = i & 63; const size_t off = (size_t)(tb + t) * 256 + h * 64 + dk;
                qs[i] = bf2f(BQ[off]); ks[i] = bf2f(BK[off]); as[i] = __expf(LA[off]); }
            for (int i = F.tid; i < 8192; i += 512) { const int t = i >> 7, dv = i & 127; vs[i] = bf2f(BV[(size_t)(tb + t) * 512 + h * 128 + dv]); }
            __syncthreads();
            for (int t = 0; t < 64; ++t) {
                const float v = vs[t * 128 + j]; float o = 0.f;
#pragma unroll
                for (int i4 = 0; i4 < 4; ++i4) {
                    const f32x4 a4 = *(const LAS f32x4*)(as + t * 64 + 16 * kq + 4 * i4), k4 = *(const LAS f32x4*)(ks + t * 64 + 16 * kq + 4 * i4), q4 = *(const LAS f32x4*)(qs + t * 64 + 16 * kq + 4 * i4);
#pragma unroll
                    for (int e = 0; e < 4; ++e) { S[4 * i4 + e] = a4[e] * S[4 * i4 + e] + k4[e] * v; o += q4[e] * S[4 * i4 + e]; }
                }
                o += __shfl_xor(o, 1); o += __shfl_xor(o, 2);
                if (kq == 0) os[t * 128 + j] = o;
            }
            __syncthreads();
            for (int r = 0; r < 8; ++r) { const int t = 8 * F.wave + r; const float o1 = os[t * 128 + F.lane], o2 = os[t * 128 + 64 + F.lane];
                const float rn = rsqrtf(wave_sum(o1 * o1 + o2 * o2) * (1.0f / 128.0f) + EPS);
                const size_t off = (size_t)(tb + t) * 512 + h * 128 + F.lane;
                YB[off] = (bf16)f2bf(o1 * rn * og[h * 128 + F.lane] * bf2f(BR[off])); YB[off + 64] = (bf16)f2bf(o2 * rn * og[h * 128 + 64 + F.lane] * bf2f(BR[off + 64])); }
        }
    }
}

__device__ __forceinline__ void phase_router(const Frame& F, ArgsP a, int l, const float* xnew) {
    LAS float* W = (LAS float*)F.lds;
    const float* WR = (const float*)(F.ws + WS_WR);
    for (int i = F.tid; i < D * 36 / 4; i += 512) ((LAS f32x4*)W)[i] = ((const f32x4*)WR)[i];
    volatile LAS unsigned* lcnt = (volatile LAS unsigned*)(F.lds + LC_LCNT); volatile LAS unsigned* lbase = (volatile LAS unsigned*)(F.lds + LC_LBASE);
    LAS unsigned* rec = (LAS unsigned*)(F.lds + LC_REC); LAS float* recw = (LAS float*)(F.lds + LC_RECW);
    unsigned* gcnt = F.ctl + CW_GCNT + l * 64; float* RS2 = (float*)(F.ws + WS_RS2); unsigned* TREC = (unsigned*)(F.ws + WS_TREC); float* TW = (float*)(F.ws + WS_TW);
    const float* bg = a->in[14] + l * 4; const float* br = a->in[16] + l * 32; const int lane = F.lane;
    for (int blk = F.vcu; blk < T / 128; blk += F.G) {
        __syncthreads();
        if (F.tid < 32) lcnt[F.tid] = 0u;
        __syncthreads();
        for (int r = 0; r < 16; ++r) {
            const int tl = F.wave * 16 + r, t = blk * 128 + tl;
            float acc[36];
#pragma unroll
            for (int jj = 0; jj < 36; ++jj) acc[jj] = 0.f;
            float ss = 0.f;
            for (int i = 0; i < 16; ++i) { const int k = lane + 64 * i; const float xv = xnew[(size_t)t * D + k]; ss += xv * xv; const LAS f32x4* wr_ = (const LAS f32x4*)(W + k * 36);
#pragma unroll
                for (int q = 0; q < 9; ++q) { const f32x4 w4 = wr_[q]; acc[4 * q] += xv * w4[0]; acc[4 * q + 1] += xv * w4[1]; acc[4 * q + 2] += xv * w4[2]; acc[4 * q + 3] += xv * w4[3]; } }
            ss = wave_sum(ss); const float rs = rsqrtf(ss * (1.0f / D) + EPS);
#pragma unroll
            for (int jj = 0; jj < 36; ++jj) acc[jj] = wave_sum(acc[jj]) * rs;
            float gl[4];
#pragma unroll
            for (int g = 0; g < 4; ++g) gl[g] = acc[g] + bg[g];
            int gi = 0; float gm = gl[0];
#pragma unroll
            for (int g = 1; g < 4; ++g) if (gl[g] > gm) { gm = gl[g]; gi = g; }
            float Z = 0.f;
#pragma unroll
            for (int g = 0; g < 4; ++g) Z += __expf(gl[g] - gm);
            const float gtop = 1.0f / Z;
            float el[8];
#pragma unroll
            for (int i = 0; i < 8; ++i) { const float v0 = acc[4 + i] + br[i], v1 = acc[12 + i] + br[8 + i], v2 = acc[20 + i] + br[16 + i], v3 = acc[28 + i] + br[24 + i]; el[i] = gi == 0 ? v0 : gi == 1 ? v1 : gi == 2 ? v2 : v3; }
            int i1 = 0; float m1 = el[0];
#pragma unroll
            for (int i = 1; i < 8; ++i) if (el[i] > m1) { m1 = el[i]; i1 = i; }
            int i2 = -1; float m2 = -3.0e38f;
#pragma unroll
            for (int i = 0; i < 8; ++i) if (i != i1 && el[i] > m2) { m2 = el[i]; i2 = i; }
            const float w1 = 1.0f / (1.0f + __expf(m2 - m1)), w2 = 1.0f - w1;
            if (lane == 0) {
                const int e1 = gi * 8 + i1, e2 = gi * 8 + i2;
                const unsigned p1 = __hip_atomic_fetch_add((LAS unsigned*)(F.lds + LC_LCNT) + e1, 1u, __ATOMIC_RELAXED, __HIP_MEMORY_SCOPE_WORKGROUP), p2 = __hip_atomic_fetch_add((LAS unsigned*)(F.lds + LC_LCNT) + e2, 1u, __ATOMIC_RELAXED, __HIP_MEMORY_SCOPE_WORKGROUP);
                rec[2 * tl] = ((unsigned)e1 << 16) | p1; rec[2 * tl + 1] = ((unsigned)e2 << 16) | p2; recw[2 * tl] = w1 * gtop; recw[2 * tl + 1] = w2 * gtop;
                RS2[t] = rs;
            }
        }
        __syncthreads();
        if (F.tid < 32) lbase[F.tid] = __hip_atomic_fetch_add(gcnt + F.tid, lcnt[F.tid], RLX_AGENT);
        __syncthreads();
        if (F.tid < 256) { const unsigned rc = rec[F.tid], e = rc >> 16; TREC[(size_t)blk * 256 + F.tid] = (e << 16) | ((rc & 0xffffu) + lbase[e]); TW[(size_t)blk * 256 + F.tid] = recw[F.tid]; }
    }
}
__device__ __forceinline__ void build_tiles(const Frame& F, int l) {
    volatile LAS int* tbase = (volatile LAS int*)(F.lds + LC_TBASE); volatile LAS int* tile_e = (volatile LAS int*)(F.lds + LC_TILEE);
    __syncthreads();
    if (F.tid == 0) { int s = 0; for (int e = 0; e < NE; ++e) { tbase[e] = s; const int n = (int)__hip_atomic_load(F.ctl + CW_GCNT + l * 64 + e, RLX_AGENT); s += (n + 255) >> 8; } tbase[NE] = s; }
    __syncthreads();
    if (F.tid < NE) { const int t0 = tbase[F.tid], t1 = tbase[F.tid + 1]; for (int t = t0; t < t1 && t < MAXTILES; ++t) tile_e[t] = F.tid; }
    __syncthreads();
}
__device__ __forceinline__ void phase_copy(const Frame& F, ArgsP a, int l, const float* xnew) {
    build_tiles(F, l);
    const volatile LAS int* tbase = (const volatile LAS int*)(F.lds + LC_TBASE);
    const float* RS2 = (const float*)(F.ws + WS_RS2); const unsigned* TREC = (const unsigned*)(F.ws + WS_TREC); const float* TW = (const float*)(F.ws + WS_TW);
    int* TSLOT = (int*)(F.ws + WS_TSLOT); float* SW = (float*)(F.ws + WS_SW); bf16* XS = (bf16*)(F.ws + WS_XS); const float* gf = a->in[12] + l * D;
    const int gw = F.vcu * 8 + F.wave, NGW = F.G * 8;
    f32x4 g[4];
#pragma unroll
    for (int j = 0; j < 4; ++j) g[j] = ((const f32x4*)gf)[F.lane + 64 * j];
    for (int t = gw; t < T; t += NGW) {
        const float rs = RS2[t]; const unsigned r0 = TREC[2 * t], r1 = TREC[2 * t + 1];
        const int s0 = 256 * tbase[r0 >> 16] + (int)(r0 & 0xffffu), s1 = 256 * tbase[r1 >> 16] + (int)(r1 & 0xffffu);
        const f32x4* xr = (const f32x4*)(xnew + (size_t)t * D) + F.lane;
        u32x2* o0 = (u32x2*)(XS + (size_t)s0 * D) + F.lane; u32x2* o1 = (u32x2*)(XS + (size_t)s1 * D) + F.lane;
#pragma unroll
        for (int j = 0; j < 4; ++j) { const f32x4 v = xr[64 * j] * g[j] * rs; u32x2 w; w.x = pk2(v[0], v[1]); w.y = pk2(v[2], v[3]); o0[64 * j] = w; o1[64 * j] = w; }
        if (F.lane == 0) { TSLOT[2 * t] = s0; TSLOT[2 * t + 1] = s1; SW[s0] = TW[2 * t]; SW[s1] = TW[2 * t + 1]; }
    }
}
__device__ __forceinline__ void phase_final(const Frame& F, float* x, bool make_xb) {
    const int* TSLOT = (const int*)(F.ws + WS_TSLOT); const bf16* Y = (const bf16*)(F.ws + WS_Y); bf16* XB = (bf16*)(F.ws + WS_XB); float* RS = (float*)(F.ws + WS_RS1);
    const int gw = F.vcu * 8 + F.wave, NGW = F.G * 8;
    for (int t = gw; t < T; t += NGW) {
        const int s0 = TSLOT[2 * t], s1 = TSLOT[2 * t + 1];
        f32x4* xr = (f32x4*)(x + (size_t)t * D) + F.lane; const u32x2* y0 = (const u32x2*)(Y + (size_t)s0 * D) + F.lane; const u32x2* y1 = (const u32x2*)(Y + (size_t)s1 * D) + F.lane;
        f32x4 v[4]; float s = 0.f;
#pragma unroll
        for (int j = 0; j < 4; ++j) { const u32x2 a0 = y0[64 * j], a1 = y1[64 * j]; v[j] = xr[64 * j] + (f32x4){bflo(a0.x), bfhi(a0.x), bflo(a0.y), bfhi(a0.y)} + (f32x4){bflo(a1.x), bfhi(a1.x), bflo(a1.y), bfhi(a1.y)};
            xr[64 * j] = v[j]; s += (v[j][0] * v[j][0] + v[j][1] * v[j][1]) + (v[j][2] * v[j][2] + v[j][3] * v[j][3]); }
        if (make_xb) {
            s = wave_sum(s);
            u32x2* o = (u32x2*)(XB + (size_t)t * D) + F.lane;
#pragma unroll
            for (int j = 0; j < 4; ++j) { u32x2 w; w.x = pk2(v[j][0], v[j][1]); w.y = pk2(v[j][2], v[j][3]); o[64 * j] = w; }
            if (F.lane == 0) RS[t] = rsqrtf(s * (1.0f / D) + EPS);
        }
    }
}

constexpr int PH_PER_LAYER = 16, NPH = DEPTH * PH_PER_LAYER;
#ifndef PH_MASK
#define PH_MASK 0xffff
#endif
__global__ void __launch_bounds__(512, 2) fwd_kernel(Args args_unused) {
    extern __shared__ __attribute__((aligned(16))) unsigned char lds_raw[];
    const int wave0 = __builtin_amdgcn_readfirstlane((int)threadIdx.x >> 6);
    {
        LAS unsigned char* lds0 = (LAS unsigned char*)lds_raw;
        for (int u = threadIdx.x; u < (LDS_BYTES - LC_OFF) / 4; u += 512) ((LAS unsigned*)(lds0 + LC_OFF))[u] = 0u;
        __syncthreads();
    }
#if MK_ONE_LAUNCH
    XcdBarrier bar; { ArgsP ap = get_args(); bar = xcd_barrier_post((unsigned*)(ap->ws + WS_CTL) + CW_BAR, (volatile LAS unsigned*)((LAS unsigned char*)lds_raw + LC_MISC) + 8); }
#define GRID_BAR() xcd_barrier(bar)
#else
#define GRID_BAR() do { } while (0)
#endif
    int lo, hi; { ArgsP ap = get_args(); lo = ap->ph_lo; hi = ap->ph_hi; }
#define IN(k) (((PH_MASK >> ((k) % PH_PER_LAYER)) & 1) && lo <= (k) && (k) < hi)
#define SEAM(k) do { if (IN(k) && IN((k) + 1)) GRID_BAR(); } while (0)
    for (int l = 0; l < DEPTH; ++l) {
        const int P = l * PH_PER_LAYER;
        if (IN(P + 0)) { ArgsP ap = get_args(); const Frame F = make_frame(ap, wave0); phase_weights(F, ap, l); if (l == 0) phase_x_to_xb(F, ap->in[0]); }
        SEAM(P + 0);
        if (IN(P + 1)) {
            ArgsP ap = get_args(); const Frame F = make_frame(ap, wave0);
            pg8::DenseOrder S; S.init(T, NIN, D, F.G, (int)blockIdx.x, F.ws + WS_XB, F.ws + WS_WIN);
            EpiIn E{(const float*)(F.ws + WS_RS1), (bf16*)(F.ws + WS_Q), (bf16*)(F.ws + WS_K), (bf16*)(F.ws + WS_V), (bf16*)(F.ws + WS_BQ), (bf16*)(F.ws + WS_BK), (bf16*)(F.ws + WS_BV), (bf16*)(F.ws + WS_BR),
                    (bf16*)(F.ws + WS_R), (bf16*)(F.ws + WS_GB), (float*)(F.ws + WS_LA), ap->in[3] + l * 512, ap->in[4] + l * 512, ap->in[7] + l * 256};
            pg8::gemm_phase<EpiIn, pg8::DenseOrder, PG8_ALIGN, PG8_SP2>(F.lds, D, S, E, F.tid);
        }
        SEAM(P + 1);
        if (IN(P + 2)) { { ArgsP ap = get_args(); const Frame F = make_frame(ap, wave0); phase_gla_naive(F, ap, l); } { ArgsP ap = get_args(); const Frame F = make_frame(ap, wave0); phase_attn_naive(F, ap, l); } }
        SEAM(P + 2);
        if (IN(P + 3)) {
            ArgsP ap = get_args(); const Frame F = make_frame(ap, wave0);
            pg8::DenseOrder S; S.init(T, D, 512, F.G, (int)blockIdx.x, F.ws + WS_YA, F.ws + WS_PA);
            EpiTmp E{(const bf16*)(F.ws + WS_R), (bf16*)(F.ws + WS_TMP)};
            pg8::gemm_phase<EpiTmp, pg8::DenseOrder, PG8_ALIGN, PG8_SP2>(F.lds, 512, S, E, F.tid);
        }
        SEAM(P + 3);
        if (IN(P + 4)) {
            ArgsP ap = get_args(); const Frame F = make_frame(ap, wave0);
            pg8::DenseOrder S; S.init(T, D, 512, F.G, (int)blockIdx.x, F.ws + WS_YB, F.ws + WS_PB);
            EpiMrg E{(const bf16*)(F.ws + WS_GB), (const bf16*)(F.ws + WS_TMP), (bf16*)(F.ws + WS_MRG)};
            pg8::gemm_phase<EpiMrg, pg8::DenseOrder, PG8_ALIGN, PG8_SP2>(F.lds, 512, S, E, F.tid);
        }
        SEAM(P + 4);
        if (IN(P + 5)) {
            ArgsP ap = get_args(); const Frame F = make_frame(ap, wave0);
            pg8::DenseOrder S; S.init(T, D, D, F.G, (int)blockIdx.x, F.ws + WS_MRG, F.ws + WS_WOUT);
            EpiOut E{(l == 0) ? ap->in[0] : (const float*)ap->out, ap->out};
            pg8::gemm_phase<EpiOut, pg8::DenseOrder, PG8_ALIGN, PG8_SP2>(F.lds, D, S, E, F.tid);
        }
        SEAM(P + 5);
        if (IN(P + 6)) { ArgsP ap = get_args(); const Frame F = make_frame(ap, wave0); phase_router(F, ap, l, ap->out); }
        SEAM(P + 6);
        if (IN(P + 7)) { ArgsP ap = get_args(); const Frame F = make_frame(ap, wave0); phase_copy(F, ap, l, ap->out); }
        SEAM(P + 7);
        if (IN(P + 8)) {
            ArgsP ap = get_args(); const Frame F = make_frame(ap, wave0);
            build_tiles(F, l);
            pg8::ExpertOrder S; S.tile_e = (const LAS int*)(F.lds + LC_TILEE); S.ntiles = __builtin_amdgcn_readfirstlane(*(const LAS int*)(F.lds + LC_TBASE + 4 * NE)); S.NPN = 2; S.G = F.G; S.c = (int)blockIdx.x;
            S.A = (const char*)(F.ws + WS_XS); S.B = (const char*)(F.ws + WS_WGU); S.a_tile = (size_t)256 * D * 2; S.b_exp = (size_t)512 * D * 2; S.b_pn = (size_t)256 * D * 2;
            EpiGU E{(bf16*)(F.ws + WS_H)};
            pg8::gemm_phase<EpiGU, pg8::ExpertOrder, PG8_ALIGN, PG8_SP2>(F.lds, D, S, E, F.tid);
        }
        SEAM(P + 8);
        if (IN(P + 9)) {
            ArgsP ap = get_args(); const Frame F = make_frame(ap, wave0);
            build_tiles(F, l);
            pg8::ExpertOrder S; S.tile_e = (const LAS int*)(F.lds + LC_TILEE); S.ntiles = __builtin_amdgcn_readfirstlane(*(const LAS int*)(F.lds + LC_TBASE + 4 * NE)); S.NPN = 4; S.G = F.G; S.c = (int)blockIdx.x;
            S.A = (const char*)(F.ws + WS_H); S.B = (const char*)(F.ws + WS_WD); S.a_tile = (size_t)256 * DE * 2; S.b_exp = (size_t)D * DE * 2; S.b_pn = (size_t)256 * DE * 2;
            EpiDown E{(const float*)(F.ws + WS_SW), (bf16*)(F.ws + WS_Y)};
            pg8::gemm_phase<EpiDown, pg8::ExpertOrder, PG8_ALIGN, PG8_SP2>(F.lds, DE, S, E, F.tid);
        }
        SEAM(P + 9);
        if (IN(P + 10)) { ArgsP ap = get_args(); const Frame F = make_frame(ap, wave0); phase_final(F, ap->out, l + 1 < DEPTH); }
        if (l + 1 < DEPTH) { if (IN(P + 10) && IN(P + PH_PER_LAYER)) GRID_BAR(); }
    }
#undef IN
#undef SEAM
}

extern "C" void kernel_launch(void* const* d_in, const int* in_sizes, int n_in, void* d_out, int out_size, void* d_ws, size_t ws_size, hipStream_t stream) {
    static int grid = 0;
    if (grid == 0) {
        if (n_in != 20 || in_sizes[0] != T * D || out_size != T * D || ws_size < WS_END) { fprintf(stderr, "kernel_launch: unexpected shapes (n_in %d, in0 %d, out %d, ws %zu); nothing launched\n", n_in, n_in > 0 ? in_sizes[0] : -1, out_size, ws_size); grid = -1; return; }
        int dev = 0, cus = 0;
        if (hipGetDevice(&dev) != hipSuccess || hipDeviceGetAttribute(&cus, hipDeviceAttributeMultiprocessorCount, dev) != hipSuccess) { grid = -1; return; }
        if (hipFuncSetAttribute((const void*)fwd_kernel, hipFuncAttributeMaxDynamicSharedMemorySize, LDS_BYTES) != hipSuccess) { fprintf(stderr, "kernel_launch: hipFuncSetAttribute failed\n"); grid = -1; return; }
        grid = cus;
    }
    if (grid < 0) return;
    (void)hipMemsetAsync((char*)d_ws + WS_CTL, 0, CTL_ZERO_BYTES, stream);
    Args a{};
    for (int i = 0; i < 20; ++i) a.in[i] = (const float*)d_in[i];
    a.out = (float*)d_out; a.ws = (unsigned char*)d_ws;
#if MK_ONE_LAUNCH
    a.ph_lo = 0; a.ph_hi = NPH;
    hipLaunchKernelGGL(fwd_kernel, dim3(grid), dim3(512), LDS_BYTES, stream, a);
#else
    for (int l = 0; l < DEPTH; ++l)
        for (int p = 0; p <= 10; ++p) { a.ph_lo = l * PH_PER_LAYER + p; a.ph_hi = a.ph_lo + 1; hipLaunchKernelGGL(fwd_kernel, dim3(grid), dim3(512), LDS_BYTES, stream, a); }
#endif
}
```

```cpp
#include <hip/hip_runtime.h>
#include <cstdio>
#include <cstdint>

#ifndef MK_ONE_LAUNCH
#define MK_ONE_LAUNCH 1
#endif

#define LAS __attribute__((address_space(3)))
#define GAS __attribute__((address_space(1)))
typedef unsigned short bf16;
typedef short bf16x8 __attribute__((ext_vector_type(8)));
typedef float f32x4 __attribute__((ext_vector_type(4)));
typedef float f32x2 __attribute__((ext_vector_type(2)));
typedef unsigned u32x4 __attribute__((ext_vector_type(4)));
typedef unsigned u32x2 __attribute__((ext_vector_type(2)));

constexpr int T = 32768, D = 1024, SEQ = 2048, DEPTH = 2;
constexpr int IN_COLS = 5136, NIN = 5376;
constexpr int NE = 32, DE = 256;
constexpr int MAXTILES = 288;
constexpr float EPS = 1e-6f, LOG2E = 1.4426950408889634f;

namespace pg8 {
constexpr int BM = 256, BK = 64, HALF = 128, HTB = HALF * BK * 2  , STAGE_BYTES = 8 * HTB, NXCD = 8, WGM = 8;
__host__ __device__ __forceinline__ int lds_byte(int r, int c) { const int st = (r >> 4) * 2 + (c >> 5), rr = r & 15, cc = c & 31, ob = rr * 64 + cc * 2; return st * 1024 + (ob ^ (((ob >> 9) & 1) << 5)); }
__host__ __device__ __forceinline__ void stage_rc(int b, int& R, int& C) { const int st = b / 1024, sb = b % 1024, swz = sb ^ (((sb >> 9) & 1) << 5); R = (st >> 1) * 16 + swz / 64; C = (st & 1) * 32 + (swz % 64) / 2; }
__host__ __device__ __forceinline__ int perm32(int rho) { const int n = rho >> 4, i = rho & 15; return 8 * (i >> 2) + 4 * n + (i & 3); }

struct Unit { int pm, pn; const char* A; const char* B; };

struct DenseOrder {
    int nM, nN, nwg, G, c; const char* A; const char* Bt; size_t tstep;
    __device__ void init(int M, int N, int K, int G_, int c_, const void* A_, const void* Bt_) { nM = M / BM; nN = N / BM; nwg = nM * nN; G = G_; c = c_; A = (const char*)A_; Bt = (const char*)Bt_; tstep = (size_t)BM * K * 2; }
    __device__ bool next(int i, Unit& u) const {
        const long L = (long)i * G + c; if (L >= nwg) return false;
        int wgid = (int)L; { const int q = nwg / NXCD, r = nwg % NXCD, xcd = wgid % NXCD, off = wgid / NXCD; wgid = (xcd < r ? xcd * (q + 1) : r * (q + 1) + (xcd - r) * q) + off; }
        const int nig = WGM * nN, gid = wgid / nig, fm = gid * WGM, gsz = (nM - fm) < WGM ? (nM - fm) : WGM;
        u.pm = fm + ((wgid % nig) % gsz); u.pn = (wgid % nig) / gsz; u.A = A + (size_t)u.pm * tstep; u.B = Bt + (size_t)u.pn * tstep; return true;
    }
    __device__ __forceinline__ void a_ready(const Unit&) const {}
    __device__ __forceinline__ void done(const Unit&) const {}
};
struct ExpertOrder {
    const LAS int* tile_e; int ntiles, NPN, G, c; const char* A; const char* B; size_t a_tile, b_exp, b_pn;
    __device__ bool next(int i, Unit& u) const {
        const long L = (long)i * G + c; if (L >= (long)ntiles * NPN) return false;
        const int tile = (int)(L / NPN), pn = (int)(L % NPN); const int e = __builtin_amdgcn_readfirstlane(tile_e[tile]);
        u.pm = tile; u.pn = pn; u.A = A + (size_t)tile * a_tile; u.B = B + (size_t)e * b_exp + (size_t)pn * b_pn; return true;
    }
    __device__ __forceinline__ void a_ready(const Unit&) const {}
    __device__ __forceinline__ void done(const Unit&) const {}
};

__device__ __forceinline__ unsigned cvt_pk_bf16(float lo, float hi) { unsigned r; asm volatile("v_cvt_pk_bf16_f32 %0, %1, %2" : "=v"(r) : "v"(lo), "v"(hi)); return r; }

template <class Epi, class Sched, bool ALIGN_EPI = false, bool SP2 = false>
__device__ __forceinline__ void gemm_phase(LAS unsigned char* lds, const int K, const Sched& S, const Epi& E, int tid_) {
    asm volatile("" : "+v"(tid_));
    const int tid = tid_, wid = __builtin_amdgcn_readfirstlane(tid >> 6), lane = tid & 63, wr = wid >> 2, wc = wid & 3, fr = lane & 15, fq = lane >> 4;
    const int nt = K / BK;
    unsigned voffA[2], voffB[2];
#pragma unroll
    for (int i = 0; i < 2; ++i) { int R, C; stage_rc(tid * 16 + i * 8192, R, C); const int Rb = Epi::PERM ? ((R & ~31) + perm32(R & 31)) : R;
        voffA[i] = (unsigned)(R * K + C) * 2u; voffB[i] = (unsigned)(Rb * K + C) * 2u; }
    const size_t kstep = (size_t)(BK * 2);
    const size_t hstep = (size_t)HALF * K * 2;
    const unsigned ldsw = (unsigned)wid * 1024u;
    const int aoff = lds_byte(wr * 64 + fr, fq * 8), boff = lds_byte(wc * 32 + fr, fq * 8);
#define PG8_SA(b, h) (((b) * 2 + (h)) * HTB)
#define PG8_SB(b, h) ((4 + (b) * 2 + (h)) * HTB)
#define PG8_STAGE(bufoff, gbase, voff) do { _Pragma("unroll") for (int _i = 0; _i < 2; ++_i) \
        __builtin_amdgcn_global_load_lds((const unsigned*)((const char*)(gbase) + (voff)[_i]), (LAS unsigned*)(lds + (bufoff) + ldsw + _i * 8192), 16, 0, 0); } while (0)
#define PG8_LDA(dst, b, h) do { _Pragma("unroll") for (int m = 0; m < 4; ++m) _Pragma("unroll") for (int k = 0; k < 2; ++k) dst[m][k] = *(const LAS bf16x8*)(lds + PG8_SA(b, h) + aoff + m * 2048 + k * 1024); } while (0)
#define PG8_LDB(dst, b, h) do { _Pragma("unroll") for (int n = 0; n < 2; ++n) _Pragma("unroll") for (int k = 0; k < 2; ++k) dst[n][k] = *(const LAS bf16x8*)(lds + PG8_SB(b, h) + boff + n * 2048 + k * 1024); } while (0)
#define PG8_MMA(ai, bj, At, Bt) do { __builtin_amdgcn_s_setprio(1); _Pragma("unroll") for (int m = 0; m < 4; ++m) _Pragma("unroll") for (int n = 0; n < 2; ++n) _Pragma("unroll") for (int k = 0; k < 2; ++k) \
        acc[ai][bj][m][n] = __builtin_amdgcn_mfma_f32_16x16x32_bf16(Bt[n][k], At[m][k], acc[ai][bj][m][n], 0, 0, 0); __builtin_amdgcn_s_setprio(0); } while (0)
#define PG8_WAIT_V(n) asm volatile("s_waitcnt vmcnt(" #n ")" ::: "memory")
#define PG8_WAIT_L(n) asm volatile("s_waitcnt lgkmcnt(" #n ")" ::: "memory")
#define PG8_BAR __builtin_amdgcn_s_barrier()
#define PG8_SCHED __builtin_amdgcn_sched_barrier(0)
    Unit cur, nxt; int ui = 0;
    if (!S.next(0, cur)) return;
    f32x4 acc[2][2][4][2];
#pragma unroll
    for (int a = 0; a < 2; ++a)
#pragma unroll
        for (int b = 0; b < 2; ++b)
#pragma unroll
            for (int m = 0; m < 4; ++m)
#pragma unroll
                for (int n = 0; n < 2; ++n) acc[a][b][m][n] = (f32x4){0.f, 0.f, 0.f, 0.f};
    bf16x8 At[4][2], B0[2][2], B1[2][2];
    const char* cA = cur.A; const char* cB = cur.B;
    S.a_ready(cur);
    if constexpr (SP2) {
        PG8_STAGE(PG8_SB(0, 0), cB, voffB); PG8_STAGE(PG8_SB(0, 1), cB + hstep, voffB); PG8_STAGE(PG8_SA(0, 0), cA, voffA); PG8_STAGE(PG8_SA(0, 1), cA + hstep, voffA);
        if (wr == 1) PG8_BAR;
        PG8_WAIT_V(2); PG8_BAR;
        PG8_STAGE(PG8_SB(1, 0), cB + kstep, voffB); PG8_STAGE(PG8_SA(1, 0), cA + kstep, voffA); PG8_STAGE(PG8_SB(1, 1), cB + hstep + kstep, voffB);
        PG8_WAIT_V(6); PG8_BAR;
    } else {
        PG8_STAGE(PG8_SB(0, 0), cB, voffB); PG8_STAGE(PG8_SA(0, 0), cA, voffA); PG8_STAGE(PG8_SB(0, 1), cB + hstep, voffB); PG8_STAGE(PG8_SA(0, 1), cA + hstep, voffA);
        if (wr == 1) PG8_BAR;
        PG8_WAIT_V(4); PG8_BAR;
        PG8_STAGE(PG8_SB(1, 0), cB + kstep, voffB); PG8_STAGE(PG8_SA(1, 0), cA + kstep, voffA); PG8_STAGE(PG8_SB(1, 1), cB + hstep + kstep, voffB);
        PG8_WAIT_V(6); PG8_BAR;
    }
    for (;;) {
        const bool has_next = S.next(ui + 1, nxt);
        const char* nA = has_next ? nxt.A : cA; const char* nB = has_next ? nxt.B : cB;
        for (int t = 0; t < nt; t += 2) {
            const bool last = (t == nt - 2);
            const char* a1 = cA + (size_t)(t + 1) * kstep;
            const char* a2 = last ? nA : cA + (size_t)(t + 2) * kstep; const char* b2 = last ? nB : cB + (size_t)(t + 2) * kstep;
            const char* a3 = a2 + kstep; const char* b3 = b2 + kstep;
            if (last && has_next) S.a_ready(nxt);
            if constexpr (SP2) {
            PG8_LDB(B0, 0, 0); PG8_LDB(B1, 0, 1); PG8_SCHED; PG8_LDA(At, 0, 0); PG8_STAGE(PG8_SA(1, 1), a1 + hstep, voffA);
            PG8_WAIT_V(8); PG8_WAIT_L(0); PG8_BAR; PG8_MMA(0, 0, At, B0); PG8_MMA(0, 1, At, B1); PG8_BAR; PG8_SCHED;
            PG8_LDA(At, 0, 1); PG8_STAGE(PG8_SB(0, 0), b2, voffB); PG8_STAGE(PG8_SB(0, 1), b2 + hstep, voffB); PG8_STAGE(PG8_SA(0, 0), a2, voffA);
            PG8_WAIT_V(8); PG8_WAIT_L(0); PG8_BAR; PG8_MMA(1, 0, At, B0); PG8_MMA(1, 1, At, B1); PG8_BAR; PG8_SCHED;
            PG8_LDB(B0, 1, 0); PG8_LDB(B1, 1, 1); PG8_SCHED; PG8_LDA(At, 1, 0); PG8_STAGE(PG8_SA(0, 1), a2 + hstep, voffA);
            PG8_WAIT_V(8); PG8_WAIT_L(0); PG8_BAR; PG8_MMA(0, 0, At, B0); PG8_MMA(0, 1, At, B1); PG8_BAR; PG8_SCHED;
            PG8_LDA(At, 1, 1); PG8_STAGE(PG8_SB(1, 0), b3, voffB); PG8_STAGE(PG8_SB(1, 1), b3 + hstep, voffB); PG8_STAGE(PG8_SA(1, 0), a3, voffA);
            PG8_WAIT_V(8); PG8_WAIT_L(0); PG8_BAR; PG8_MMA(1, 0, At, B0); PG8_MMA(1, 1, At, B1); PG8_BAR; PG8_SCHED;
            } else {
            PG8_LDB(B0, 0, 0); PG8_SCHED; PG8_LDA(At, 0, 0); PG8_STAGE(PG8_SA(1, 1), a1 + hstep, voffA);
            PG8_WAIT_L(8); PG8_BAR; PG8_WAIT_L(0); PG8_MMA(0, 0, At, B0); PG8_BAR; PG8_SCHED;
            PG8_LDB(B1, 0, 1); PG8_STAGE(PG8_SB(0, 0), b2, voffB);
            PG8_BAR; PG8_WAIT_L(0); PG8_MMA(0, 1, At, B1); PG8_BAR;
            PG8_LDA(At, 0, 1); PG8_STAGE(PG8_SA(0, 0), a2, voffA);
            PG8_BAR; PG8_WAIT_L(0); PG8_MMA(1, 0, At, B0); PG8_BAR; PG8_SCHED;
            PG8_STAGE(PG8_SB(0, 1), b2 + hstep, voffB);
            PG8_WAIT_V(6); PG8_BAR; PG8_MMA(1, 1, At, B1); PG8_BAR;
            PG8_LDB(B0, 1, 0); PG8_SCHED; PG8_LDA(At, 1, 0); PG8_STAGE(PG8_SA(0, 1), a2 + hstep, voffA);
            PG8_WAIT_L(8); PG8_BAR; PG8_WAIT_L(0); PG8_MMA(0, 0, At, B0); PG8_BAR; PG8_SCHED;
            PG8_LDB(B1, 1, 1); PG8_STAGE(PG8_SB(1, 0), b3, voffB);
            PG8_BAR; PG8_WAIT_L(0); PG8_MMA(0, 1, At, B1); PG8_BAR;
            PG8_LDA(At, 1, 1); PG8_STAGE(PG8_SA(1, 0), a3, voffA);
            PG8_BAR; PG8_WAIT_L(0); PG8_MMA(1, 0, At, B0); PG8_BAR; PG8_SCHED;
            PG8_STAGE(PG8_SB(1, 1), b3 + hstep, voffB);
            PG8_WAIT_V(6); PG8_BAR; PG8_MMA(1, 1, At, B1); PG8_BAR;
            }
        }
        if constexpr (ALIGN_EPI) { if (wr == 0) PG8_BAR; }
        E(acc, cur, wr, wc, fr, fq); S.done(cur);
        if (!has_next) break;
#pragma unroll
        for (int a = 0; a < 2; ++a)
#pragma unroll
            for (int b = 0; b < 2; ++b)
#pragma unroll
                for (int m = 0; m < 4; ++m)
#pragma unroll
                    for (int n = 0; n < 2; ++n) acc[a][b][m][n] = (f32x4){0.f, 0.f, 0.f, 0.f};
        cur = nxt; cA = nA; cB = nB; ++ui;
        if constexpr (ALIGN_EPI) { if (wr == 1) PG8_BAR; }
    }
    PG8_WAIT_V(0);
    if constexpr (!ALIGN_EPI) { if (wr == 0) PG8_BAR; }
    PG8_BAR;
#undef PG8_SA
#undef PG8_SB
#undef PG8_STAGE
#undef PG8_LDA
#undef PG8_LDB
#undef PG8_MMA
#undef PG8_WAIT_V
#undef PG8_WAIT_L
#undef PG8_BAR
#undef PG8_SCHED
}
}

#define PG8_SP2 true
#define PG8_ALIGN true

constexpr size_t MiB = 1u << 20;
constexpr size_t WS_CTL = 0, CTL_ZERO_BYTES = 1 * MiB;
constexpr size_t WS_WIN = 1 * MiB;
constexpr size_t WS_WR = WS_WIN + (size_t)NIN * D * 2;
constexpr size_t WS_PA = 12 * MiB, WS_PB = 13 * MiB, WS_WOUT = 14 * MiB, WS_WGU = 16 * MiB, WS_WD = 48 * MiB;
constexpr size_t WS_XB = 64 * MiB;
constexpr size_t WS_YA = 64 * MiB, WS_YB = 96 * MiB;
constexpr size_t WS_SMALL = 128 * MiB;
constexpr size_t WS_RS1 = WS_SMALL, WS_RS2 = WS_SMALL + 128 * 1024, WS_TREC = WS_SMALL + 256 * 1024, WS_TW = WS_SMALL + 512 * 1024, WS_TSLOT = WS_SMALL + 768 * 1024, WS_SW = WS_SMALL + 1024 * 1024;
constexpr size_t WS_Q = 130 * MiB, WS_K = 162 * MiB, WS_V = 194 * MiB, WS_BQ = 226 * MiB, WS_BK = 242 * MiB, WS_BV = 258 * MiB, WS_BR = 290 * MiB, WS_LA = 322 * MiB, WS_R = 354 * MiB, WS_GB = 418 * MiB;
constexpr size_t WS_TMP = 130 * MiB, WS_MRG = 194 * MiB;
constexpr size_t WS_XS = 130 * MiB, WS_H = 274 * MiB, WS_Y = 310 * MiB;
constexpr size_t WS_END = 482 * MiB;
constexpr int CW_TMO = 0, CW_CODE = 1, CW_BAR = 4096, CW_GCNT = 8192;

constexpr int SCR_BYTES = 155648;
constexpr int LC_OFF = SCR_BYTES;
constexpr int LC_MISC = LC_OFF, LC_TBASE = LC_OFF + 128, LC_TILEE = LC_OFF + 512, LC_LCNT = LC_OFF + 1792, LC_LBASE = LC_OFF + 1920, LC_REC = LC_OFF + 2048, LC_RECW = LC_OFF + 3072;
constexpr int LDS_BYTES = 163840;

#define RLX_AGENT __ATOMIC_RELAXED, __HIP_MEMORY_SCOPE_AGENT
#define LDS_WAIT() asm volatile("s_waitcnt lgkmcnt(0)" ::: "memory")
__device__ __forceinline__ unsigned f2bf(float f) { unsigned u = __builtin_bit_cast(unsigned, f); return (u + 0x7fffu + ((u >> 16) & 1u)) >> 16; }
__device__ __forceinline__ unsigned pk2(float lo, float hi) { return f2bf(lo) | (f2bf(hi) << 16); }
__device__ __forceinline__ float bflo(unsigned w) { return __uint_as_float(w << 16); }
__device__ __forceinline__ float bfhi(unsigned w) { return __uint_as_float(w & 0xffff0000u); }
__device__ __forceinline__ float bf2f(bf16 b) { return __uint_as_float(((unsigned)b) << 16); }
__device__ __forceinline__ float wave_sum(float v) {
#pragma unroll
    for (int o = 1; o < 64; o <<= 1) v += __shfl_xor(v, o);
    return v;
}
__device__ __forceinline__ float rdlane(float v, int i) { return __uint_as_float((unsigned)__builtin_amdgcn_readlane((int)__float_as_uint(v), i)); }
__device__ __forceinline__ float wave_max(float v) {
#pragma unroll
    for (int o = 1; o < 64; o <<= 1) v = fmaxf(v, __shfl_xor(v, o));
    return v;
}

#define XB_TMO      128
#define XB_XCNT(j)  (256  + 64 * (j))
#define XB_XSUB(j)  (1280 + 64 * (j))
#define XB_XGEN(j)  (2304 + 64 * (j))
#define XB_TOP      3328
#define XB_TOPGEN   3392
#define XCD_BAR_WORDS 3456
#define XB_SPIN_CAP (1u << 18)
__device__ __forceinline__ unsigned xb_ld(unsigned* p)              { return __hip_atomic_load(p, __ATOMIC_RELAXED, __HIP_MEMORY_SCOPE_AGENT); }
__device__ __forceinline__ unsigned xb_add(unsigned* p, unsigned v) { return __hip_atomic_fetch_add(p, v, __ATOMIC_RELAXED, __HIP_MEMORY_SCOPE_AGENT); }
__device__ __forceinline__ unsigned xb_xcc_id() { return (unsigned)__builtin_amdgcn_s_getreg((3 << 11) | 20) & 0xFu; }
#define XB_SPIN(cond, bar) do { unsigned _sp = 0; while (cond) { __builtin_amdgcn_s_sleep(1); \
    if ((++_sp & 255u) == 0u) { if (xb_ld(&(bar)[XB_TMO])) break; if (_sp > XB_SPIN_CAP) { atomicAdd(&(bar)[XB_TMO], 1u); break; } } } } while (0)
struct XcdBarrier { unsigned* bar; unsigned x; volatile LAS unsigned* st; };
__device__ __forceinline__ XcdBarrier xcd_barrier_post(unsigned* bar, volatile LAS unsigned* st) {
    XcdBarrier b; b.bar = bar; b.x = xb_xcc_id(); b.st = st;
    if (threadIdx.x == 0) (void)xb_add(&bar[XB_XCNT(b.x)], 1u);
    return b;
}
__device__ __forceinline__ void xcd_barrier_complete(unsigned* bar, unsigned x, unsigned& nloc, unsigned& nx) {
    const unsigned G = gridDim.x * gridDim.y * gridDim.z;
    unsigned sum, cnt, mine, sp = 0u;
    for (;;) {
        sum = 0u; cnt = 0u; mine = 0u;
#pragma unroll
        for (unsigned j = 0; j < 16; ++j) { const unsigned c = xb_ld(&bar[XB_XCNT(j)]); sum += c; cnt += (c > 0u) ? 1u : 0u; mine = (j == x) ? c : mine; }
        if (sum == G) break;
        __builtin_amdgcn_s_sleep(1);
        if ((++sp & 255u) == 0u) { if (xb_ld(&bar[XB_TMO])) break; if (sp > XB_SPIN_CAP) { atomicAdd(&bar[XB_TMO], 1u); break; } }
    }
    nloc = mine > 0u ? mine : 1u; nx = cnt > 0u ? cnt : 1u;
}
__device__ __forceinline__ void xcd_barrier(const XcdBarrier& b) {
    asm volatile("s_waitcnt vmcnt(0)" ::: "memory");
    __syncthreads();
    if (threadIdx.x == 0) {
        unsigned* bar = b.bar;
        __builtin_amdgcn_s_waitcnt(0);
        unsigned nloc = b.st[0], nx = b.st[1];
        if (nloc == 0u) { xcd_barrier_complete(bar, b.x, nloc, nx); b.st[0] = nloc; b.st[1] = nx; }
        const unsigned old = xb_add(&bar[XB_XSUB(b.x)], 1u);
        const unsigned gen = old / nloc;
        if (old + 1u == (gen + 1u) * nloc) {
            __builtin_amdgcn_fence(__ATOMIC_RELEASE, "agent");
            asm volatile("s_waitcnt vmcnt(0)" ::: "memory");
            const unsigned og = xb_add(&bar[XB_TOP], 1u);
            const unsigned tg = og / nx;
            if (og + 1u == (tg + 1u) * nx) xb_add(&bar[XB_TOPGEN], 1u);
            else XB_SPIN(xb_ld(&bar[XB_TOPGEN]) == tg, bar);
            __builtin_amdgcn_fence(__ATOMIC_ACQUIRE, "agent");
            xb_add(&bar[XB_XGEN(b.x)], 1u);
            asm volatile("s_waitcnt vmcnt(0)" ::: "memory");
        } else {
            XB_SPIN(xb_ld(&bar[XB_XGEN(b.x)]) == gen, bar);
            __builtin_amdgcn_fence(__ATOMIC_ACQUIRE, "agent");
            asm volatile("s_waitcnt vmcnt(0)" ::: "memory");
        }
    }
    __syncthreads();
}

struct Args { const float* in[20]; float* out; unsigned char* ws; int ph_lo, ph_hi; };
typedef const __attribute__((address_space(4))) Args* ArgsP;
struct Frame {
    LAS unsigned char* lds; unsigned* ctl; unsigned char* ws;
    int tid, lane, wave, vcu, G;
};
__device__ __forceinline__ ArgsP get_args() { ArgsP p = (ArgsP)__builtin_amdgcn_kernarg_segment_ptr(); asm volatile("" : "+s"(p)); return p; }
__device__ __forceinline__ Frame make_frame(ArgsP ap, int wave0) {
    extern __shared__ __attribute__((aligned(16))) unsigned char lds_raw[];
    Frame F; F.lds = (LAS unsigned char*)lds_raw; F.ws = ap->ws; F.ctl = (unsigned*)(F.ws + WS_CTL);
    unsigned z = 0u; asm volatile("" : "+v"(z));
    int t = wave0 * 64 + (int)__builtin_amdgcn_mbcnt_hi(~0u, __builtin_amdgcn_mbcnt_lo(~0u, z)); asm volatile("" : "+v"(t));
    F.tid = t; F.lane = t & 63; F.wave = __builtin_amdgcn_readfirstlane(t >> 6);
    F.G = gridDim.x; { const int bx = blockIdx.x; F.vcu = (F.G % 8 == 0) ? (bx % 8) * (F.G / 8) + bx / 8 : bx; }
    return F;
}

using pg8::cvt_pk_bf16;
__device__ __forceinline__ u32x4 pack8(f32x4 a, f32x4 b) { u32x4 w; w.x = cvt_pk_bf16(a[0], a[1]); w.y = cvt_pk_bf16(a[2], a[3]); w.z = cvt_pk_bf16(b[0], b[1]); w.w = cvt_pk_bf16(b[2], b[3]); return w; }
__device__ __forceinline__ void unpack8(u32x4 w, f32x4& a, f32x4& b) { a = (f32x4){bflo(w.x), bfhi(w.x), bflo(w.y), bfhi(w.y)}; b = (f32x4){bflo(w.z), bfhi(w.z), bflo(w.w), bfhi(w.w)}; }
__device__ __forceinline__ float sigmoidf_(float z) { return 1.0f / (1.0f + __expf(-z)); }

struct EpiIn {
    static constexpr bool PERM = true;
    const float* rowscale; bf16 *Q, *K, *V, *BQ, *BK, *BV, *BR, *R, *GB; float* LOGA; const float *qg, *kg, *lbias;
    __device__ __forceinline__ void operator()(const f32x4 (&acc)[2][2][4][2], const pg8::Unit& u, int wr, int wc, int fr, int fq) const {
        const int pn = u.pn, row0 = u.pm * 256 + wr * 64 + fr;
        if (pn < 4) {
            const bool isq = pn < 2; const int hh = 4 * (pn & 1) + wc;
            const float* g = (isq ? qg : kg) + hh * 64 + 8 * fq;
            f32x4 g0[2], g1[2];
#pragma unroll
            for (int bj = 0; bj < 2; ++bj) { g0[bj] = *(const f32x4*)(g + 32 * bj); g1[bj] = *(const f32x4*)(g + 32 * bj + 4); }
            const float sc = isq ? 0.125f * LOG2E : 1.0f; bf16* O = isq ? Q : K;
#pragma unroll
            for (int ai = 0; ai < 2; ++ai)
#pragma unroll
                for (int m = 0; m < 4; ++m) {
                    const int row = row0 + ai * 128 + m * 16; const float rs = rowscale[row];
                    f32x4 v[2][2]; float ss = 0.f;
#pragma unroll
                    for (int bj = 0; bj < 2; ++bj)
#pragma unroll
                        for (int n = 0; n < 2; ++n) { v[bj][n] = acc[ai][bj][m][n] * rs; const f32x4 q = v[bj][n] * v[bj][n]; ss += (q[0] + q[1]) + (q[2] + q[3]); }
                    ss += __shfl_xor(ss, 16); ss += __shfl_xor(ss, 32);
                    const float rn = rsqrtf(ss * (1.0f / 64.0f) + EPS) * sc;
#pragma unroll
                    for (int bj = 0; bj < 2; ++bj) *(u32x4*)(O + (size_t)row * 512 + hh * 64 + 32 * bj + 8 * fq) = pack8(v[bj][0] * g0[bj] * rn, v[bj][1] * g1[bj] * rn);
                }
        } else if (pn < 12) {
            bf16* O; int ld, cb; float sc = 1.0f; bool act = false;
            if (pn < 6) { O = V; ld = 512; cb = 256 * (pn - 4); }
            else if (pn == 6) { O = BQ; ld = 256; cb = 0; sc = 0.125f; }
            else if (pn == 7) { O = BK; ld = 256; cb = 0; }
            else if (pn < 10) { O = BV; ld = 512; cb = 256 * (pn - 8); }
            else { O = BR; ld = 512; cb = 256 * (pn - 10); act = true; }
#pragma unroll
            for (int ai = 0; ai < 2; ++ai)
#pragma unroll
                for (int m = 0; m < 4; ++m) {
                    const int row = row0 + ai * 128 + m * 16; const float rs = rowscale[row] * sc;
#pragma unroll
                    for (int bj = 0; bj < 2; ++bj) {
                        f32x4 a = acc[ai][bj][m][0] * rs, b = acc[ai][bj][m][1] * rs;
                        if (act) {
#pragma unroll
                            for (int e = 0; e < 4; ++e) { a[e] = a[e] * sigmoidf_(a[e]); b[e] = b[e] * sigmoidf_(b[e]); }
                        }
                        *(u32x4*)(O + (size_t)row * ld + cb + 64 * wc + 32 * bj + 8 * fq) = pack8(a, b);
                    }
                }
        } else if (pn == 12) {
            f32x4 b0[2], b1[2];
#pragma unroll
            for (int bj = 0; bj < 2; ++bj) { b0[bj] = *(const f32x4*)(lbias + 64 * wc + 32 * bj + 8 * fq); b1[bj] = *(const f32x4*)(lbias + 64 * wc + 32 * bj + 8 * fq + 4); }
            const int l15 = ((fq << 4) | 15);
#pragma unroll
            for (int ai = 0; ai < 2; ++ai)
#pragma unroll
                for (int bj = 0; bj < 2; ++bj)
#pragma unroll
                    for (int n = 0; n < 2; ++n) {
                        f32x4 v[4];
#pragma unroll
                        for (int m = 0; m < 4; ++m) { const float rs = rowscale[row0 + ai * 128 + m * 16];
                            f32x4 z = acc[ai][bj][m][n] * rs + (n ? b1[bj] : b0[bj]);
#pragma unroll
                            for (int e = 0; e < 4; ++e) z[e] = (fminf(z[e], 0.f) - __logf(1.0f + __expf(-fabsf(z[e])))) * 0.0625f;
                            v[m] = z; }
#pragma unroll
                        for (int e = 0; e < 4; ++e) {
                            float x[4];
#pragma unroll
                            for (int m = 0; m < 4; ++m) { float t = v[m][e];
                                t += __uint_as_float(__builtin_amdgcn_update_dpp(0, (int)__float_as_uint(t), 0x111, 0xf, 0xf, true));
                                t += __uint_as_float(__builtin_amdgcn_update_dpp(0, (int)__float_as_uint(t), 0x112, 0xf, 0xf, true));
                                t += __uint_as_float(__builtin_amdgcn_update_dpp(0, (int)__float_as_uint(t), 0x114, 0xf, 0xf, true));
                                t += __uint_as_float(__builtin_amdgcn_update_dpp(0, (int)__float_as_uint(t), 0x118, 0xf, 0xf, true));
                                x[m] = t; }
                            x[1] += __shfl(x[0], l15); x[2] += __shfl(x[1], l15); x[3] += __shfl(x[2], l15);
#pragma unroll
                            for (int m = 0; m < 4; ++m) v[m][e] = x[m];
                        }
#pragma unroll
                        for (int m = 0; m < 4; ++m) *(f32x4*)(LOGA + (size_t)(row0 + ai * 128 + m * 16) * 256 + 64 * wc + 32 * bj + 8 * fq + 4 * n) = v[m];
                    }
        } else {
            const int cb = 128 * (pn - 13) + 32 * wc + 8 * fq;
#pragma unroll
            for (int ai = 0; ai < 2; ++ai)
#pragma unroll
                for (int m = 0; m < 4; ++m) {
                    const int row = row0 + ai * 128 + m * 16; const float rs = rowscale[row];
                    f32x4 ra, rb_, ga, gb_;
#pragma unroll
                    for (int e = 0; e < 4; ++e) {
                        float za = fminf(fmaxf(acc[ai][0][m][0][e] * rs, -30.f), 30.f), zb = fminf(fmaxf(acc[ai][1][m][0][e] * rs, -30.f), 30.f);
                        float ea = __expf(-za), eb = __expf(-zb); ga[e] = 1.0f / (1.0f + eb); ra[e] = (1.0f + eb) / (1.0f + ea);
                        za = fminf(fmaxf(acc[ai][0][m][1][e] * rs, -30.f), 30.f); zb = fminf(fmaxf(acc[ai][1][m][1][e] * rs, -30.f), 30.f);
                        ea = __expf(-za); eb = __expf(-zb); gb_[e] = 1.0f / (1.0f + eb); rb_[e] = (1.0f + eb) / (1.0f + ea);
                    }
                    *(u32x4*)(R + (size_t)row * 1024 + cb) = pack8(ra, rb_);
                    *(u32x4*)(GB + (size_t)row * 1024 + cb) = pack8(ga, gb_);
                }
        }
    }
};
struct EpiTmp {
    static constexpr bool PERM = true;
    const bf16* R; bf16* TMP;
    __device__ __forceinline__ void operator()(const f32x4 (&acc)[2][2][4][2], const pg8::Unit& u, int wr, int wc, int fr, int fq) const {
        const int row0 = u.pm * 256 + wr * 64 + fr, col0 = u.pn * 256 + wc * 32 + 8 * fq;
#pragma unroll
        for (int ai = 0; ai < 2; ++ai)
#pragma unroll
            for (int m = 0; m < 4; ++m)
#pragma unroll
                for (int bj = 0; bj < 2; ++bj) {
                    const size_t off = (size_t)(row0 + ai * 128 + m * 16) * 1024 + col0 + bj * 128;
                    f32x4 ra, rb_; unpack8(*(const u32x4*)(R + off), ra, rb_);
                    *(u32x4*)(TMP + off) = pack8(acc[ai][bj][m][0] * ra, acc[ai][bj][m][1] * rb_);
                }
    }
};
struct EpiMrg {
    static constexpr bool PERM = true;
    const bf16* GB; const bf16* TMP; bf16* MRG;
    __device__ __forceinline__ void operator()(const f32x4 (&acc)[2][2][4][2], const pg8::Unit& u, int wr, int wc, int fr, int fq) const {
        const int row0 = u.pm * 256 + wr * 64 + fr, col0 = u.pn * 256 + wc * 32 + 8 * fq;
#pragma unroll
        for (int ai = 0; ai < 2; ++ai)
#pragma unroll
            for (int m = 0; m < 4; ++m)
#pragma unroll
                for (int bj = 0; bj < 2; ++bj) {
                    const size_t off = (size_t)(row0 + ai * 128 + m * 16) * 1024 + col0 + bj * 128;
                    f32x4 ga, gb_, ta, tb; unpack8(*(const u32x4*)(GB + off), ga, gb_); unpack8(*(const u32x4*)(TMP + off), ta, tb);
                    *(u32x4*)(MRG + off) = pack8((acc[ai][bj][m][0] + ta) * ga, (acc[ai][bj][m][1] + tb) * gb_);
                }
    }
};
struct EpiOut {
    static constexpr bool PERM = false;
    const float* xres; float* xnew;
    __device__ __forceinline__ void operator()(const f32x4 (&acc)[2][2][4][2], const pg8::Unit& u, int wr, int wc, int fr, int fq) const {
        const int row0 = u.pm * 256 + wr * 64 + fr, col0 = u.pn * 256 + wc * 32 + 4 * fq;
#pragma unroll
        for (int ai = 0; ai < 2; ++ai)
#pragma unroll
            for (int m = 0; m < 4; ++m) {
                const size_t off = (size_t)(row0 + ai * 128 + m * 16) * 1024 + col0;
#pragma unroll
                for (int bj = 0; bj < 2; ++bj)
#pragma unroll
                    for (int n = 0; n < 2; ++n) { const f32x4 xr = *(const f32x4*)(xres + off + bj * 128 + n * 16); *(f32x4*)(xnew + off + bj * 128 + n * 16) = xr + acc[ai][bj][m][n]; }
            }
    }
};
struct EpiGU {
    static constexpr bool PERM = true;
    bf16* H;
    __device__ __forceinline__ void operator()(const f32x4 (&acc)[2][2][4][2], const pg8::Unit& u, int wr, int wc, int fr, int fq) const {
        const int row0 = u.pm * 256 + wr * 64 + fr, col0 = u.pn * 128 + wc * 32 + 8 * fq;
#pragma unroll
        for (int ai = 0; ai < 2; ++ai)
#pragma unroll
            for (int m = 0; m < 4; ++m) {
                f32x4 a, b;
#pragma unroll
                for (int e = 0; e < 4; ++e) { const float g0 = acc[ai][0][m][0][e], g1 = acc[ai][0][m][1][e]; a[e] = g0 * sigmoidf_(g0) * acc[ai][1][m][0][e]; b[e] = g1 * sigmoidf_(g1) * acc[ai][1][m][1][e]; }
                *(u32x4*)(H + (size_t)(row0 + ai * 128 + m * 16) * 256 + col0) = pack8(a, b);
            }
    }
};
struct EpiDown {
    static constexpr bool PERM = true;
    const float* sw; bf16* Y;
    __device__ __forceinline__ void operator()(const f32x4 (&acc)[2][2][4][2], const pg8::Unit& u, int wr, int wc, int fr, int fq) const {
        const int row0 = u.pm * 256 + wr * 64 + fr, col0 = u.pn * 256 + wc * 32 + 8 * fq;
#pragma unroll
        for (int ai = 0; ai < 2; ++ai)
#pragma unroll
            for (int m = 0; m < 4; ++m) {
                const int row = row0 + ai * 128 + m * 16; const float w = sw[row];
#pragma unroll
                for (int bj = 0; bj < 2; ++bj) *(u32x4*)(Y + (size_t)row * 1024 + col0 + bj * 128) = pack8(acc[ai][bj][m][0] * w, acc[ai][bj][m][1] * w);
            }
    }
};

__device__ __forceinline__ void cvt_item(const float* src, int ldn, const float* kscale, bf16* dst, int Kd, int drow0, int k0, LAS float* scr, int lane) {
#pragma unroll 8
    for (int i = 0; i < 32; ++i) { const int kk = 2 * i + (lane >> 5); float v = src[(size_t)(k0 + kk) * ldn + (lane & 31)]; if (kscale) v *= kscale[k0 + kk]; scr[kk * 33 + (lane & 31)] = v; }
    LDS_WAIT(); asm volatile("" ::: "memory");
    const int c = lane & 7;
#pragma unroll
    for (int j = 0; j < 4; ++j) { const int n = (lane >> 3) + 8 * j; const LAS float* s = scr + (8 * c) * 33 + n;
        u32x4 o; o.x = pk2(s[0 * 33], s[1 * 33]); o.y = pk2(s[2 * 33], s[3 * 33]); o.z = pk2(s[4 * 33], s[5 * 33]); o.w = pk2(s[6 * 33], s[7 * 33]);
        *(u32x4*)(dst + (size_t)(drow0 + n) * Kd + k0 + 8 * c) = o; }
    LDS_WAIT(); asm volatile("" ::: "memory");
}
__device__ __forceinline__ void cvt_item_lr(const float* win, const float* gup, int c0, const float* kscale, bf16* dst, int drow0, int k0, LAS float* scr, int lane) {
    float gu[16];
#pragma unroll
    for (int r = 0; r < 16; ++r) gu[r] = gup[r * 256 + c0 + (lane & 31)];
#pragma unroll 4
    for (int i = 0; i < 32; ++i) { const int kk = 2 * i + (lane >> 5); const float* wr_ = win + (size_t)(k0 + kk) * IN_COLS + 3072; float v = 0.f;
#pragma unroll
        for (int r = 0; r < 16; ++r) v += wr_[r] * gu[r];
        scr[kk * 33 + (lane & 31)] = v * kscale[k0 + kk]; }
    LDS_WAIT(); asm volatile("" ::: "memory");
    const int c = lane & 7;
#pragma unroll
    for (int j = 0; j < 4; ++j) { const int n = (lane >> 3) + 8 * j; const LAS float* s = scr + (8 * c) * 33 + n;
        u32x4 o; o.x = pk2(s[0 * 33], s[1 * 33]); o.y = pk2(s[2 * 33], s[3 * 33]); o.z = pk2(s[4 * 33], s[5 * 33]); o.w = pk2(s[6 * 33], s[7 * 33]);
        *(u32x4*)(dst + (size_t)(drow0 + n) * D + k0 + 8 * c) = o; }
    LDS_WAIT(); asm volatile("" ::: "memory");
}
__device__ __forceinline__ void phase_weights(const Frame& F, ArgsP a, int l) {
    LAS float* scr = (LAS float*)(F.lds + F.wave * 16384);
    const int gw = F.vcu * 8 + F.wave, NGW = F.G * 8, lane = F.lane;
    const float* win = a->in[2] + (size_t)l * D * IN_COLS; const float* gmix = a->in[1] + l * D; const float* gup = a->in[6] + l * 16 * 256;
    bf16* WIN = (bf16*)(F.ws + WS_WIN); bf16* PA = (bf16*)(F.ws + WS_PA); bf16* PB = (bf16*)(F.ws + WS_PB); bf16* WOUT = (bf16*)(F.ws + WS_WOUT); bf16* WGU = (bf16*)(F.ws + WS_WGU); bf16* WD = (bf16*)(F.ws + WS_WD);
    constexpr int I0 = (NIN / 32) * 16, I1 = 32 * 8, I2 = 32 * 8, I3 = 32 * 16, I4 = NE * 16 * 16, I5 = NE * 32 * 4;
    for (int it = gw; it < I0 + I1 + I2 + I3 + I4 + I5; it += NGW) {
        int r = it;
        if (r < I0) { const int nb = r >> 4, kb = r & 15, P = nb * 32, pn = P >> 8, p = P & 255;
            if (pn == 12) { const int c0 = 64 * ((p >> 5) & 3) + 32 * (p >> 7); cvt_item_lr(win, gup, c0, gmix, WIN, P, kb * 64, scr, lane); }
            else { const int src = pn < 12 ? 256 * pn + 64 * ((p >> 5) & 3) + 32 * (p >> 7) : 3088 + 1024 * (p >> 7) + 128 * (pn - 13) + (p & 127);
                   cvt_item(win + src, IN_COLS, gmix, WIN, D, P, kb * 64, scr, lane); }
            continue; } r -= I0;
        if (r < I1) { const int nb = r >> 3, kb = r & 7; cvt_item(a->in[9] + (size_t)l * 512 * D + nb * 32, D, nullptr, PA, 512, nb * 32, kb * 64, scr, lane); continue; } r -= I1;
        if (r < I2) { const int nb = r >> 3, kb = r & 7; cvt_item(a->in[10] + (size_t)l * 512 * D + nb * 32, D, nullptr, PB, 512, nb * 32, kb * 64, scr, lane); continue; } r -= I2;
        if (r < I3) { const int nb = r >> 4, kb = r & 15; cvt_item(a->in[11] + (size_t)l * D * D + nb * 32, D, nullptr, WOUT, D, nb * 32, kb * 64, scr, lane); continue; } r -= I3;
        if (r < I4) { const int e = r >> 8, nb = (r >> 4) & 15, kb = r & 15, p0 = nb * 32; const int j0 = 128 * (p0 >> 8) + (p0 & 127);
            const float* src = ((p0 >> 7) & 1 ? a->in[18] : a->in[17]) + ((size_t)(l * NE + e) * D) * DE + j0;
            cvt_item(src, DE, nullptr, WGU + (size_t)e * 512 * D, D, p0, kb * 64, scr, lane); continue; } r -= I4;
        { const int e = r >> 7, nb = (r >> 2) & 31, kb = r & 3;
            cvt_item(a->in[19] + ((size_t)(l * NE + e) * DE) * D + nb * 32, D, nullptr, WD + (size_t)e * D * DE, DE, nb * 32, kb * 64, scr, lane); }
    }
    float* WR = (float*)(F.ws + WS_WR); const float* gf = a->in[12] + l * D; const float* wg = a->in[13] + (size_t)l * D * 4; const float* wrt = a->in[15] + (size_t)l * D * 32;
    for (int i = (F.vcu * 512 + F.tid); i < D * 36; i += F.G * 512) { const int k = i / 36, j = i % 36; WR[i] = gf[k] * (j < 4 ? wg[k * 4 + j] : wrt[k * 32 + j - 4]); }
}
__device__ __forceinline__ void phase_x_to_xb(const Frame& F, const float* x) {
    bf16* XB = (bf16*)(F.ws + WS_XB); float* RS = (float*)(F.ws + WS_RS1);
    const int gw = F.vcu * 8 + F.wave, NGW = F.G * 8;
    for (int m = gw; m < T; m += NGW) {
        const f32x4* xr = (const f32x4*)(x + (size_t)m * D) + F.lane; f32x4 v[4]; float s = 0.f;
#pragma unroll
        for (int j = 0; j < 4; ++j) { v[j] = xr[64 * j]; s += (v[j][0] * v[j][0] + v[j][1] * v[j][1]) + (v[j][2] * v[j][2] + v[j][3] * v[j][3]); }
        s = wave_sum(s);
        u32x2* o = (u32x2*)(XB + (size_t)m * D) + F.lane;
#pragma unroll
        for (int j = 0; j < 4; ++j) { u32x2 w; w.x = pk2(v[j][0], v[j][1]); w.y = pk2(v[j][2], v[j][3]); o[64 * j] = w; }
        if (F.lane == 0) RS[m] = rsqrtf(s * (1.0f / D) + EPS);
    }
}

__device__ __forceinline__ void phase_attn_naive(const Frame& F, ArgsP a, int l) {
    constexpr int KP = 136, VP = 128;
    LAS unsigned char* Ks = F.lds; LAS unsigned char* Vs = F.lds + 576 * KP;
    const bf16* Qb = (const bf16*)(F.ws + WS_Q); const bf16* Kb = (const bf16*)(F.ws + WS_K); const bf16* Vb = (const bf16*)(F.ws + WS_V); bf16* YA = (bf16*)(F.ws + WS_YA);
    const float* rb = a->in[5]; const int lane = F.lane;
    for (int u = F.vcu; u < 4096; u += F.G) {
        const int c = u & 31, h = (u >> 5) & 7, b = u >> 8, t0 = b * SEQ + c * 64;
        __syncthreads();
        for (int i = F.tid; i < 576 * 8; i += 512) { const int kk = i >> 3, ch = i & 7, jb = kk >> 6; u32x4 kv = (u32x4){0u, 0u, 0u, 0u}, vv = kv;
            if (c - 8 + jb >= 0) { const size_t off = (size_t)(t0 - 512 + kk) * 512 + h * 64 + ch * 8; kv = *(const u32x4*)(Kb + off); vv = *(const u32x4*)(Vb + off); }
            *(LAS u32x2*)(Ks + kk * KP + ch * 16) = (u32x2){kv.x, kv.y}; *(LAS u32x2*)(Ks + kk * KP + ch * 16 + 8) = (u32x2){kv.z, kv.w};
            *(LAS u32x4*)(Vs + kk * VP + ch * 16) = vv; }
        __syncthreads();
        const float mq = wave_max(fabsf(a->in[3][(l * 8 + h) * 64 + lane])), mk = wave_max(fabsf(a->in[4][(l * 8 + h) * 64 + lane]));
        float mb = 0.f; for (int i = lane; i < 257; i += 64) mb = fmaxf(mb, fabsf(rb[i * 8 + h])); mb = wave_max(mb);
        const float M2 = LOG2E * (8.0f * mq * mk + mb);
        for (int qq = 0; qq < 8; ++qq) {
            const int qi = 8 * F.wave + qq, t = t0 + qi;
            const float qv = bf2f(Qb[(size_t)t * 512 + h * 64 + lane]);
            float p[9]; float lsum = 0.f;
#pragma unroll
            for (int j = 0; j < 9; ++j) {
                float s = 0.f; const LAS unsigned char* kr = Ks + (64 * j + lane) * KP;
#pragma unroll
                for (int d4 = 0; d4 < 16; ++d4) { const u32x2 w = *(const LAS u32x2*)(kr + d4 * 8);
                    s += rdlane(qv, 4 * d4) * bflo(w.x) + rdlane(qv, 4 * d4 + 1) * bfhi(w.x) + rdlane(qv, 4 * d4 + 2) * bflo(w.y) + rdlane(qv, 4 * d4 + 3) * bfhi(w.y); }
                int idx = 64 * (8 - j) + qi - lane; idx = (idx > 128 ? 128 : idx) + 128;
                const float bias = rb[idx * 8 + h] * LOG2E;
                p[j] = (c - 8 + j >= 0) ? exp2f(s + bias - M2) : 0.f; lsum += p[j];
            }
            lsum = wave_sum(lsum);
            float o = 0.f;
#pragma unroll
            for (int j = 0; j < 9; ++j)
                for (int i = 0; i < 64; ++i) o += rdlane(p[j], i) * bf2f(*(const LAS bf16*)(Vs + (64 * j + i) * VP + lane * 2));
            YA[(size_t)t * 512 + h * 64 + lane] = (bf16)f2bf(o / lsum);
        }
    }
}


typedef float f32x16 __attribute__((ext_vector_type(16)));
typedef short s16x4 __attribute__((ext_vector_type(4)));
#define MFMA32(a, b, c) __builtin_amdgcn_mfma_f32_32x32x16_bf16((a), (b), (c), 0, 0, 0)
__device__ __forceinline__ unsigned cvtpk(float lo, float hi) { typedef float f2_ __attribute__((ext_vector_type(2))); typedef __bf16 b2_ __attribute__((ext_vector_type(2))); f2_ v = {lo, hi}; b2_ b = __builtin_convertvector(v, b2_); return __builtin_bit_cast(unsigned, b); }
__device__ __forceinline__ u32x4 pack8c(f32x4 a, f32x4 b) { u32x4 w; w.x = cvtpk(a[0], a[1]); w.y = cvtpk(a[2], a[3]); w.z = cvtpk(b[0], b[1]); w.w = cvtpk(b[2], b[3]); return w; }
__device__ __forceinline__ s16x4 tr_read(const LAS unsigned char* p) { return __builtin_amdgcn_ds_read_tr16_b64_v4i16((LAS s16x4*)p); }
__device__ __forceinline__ bf16x8 pack_step(const f32x16& x, int s) {
    u32x4 p; p.x = cvtpk(x[8 * s], x[8 * s + 1]); p.y = cvtpk(x[8 * s + 2], x[8 * s + 3]); p.z = cvtpk(x[8 * s + 4], x[8 * s + 5]); p.w = cvtpk(x[8 * s + 6], x[8 * s + 7]);
    return __builtin_bit_cast(bf16x8, p);
}
constexpr int ATT_K = 0, ATT_V = 16384, ATT_TBL = 32768;
__device__ __forceinline__ void attn_unit(const Frame& F, ArgsP a, int l, int u) {
    const int lane = F.lane, w = F.wave, r = lane & 31, hl = lane >> 5;
    const int ci = (w < 4) ? (w >> 1) : (3 - ((w - 4) >> 1));
    const int qh = w & 1;
    const int cq = u & 7, h = (u >> 3) & 7, b = u >> 6, c0 = 4 * cq, t0 = b * SEQ + c0 * 64;
    const bf16* Qb = (const bf16*)(F.ws + WS_Q); const bf16* Kb = (const bf16*)(F.ws + WS_K); const bf16* Vb = (const bf16*)(F.ws + WS_V); bf16* YA = (bf16*)(F.ws + WS_YA);
    LAS unsigned char* Ks = F.lds + ATT_K; LAS unsigned char* Vs = F.lds + ATT_V; LAS float* tbl = (LAS float*)(F.lds + ATT_TBL);
    const float* rb = a->in[5];
    const float mq = wave_max(fabsf(a->in[3][(l * 8 + h) * 64 + lane])), mk = wave_max(fabsf(a->in[4][(l * 8 + h) * 64 + lane]));
    float mb = 0.f; for (int i = lane; i < 257; i += 64) mb = fmaxf(mb, fabsf(rb[i * 8 + h])); mb = wave_max(mb);
    const float M2 = LOG2E * (8.0f * mq * mk + mb);
    __syncthreads();
    for (int i = F.tid; i < 257; i += 512) tbl[i] = rb[i * 8 + h] * LOG2E - M2;
    const int qrow = t0 + ci * 64 + qh * 32 + r;
    bf16x8 qf[4];
#pragma unroll
    for (int s = 0; s < 4; ++s) qf[s] = *(const bf16x8*)(Qb + (size_t)qrow * 512 + h * 64 + 16 * s + 8 * hl);
    const int jmin = (8 - c0) > 0 ? (8 - c0) : 0;
    const int key = F.tid >> 3, ch = F.tid & 7;
    const long g0 = (long)(t0 - 512 + key) * 512 + h * 64 + ch * 8;
    const int kst = key * 128 + ((ch ^ ((key >> 1) & 7)) << 4);
    const int vst = ((key >> 3) * 2 + (ch >> 2)) * 512 + (key & 7) * 64 + (ch & 3) * 16;
    u32x4 kreg = *(const u32x4*)(Kb + g0 + (long)jmin * 64 * 512), vreg = *(const u32x4*)(Vb + g0 + (long)jmin * 64 * 512);
    *(LAS u32x4*)(Ks + kst) = kreg; *(LAS u32x4*)(Vs + vst) = vreg;
    __syncthreads();
    const float cb = tbl[256];
    const int qi = 32 * qh + r;
    const int kro = r * 128, ksw = (r >> 1) & 7;
    const int g16 = lane >> 4, i16 = lane & 15;
    const int vro = (4 * (g16 >> 1) + (i16 >> 2)) * 64 + (16 * (g16 & 1) + 4 * (i16 & 3)) * 2;
    f32x16 o[2]; float lsum = 0.f;
#pragma unroll
    for (int i = 0; i < 16; ++i) { o[0][i] = 0.f; o[1][i] = 0.f; }
    for (int j = jmin; j < 12; ++j) {
        const int cur = (j - jmin) & 1;
        if (j + 1 < 12) { kreg = *(const u32x4*)(Kb + g0 + (long)(j + 1) * 64 * 512); vreg = *(const u32x4*)(Vb + g0 + (long)(j + 1) * 64 * 512); }
        if (j >= ci && j <= ci + 8) {
            const LAS unsigned char* Kt = Ks + cur * 8192; const LAS unsigned char* Vt = Vs + cur * 8192;
            f32x16 pr[2];
#pragma unroll
            for (int kh = 0; kh < 2; ++kh) {
                f32x16 acc;
#pragma unroll
                for (int i = 0; i < 16; ++i) acc[i] = 0.f;
#pragma unroll
                for (int s = 0; s < 4; ++s) { const bf16x8 kf = *(const LAS bf16x8*)(Kt + kh * 4096 + kro + (((2 * s + hl) ^ ksw) << 4)); acc = MFMA32(kf, qf[s], acc); }
                pr[kh] = acc;
            }
            const int jp = j - ci;
            if (jp <= 5) {
#pragma unroll
                for (int kh = 0; kh < 2; ++kh)
#pragma unroll
                    for (int i = 0; i < 16; ++i) { const float p = __builtin_amdgcn_exp2f(pr[kh][i] + cb); pr[kh][i] = p; lsum += p; }
            } else {
                const int base = 64 * (8 - jp) + qi - 4 * hl;
#pragma unroll
                for (int kh = 0; kh < 2; ++kh)
#pragma unroll
                    for (int i = 0; i < 16; ++i) { int d = base - 32 * kh - ((i & 3) + 8 * (i >> 2)); d = (d > 128 ? 128 : d) + 128;
                        const float p = __builtin_amdgcn_exp2f(pr[kh][i] + tbl[d]); pr[kh][i] = p; lsum += p; }
            }
#pragma unroll
            for (int s16 = 0; s16 < 4; ++s16) {
                const bf16x8 pb = pack_step(pr[s16 >> 1], s16 & 1);
#pragma unroll
                for (int dh = 0; dh < 2; ++dh) {
                    const s16x4 lo = tr_read(Vt + vro + dh * 512 + (2 * s16) * 1024), hi = tr_read(Vt + vro + dh * 512 + (2 * s16 + 1) * 1024);
                    const bf16x8 va = __builtin_shufflevector(lo, hi, 0, 1, 2, 3, 4, 5, 6, 7);
                    o[dh] = MFMA32(va, pb, o[dh]);
                }
            }
        }
        if (j + 1 < 12) { *(LAS u32x4*)(Ks + (cur ^ 1) * 8192 + kst) = kreg; *(LAS u32x4*)(Vs + (cur ^ 1) * 8192 + vst) = vreg; }
        __syncthreads();
    }
    lsum += __shfl_xor(lsum, 32);
    const float inv = 1.0f / lsum;
    bf16* yo = YA + (size_t)qrow * 512 + h * 64 + 4 * hl;
#pragma unroll
    for (int dh = 0; dh < 2; ++dh)
#pragma unroll
        for (int g = 0; g < 4; ++g) { u32x2 wv; wv.x = cvtpk(o[dh][4 * g] * inv, o[dh][4 * g + 1] * inv); wv.y = cvtpk(o[dh][4 * g + 2] * inv, o[dh][4 * g + 3] * inv); *(u32x2*)(yo + 32 * dh + 8 * g) = wv; }
}
__device__ __forceinline__ void phase_attn(const Frame& F, ArgsP a, int l) {
    for (int u = F.vcu; u < 1024; u += F.G) attn_unit(F, a, l, u);
}


constexpr int GL_QT = 0, GL_KH = 8704, GL_AT = 16896, GL_V = 25088, GL_D = 41472, GL_BUF = 41728, GL_SS = 2 * GL_BUF, GL_GN = GL_SS + 2048;
#define GL_BARRIER() do { asm volatile("s_waitcnt lgkmcnt(0)" ::: "memory"); __builtin_amdgcn_s_barrier(); asm volatile("" ::: "memory"); } while (0)
template <bool DIAG>
__device__ __forceinline__ void gla_prep_qk(LAS unsigned char* L, const bf16* BQ, const bf16* BK, const float* CB, int b, int h, int it, int jt, int lane_) {
    asm volatile("" : "+v"(lane_));
    const int r = lane_ & 31, hl = lane_ >> 5;
    u32x4 qraw[4], kraw[4]; f32x4 bq[4][2], bx[4][2];
    auto load = [&](int c) {
        const size_t tb_ = (size_t)b * SEQ + (size_t)c * 64; const size_t qo = (tb_ + 32 * it + r) * 256 + h * 64 + 8 * hl, ko = (tb_ + 32 * jt + r) * 256 + h * 64 + 8 * hl, xo = DIAG ? (tb_ + 63) * 256 + h * 64 + 8 * hl : ko;
#pragma unroll
        for (int s = 0; s < 4; ++s) { qraw[s] = *(const u32x4*)(BQ + qo + 16 * s); kraw[s] = *(const u32x4*)(BK + ko + 16 * s);
            bq[s][0] = *(const f32x4*)(CB + qo + 16 * s); bq[s][1] = *(const f32x4*)(CB + qo + 16 * s + 4); bx[s][0] = *(const f32x4*)(CB + xo + 16 * s); bx[s][1] = *(const f32x4*)(CB + xo + 16 * s + 4); }
    };
    auto prep = [&](int c) {
        LAS unsigned char* B_ = L + (c & 1) * GL_BUF; bf16x8 qt[4], kt[4];
#pragma unroll
        for (int s = 0; s < 4; ++s) {
            f32x4 q0, q1, k0, k1; unpack8(qraw[s], q0, q1); unpack8(kraw[s], k0, k1); f32x4 eq0, eq1, ek0, ek1;
#pragma unroll
            for (int e = 0; e < 4; ++e) { eq0[e] = __expf(bq[s][0][e]); eq1[e] = __expf(bq[s][1][e]); ek0[e] = __expf(DIAG ? -bq[s][0][e] : -bx[s][0][e]); ek1[e] = __expf(DIAG ? -bq[s][1][e] : -bx[s][1][e]); }
            const u32x4 qp = pack8c(q0 * eq0, q1 * eq1), kp = pack8c(k0 * ek0, k1 * ek1); qt[s] = __builtin_bit_cast(bf16x8, qp); kt[s] = __builtin_bit_cast(bf16x8, kp);
            if (DIAG) {
                f32x4 eh0, eh1;
#pragma unroll
                for (int e = 0; e < 4; ++e) { eh0[e] = __expf(bx[s][0][e] - bq[s][0][e]); eh1[e] = __expf(bx[s][1][e] - bq[s][1][e]); }
                const int t_ = 32 * it + r, dk_ = 16 * s + 8 * hl;
                *(LAS u32x2*)(B_ + GL_QT + t_ * 136 + dk_ * 2) = (u32x2){qp.x, qp.y}; *(LAS u32x2*)(B_ + GL_QT + t_ * 136 + dk_ * 2 + 8) = (u32x2){qp.z, qp.w};
                *(LAS u32x4*)(B_ + GL_KH + ((t_ >> 3) * 2 + (dk_ >> 5)) * 512 + (t_ & 7) * 64 + (dk_ & 31) * 2) = pack8c(k0 * eh0, k1 * eh1);
            }
        }
        f32x16 at_;
#pragma unroll
        for (int i = 0; i < 16; ++i) at_[i] = 0.f;
#pragma unroll
        for (int s = 0; s < 4; ++s) at_ = MFMA32(kt[s], qt[s], at_);
        const int i_ = 32 * it + r;
#pragma unroll
        for (int g = 0; g < 4; ++g) { float x0 = at_[4 * g], x1 = at_[4 * g + 1], x2 = at_[4 * g + 2], x3 = at_[4 * g + 3];
            if (DIAG) { const int j0 = 8 * g + 4 * hl; x0 = (r >= j0) ? x0 : 0.f; x1 = (r >= j0 + 1) ? x1 : 0.f; x2 = (r >= j0 + 2) ? x2 : 0.f; x3 = (r >= j0 + 3) ? x3 : 0.f; }
            *(LAS u32x2*)(B_ + GL_AT + i_ * 128 + (((4 * jt + g) ^ ((i_ >> 1) & 7)) << 4) + 8 * hl) = (u32x2){cvtpk(x0, x1), cvtpk(x2, x3)}; }
    };
    load(0); prep(0); load(1);
    GL_BARRIER();
    for (int c = 0; c < 32; ++c) {
        if (c + 1 < 32) { prep(c + 1); if (c + 2 < 32) load(c + 2); }
        GL_BARRIER();
    }
}
__device__ __forceinline__ void gla_prep_v(LAS unsigned char* L, const bf16* BV, const float* CB, int b, int h, int lane) {
    asm volatile("" : "+v"(lane));
    u32x4 vraw[16]; float draw;
    auto load = [&](int c) { const size_t tb_ = (size_t)b * SEQ + (size_t)c * 64;
#pragma unroll
        for (int k = 0; k < 16; ++k) { const int pi = lane + 64 * k; vraw[k] = *(const u32x4*)(BV + (tb_ + (pi >> 4)) * 512 + h * 128 + (pi & 15) * 8); }
        draw = CB[(tb_ + 63) * 256 + h * 64 + lane]; };
    auto prep = [&](int c) { LAS unsigned char* B_ = L + (c & 1) * GL_BUF;
#pragma unroll
        for (int k = 0; k < 16; ++k) { const int pi = lane + 64 * k, t_ = pi >> 4, c16 = pi & 15; *(LAS u32x4*)(B_ + GL_V + ((t_ >> 3) * 4 + (c16 >> 2)) * 512 + (t_ & 7) * 64 + (c16 & 3) * 16) = vraw[k]; }
        *(LAS float*)(B_ + GL_D + 4 * lane) = __expf(draw); };
    load(0); prep(0); load(1);
    GL_BARRIER();
    for (int c = 0; c < 32; ++c) {
        if (c + 1 < 32) { prep(c + 1); if (c + 2 < 32) load(c + 2); }
        GL_BARRIER();
    }
}
__device__ __forceinline__ void gla_state(LAS unsigned char* L, const bf16* BR, bf16* YB, int b, int h, int n, int lane) {
    asm volatile("" : "+v"(lane));
    const int r = lane & 31, hl = lane >> 5, g16 = lane >> 4, i16 = lane & 15;
    const int tro = (i16 >> 2) * 64 + (16 * (g16 & 1) + 4 * (i16 & 3)) * 2;
    f32x16 S[2], o[2]; u32x2 op[2][4], brp[2][4];
#pragma unroll
    for (int i = 0; i < 16; ++i) { S[0][i] = 0.f; S[1][i] = 0.f; }
    const size_t yo0 = ((size_t)b * SEQ + r) * 512 + h * 128 + 32 * n + 4 * hl;
    LAS float* SSb = (LAS float*)(L + GL_SS); const LAS float* GN = (const LAS float*)(L + GL_GN) + 32 * n + 4 * hl;
    GL_BARRIER();
    for (int c = 0; c <= 32; ++c) {
        if (c > 0) {
            const int par = (c - 1) & 1;
#pragma unroll
            for (int tt = 0; tt < 2; ++tt) { const int t_ = 32 * tt + r; const float tot = SSb[par * 256 + t_] + SSb[par * 256 + 64 + t_] + SSb[par * 256 + 128 + t_] + SSb[par * 256 + 192 + t_];
                const float rn = rsqrtf(tot * (1.0f / 128.0f) + EPS);
#pragma unroll
                for (int g = 0; g < 4; ++g) { const u32x2 rr = brp[tt][g], ov = op[tt][g]; const f32x4 gn = *(const LAS f32x4*)(GN + 8 * g);
                    u32x2 wv; wv.x = cvtpk(bflo(ov.x) * rn * gn[0] * bflo(rr.x), bfhi(ov.x) * rn * gn[1] * bfhi(rr.x)); wv.y = cvtpk(bflo(ov.y) * rn * gn[2] * bflo(rr.y), bfhi(ov.y) * rn * gn[3] * bfhi(rr.y));
                    *(u32x2*)(YB + yo0 + (size_t)(64 * (c - 1) + 32 * tt) * 512 + 8 * g) = wv; } }
        }
        if (c == 32) break;
        const LAS unsigned char* B_ = L + (c & 1) * GL_BUF;
#pragma unroll
        for (int tt = 0; tt < 2; ++tt)
#pragma unroll
            for (int g = 0; g < 4; ++g) brp[tt][g] = *(const u32x2*)(BR + yo0 + (size_t)(64 * c + 32 * tt) * 512 + 8 * g);
        bf16x8 sp[2][2];
#pragma unroll
        for (int dkt = 0; dkt < 2; ++dkt) { sp[dkt][0] = pack_step(S[dkt], 0); sp[dkt][1] = pack_step(S[dkt], 1); }
#pragma unroll
        for (int tt = 0; tt < 2; ++tt) {
            f32x16 acc;
#pragma unroll
            for (int i = 0; i < 16; ++i) acc[i] = 0.f;
#pragma unroll
            for (int dkt = 0; dkt < 2; ++dkt)
#pragma unroll
                for (int s = 0; s < 2; ++s) { const LAS unsigned char* qp_ = B_ + GL_QT + (32 * tt + r) * 136 + (32 * dkt + 16 * s + 4 * hl) * 2;
                    const u32x2 lo = *(const LAS u32x2*)qp_, hi = *(const LAS u32x2*)(qp_ + 16); const u32x4 qv = (u32x4){lo.x, lo.y, hi.x, hi.y};
                    acc = MFMA32(sp[dkt][s], __builtin_bit_cast(bf16x8, qv), acc); }
            o[tt] = acc;
        }
        bf16x8 vf[4];
#pragma unroll
        for (int s = 0; s < 4; ++s) { const LAS unsigned char* vp_ = B_ + GL_V + ((2 * s + hl) * 4 + n) * 512 + tro; const s16x4 lo = tr_read(vp_), hi = tr_read(vp_ + 256); vf[s] = __builtin_shufflevector(lo, hi, 0, 1, 2, 3, 4, 5, 6, 7); }
#pragma unroll
        for (int tt = 0; tt < 2; ++tt)
#pragma unroll
            for (int s = 0; s < 4; ++s) { if (tt == 0 && s >= 2) continue;
                const int i_ = 32 * tt + r; const bf16x8 af = *(const LAS bf16x8*)(B_ + GL_AT + i_ * 128 + (((2 * s + hl) ^ ((i_ >> 1) & 7)) << 4));
                o[tt] = MFMA32(vf[s], af, o[tt]); }
#pragma unroll
        for (int dkt = 0; dkt < 2; ++dkt) {
#pragma unroll
            for (int g = 0; g < 4; ++g) { const f32x4 d4 = *(const LAS f32x4*)(B_ + GL_D + (32 * dkt + 8 * g + 4 * hl) * 4);
                S[dkt][4 * g] *= d4[0]; S[dkt][4 * g + 1] *= d4[1]; S[dkt][4 * g + 2] *= d4[2]; S[dkt][4 * g + 3] *= d4[3]; }
#pragma unroll
            for (int s = 0; s < 4; ++s) { const LAS unsigned char* kp_ = B_ + GL_KH + ((2 * s + hl) * 2 + dkt) * 512 + tro; const s16x4 lo = tr_read(kp_), hi = tr_read(kp_ + 256);
                S[dkt] = MFMA32(__builtin_shufflevector(lo, hi, 0, 1, 2, 3, 4, 5, 6, 7), vf[s], S[dkt]); }
        }
#pragma unroll
        for (int tt = 0; tt < 2; ++tt) { float q = 0.f;
#pragma unroll
            for (int i = 0; i < 16; ++i) q += o[tt][i] * o[tt][i];
            q += __shfl_xor(q, 32);
            if (hl == 0) SSb[(c & 1) * 256 + n * 64 + 32 * tt + r] = q;
#pragma unroll
            for (int g = 0; g < 4; ++g) op[tt][g] = (u32x2){cvtpk(o[tt][4 * g], o[tt][4 * g + 1]), cvtpk(o[tt][4 * g + 2], o[tt][4 * g + 3])}; }
        GL_BARRIER();
    }
}
__device__ __forceinline__ void gla_unit(const Frame& F, ArgsP a, int l, int u) {
    const int lane = F.lane, w = __builtin_amdgcn_readfirstlane(F.wave), h = u & 3, b = u >> 2;
    const bf16* BQ = (const bf16*)(F.ws + WS_BQ); const bf16* BK = (const bf16*)(F.ws + WS_BK); const bf16* BV = (const bf16*)(F.ws + WS_BV); const bf16* BR = (const bf16*)(F.ws + WS_BR);
    const float* CB = (const float*)(F.ws + WS_LA); bf16* YB = (bf16*)(F.ws + WS_YB);
    __syncthreads();
    if (F.tid < 128) *(LAS float*)(F.lds + GL_GN + 4 * F.tid) = a->in[8][l * 512 + h * 128 + F.tid];
#ifndef GLA_ROLES
#define GLA_ROLES 31
#endif
    if (w == 4) { if (GLA_ROLES & 1) gla_prep_qk<true>(F.lds, BQ, BK, CB, b, h, 0, 0, lane); }
    else if (w == 5) { if (GLA_ROLES & 2) gla_prep_qk<true>(F.lds, BQ, BK, CB, b, h, 1, 1, lane); }
    else if (w == 6) { if (GLA_ROLES & 4) gla_prep_qk<false>(F.lds, BQ, BK, CB, b, h, 1, 0, lane); }
    else if (w == 7) { if (GLA_ROLES & 8) gla_prep_v(F.lds, BV, CB, b, h, lane); }
    else { if (GLA_ROLES & 16) gla_state(F.lds, BR, YB, b, h, w, lane); }
    __syncthreads();
}
__device__ __forceinline__ void phase_gla(const Frame& F, ArgsP a, int l) {
    const int bx = blockIdx.x;
    if ((bx & 3) == 0) for (int u = bx >> 2; u < 64; u += (F.G + 3) >> 2) gla_unit(F, a, l, u);
}

__device__ __forceinline__ void phase_gla_naive(const Frame& F, ArgsP a, int l) {
    LAS float* qs = (LAS float*)F.lds; LAS float* ks = qs + 4096; LAS float* as = ks + 4096; LAS float* vs = as + 4096; LAS float* os = vs + 8192;
    const bf16* BQ = (const bf16*)(F.ws + WS_BQ); const bf16* BK = (const bf16*)(F.ws + WS_BK); const bf16* BV = (const bf16*)(F.ws + WS_BV); const bf16* BR = (const bf16*)(F.ws + WS_BR);
    const float* LA = (const float*)(F.ws + WS_LA); bf16* YB = (bf16*)(F.ws + WS_YB); const float* og = a->in[8] + l * 512;
    const int j = F.tid >> 2, kq = F.tid & 3;
    for (int u = F.vcu; u < 64; u += F.G) {
        const int h = u & 3, b = u >> 2;
        float S[16];
#pragma unroll
        for (int i = 0; i < 16; ++i) S[i] = 0.f;
        for (int c = 0; c < 32; ++c) {
            const int tb = b * SEQ + c * 64;
            __syncthreads();
            for (int i = F.tid; i < 4096; i += 512) { const int t = i >> 6, dk = i & 63; const size_t off = (size_t)(tb + t) * 256 + h * 64 + dk;
                qs[i] = bf2f(BQ[off]); ks[i] = bf2f(BK[off]); as[i] = __expf(LA[off]); }
            for (int i = F.tid; i < 8192; i += 512) { const int t = i >> 7, dv = i & 127; vs[i] = bf2f(BV[(size_t)(tb + t) * 512 + h * 128 + dv]); }
            __syncthreads();
            for (int t = 0; t < 64; ++t) {
                const float v = vs[t * 128 + j]; float o = 0.f;
#pragma unroll
                for (int i4 = 0; i4 < 4; ++i4) {
                    const f32x4 a4 = *(const LAS f32x4*)(as + t * 64 + 16 * kq + 4 * i4), k4 = *(const LAS f32x4*)(ks + t * 64 + 16 * kq + 4 * i4), q4 = *(const LAS f32x4*)(qs + t * 64 + 16 * kq + 4 * i4);
#pragma unroll
                    for (int e = 0; e < 4; ++e) { S[4 * i4 + e] = a4[e] * S[4 * i4 + e] + k4[e] * v; o += q4[e] * S[4 * i4 + e]; }
                }
                o += __shfl_xor(o, 1); o += __shfl_xor(o, 2);
                if (kq == 0) os[t * 128 + j] = o;
            }
            __syncthreads();
            for (int r = 0; r < 8; ++r) { const int t = 8 * F.wave + r; const float o1 = os[t * 128 + F.lane], o2 = os[t * 128 + 64 + F.lane];
                const float rn = rsqrtf(wave_sum(o1 * o1 + o2 * o2) * (1.0f / 128.0f) + EPS);
                const size_t off = (size_t)(tb + t) * 512 + h * 128 + F.lane;
                YB[off] = (bf16)f2bf(o1 * rn * og[h * 128 + F.lane] * bf2f(BR[off])); YB[off + 64] = (bf16)f2bf(o2 * rn * og[h * 128 + 64 + F.lane] * bf2f(BR[off + 64])); }
        }
    }
}

__device__ __forceinline__ void phase_router(const Frame& F, ArgsP a, int l, const float* xnew) {
    LAS float* W = (LAS float*)F.lds;
    const float* WR = (const float*)(F.ws + WS_WR);
    for (int i = F.tid; i < D * 36 / 4; i += 512) ((LAS f32x4*)W)[i] = ((const f32x4*)WR)[i];
    volatile LAS unsigned* lcnt = (volatile LAS unsigned*)(F.lds + LC_LCNT); volatile LAS unsigned* lbase = (volatile LAS unsigned*)(F.lds + LC_LBASE);
    LAS unsigned* rec = (LAS unsigned*)(F.lds + LC_REC); LAS float* recw = (LAS float*)(F.lds + LC_RECW);
    unsigned* gcnt = F.ctl + CW_GCNT + l * 64; float* RS2 = (float*)(F.ws + WS_RS2); unsigned* TREC = (unsigned*)(F.ws + WS_TREC); float* TW = (float*)(F.ws + WS_TW);
    const float* bg = a->in[14] + l * 4; const float* br = a->in[16] + l * 32; const int lane = F.lane;
    for (int blk = F.vcu; blk < T / 128; blk += F.G) {
        __syncthreads();
        if (F.tid < 32) lcnt[F.tid] = 0u;
        __syncthreads();
        for (int r = 0; r < 16; ++r) {
            const int tl = F.wave * 16 + r, t = blk * 128 + tl;
            float acc[36];
#pragma unroll
            for (int jj = 0; jj < 36; ++jj) acc[jj] = 0.f;
            float ss = 0.f;
            for (int i = 0; i < 16; ++i) { const int k = lane + 64 * i; const float xv = xnew[(size_t)t * D + k]; ss += xv * xv; const LAS f32x4* wr_ = (const LAS f32x4*)(W + k * 36);
#pragma unroll
                for (int q = 0; q < 9; ++q) { const f32x4 w4 = wr_[q]; acc[4 * q] += xv * w4[0]; acc[4 * q + 1] += xv * w4[1]; acc[4 * q + 2] += xv * w4[2]; acc[4 * q + 3] += xv * w4[3]; } }
            ss = wave_sum(ss); const float rs = rsqrtf(ss * (1.0f / D) + EPS);
#pragma unroll
            for (int jj = 0; jj < 36; ++jj) acc[jj] = wave_sum(acc[jj]) * rs;
            float gl[4];
#pragma unroll
            for (int g = 0; g < 4; ++g) gl[g] = acc[g] + bg[g];
            int gi = 0; float gm = gl[0];
#pragma unroll
            for (int g = 1; g < 4; ++g) if (gl[g] > gm) { gm = gl[g]; gi = g; }
            float Z = 0.f;
#pragma unroll
            for (int g = 0; g < 4; ++g) Z += __expf(gl[g] - gm);
            const float gtop = 1.0f / Z;
            float el[8];
#pragma unroll
            for (int i = 0; i < 8; ++i) { const float v0 = acc[4 + i] + br[i], v1 = acc[12 + i] + br[8 + i], v2 = acc[20 + i] + br[16 + i], v3 = acc[28 + i] + br[24 + i]; el[i] = gi == 0 ? v0 : gi == 1 ? v1 : gi == 2 ? v2 : v3; }
            int i1 = 0; float m1 = el[0];
#pragma unroll
            for (int i = 1; i < 8; ++i) if (el[i] > m1) { m1 = el[i]; i1 = i; }
            int i2 = -1; float m2 = -3.0e38f;
#pragma unroll
            for (int i = 0; i < 8; ++i) if (i != i1 && el[i] > m2) { m2 = el[i]; i2 = i; }
            const float w1 = 1.0f / (1.0f + __expf(m2 - m1)), w2 = 1.0f - w1;
            if (lane == 0) {
                const int e1 = gi * 8 + i1, e2 = gi * 8 + i2;
                const unsigned p1 = __hip_atomic_fetch_add((LAS unsigned*)(F.lds + LC_LCNT) + e1, 1u, __ATOMIC_RELAXED, __HIP_MEMORY_SCOPE_WORKGROUP), p2 = __hip_atomic_fetch_add((LAS unsigned*)(F.lds + LC_LCNT) + e2, 1u, __ATOMIC_RELAXED, __HIP_MEMORY_SCOPE_WORKGROUP);
                rec[2 * tl] = ((unsigned)e1 << 16) | p1; rec[2 * tl + 1] = ((unsigned)e2 << 16) | p2; recw[2 * tl] = w1 * gtop; recw[2 * tl + 1] = w2 * gtop;
                RS2[t] = rs;
            }
        }
        __syncthreads();
        if (F.tid < 32) lbase[F.tid] = __hip_atomic_fetch_add(gcnt + F.tid, lcnt[F.tid], RLX_AGENT);
        __syncthreads();
        if (F.tid < 256) { const unsigned rc = rec[F.tid], e = rc >> 16; TREC[(size_t)blk * 256 + F.tid] = (e << 16) | ((rc & 0xffffu) + lbase[e]); TW[(size_t)blk * 256 + F.tid] = recw[F.tid]; }
    }
}
__device__ __forceinline__ void build_tiles(const Frame& F, int l) {
    volatile LAS int* tbase = (volatile LAS int*)(F.lds + LC_TBASE); volatile LAS int* tile_e = (volatile LAS int*)(F.lds + LC_TILEE);
    __syncthreads();
    if (F.tid == 0) { int s = 0; for (int e = 0; e < NE; ++e) { tbase[e] = s; const int n = (int)__hip_atomic_load(F.ctl + CW_GCNT + l * 64 + e, RLX_AGENT); s += (n + 255) >> 8; } tbase[NE] = s; }
    __syncthreads();
    if (F.tid < NE) { const int t0 = tbase[F.tid], t1 = tbase[F.tid + 1]; for (int t = t0; t < t1 && t < MAXTILES; ++t) tile_e[t] = F.tid; }
    __syncthreads();
}
__device__ __forceinline__ void phase_copy(const Frame& F, ArgsP a, int l, const float* xnew) {
    build_tiles(F, l);
    const volatile LAS int* tbase = (const volatile LAS int*)(F.lds + LC_TBASE);
    const float* RS2 = (const float*)(F.ws + WS_RS2); const unsigned* TREC = (const unsigned*)(F.ws + WS_TREC); const float* TW = (const float*)(F.ws + WS_TW);
    int* TSLOT = (int*)(F.ws + WS_TSLOT); float* SW = (float*)(F.ws + WS_SW); bf16* XS = (bf16*)(F.ws + WS_XS); const float* gf = a->in[12] + l * D;
    const int gw = F.vcu * 8 + F.wave, NGW = F.G * 8;
    f32x4 g[4];
#pragma unroll
    for (int j = 0; j < 4; ++j) g[j] = ((const f32x4*)gf)[F.lane + 64 * j];
    for (int t = gw; t < T; t += NGW) {
        const float rs = RS2[t]; const unsigned r0 = TREC[2 * t], r1 = TREC[2 * t + 1];
        const int s0 = 256 * tbase[r0 >> 16] + (int)(r0 & 0xffffu), s1 = 256 * tbase[r1 >> 16] + (int)(r1 & 0xffffu);
        const f32x4* xr = (const f32x4*)(xnew + (size_t)t * D) + F.lane;
        u32x2* o0 = (u32x2*)(XS + (size_t)s0 * D) + F.lane; u32x2* o1 = (u32x2*)(XS + (size_t)s1 * D) + F.lane;
#pragma unroll
        for (int j = 0; j < 4; ++j) { const f32x4 v = xr[64 * j] * g[j] * rs; u32x2 w; w.x = pk2(v[0], v[1]); w.y = pk2(v[2], v[3]); o0[64 * j] = w; o1[64 * j] = w; }
        if (F.lane == 0) { TSLOT[2 * t] = s0; TSLOT[2 * t + 1] = s1; SW[s0] = TW[2 * t]; SW[s1] = TW[2 * t + 1]; }
    }
}
__device__ __forceinline__ void phase_final(const Frame& F, float* x, bool make_xb) {
    const int* TSLOT = (const int*)(F.ws + WS_TSLOT); const bf16* Y = (const bf16*)(F.ws + WS_Y); bf16* XB = (bf16*)(F.ws + WS_XB); float* RS = (float*)(F.ws + WS_RS1);
    const int gw = F.vcu * 8 + F.wave, NGW = F.G * 8;
    for (int t = gw; t < T; t += NGW) {
        const int s0 = TSLOT[2 * t], s1 = TSLOT[2 * t + 1];
        f32x4* xr = (f32x4*)(x + (size_t)t * D) + F.lane; const u32x2* y0 = (const u32x2*)(Y + (size_t)s0 * D) + F.lane; const u32x2* y1 = (const u32x2*)(Y + (size_t)s1 * D) + F.lane;
        f32x4 v[4]; float s = 0.f;
#pragma unroll
        for (int j = 0; j < 4; ++j) { const u32x2 a0 = y0[64 * j], a1 = y1[64 * j]; v[j] = xr[64 * j] + (f32x4){bflo(a0.x), bfhi(a0.x), bflo(a0.y), bfhi(a0.y)} + (f32x4){bflo(a1.x), bfhi(a1.x), bflo(a1.y), bfhi(a1.y)};
            xr[64 * j] = v[j]; s += (v[j][0] * v[j][0] + v[j][1] * v[j][1]) + (v[j][2] * v[j][2] + v[j][3] * v[j][3]); }
        if (make_xb) {
            s = wave_sum(s);
            u32x2* o = (u32x2*)(XB + (size_t)t * D) + F.lane;
#pragma unroll
            for (int j = 0; j < 4; ++j) { u32x2 w; w.x = pk2(v[j][0], v[j][1]); w.y = pk2(v[j][2], v[j][3]); o[64 * j] = w; }
            if (F.lane == 0) RS[t] = rsqrtf(s * (1.0f / D) + EPS);
        }
    }
}

constexpr int PH_PER_LAYER = 16, NPH = DEPTH * PH_PER_LAYER;
#ifndef PH_MASK
#define PH_MASK 0x1ffff
#endif
#ifndef DUP_MASK
#define DUP_MASK 0
#endif
#define REP(k) for (int rep_ = 0; rep_ < 1 + ((DUP_MASK >> (k)) & 1); ++rep_)
__global__ void __launch_bounds__(512, 2) fwd_kernel(Args args_unused) {
    extern __shared__ __attribute__((aligned(16))) unsigned char lds_raw[];
    const int wave0 = __builtin_amdgcn_readfirstlane((int)threadIdx.x >> 6);
    {
        LAS unsigned char* lds0 = (LAS unsigned char*)lds_raw;
        for (int u = threadIdx.x; u < (LDS_BYTES - LC_OFF) / 4; u += 512) ((LAS unsigned*)(lds0 + LC_OFF))[u] = 0u;
        __syncthreads();
    }
#if MK_ONE_LAUNCH
    XcdBarrier bar; { ArgsP ap = get_args(); bar = xcd_barrier_post((unsigned*)(ap->ws + WS_CTL) + CW_BAR, (volatile LAS unsigned*)((LAS unsigned char*)lds_raw + LC_MISC) + 8); }
#define GRID_BAR() xcd_barrier(bar)
#else
#define GRID_BAR() do { } while (0)
#endif
    int lo, hi; { ArgsP ap = get_args(); lo = ap->ph_lo; hi = ap->ph_hi; }
#define IN(k) (((PH_MASK >> ((k) % PH_PER_LAYER)) & 1) && lo <= (k) && (k) < hi)
#define SEAM(k) do { if (IN(k) && IN((k) + 1)) GRID_BAR(); } while (0)
    for (int l = 0; l < DEPTH; ++l) {
        const int P = l * PH_PER_LAYER;
        if (IN(P + 0)) REP(0) { ArgsP ap = get_args(); const Frame F = make_frame(ap, wave0); phase_weights(F, ap, l); if (l == 0) phase_x_to_xb(F, ap->in[0]); }
        SEAM(P + 0);
        if (IN(P + 1)) REP(1) {
            ArgsP ap = get_args(); const Frame F = make_frame(ap, wave0);
            pg8::DenseOrder S; S.init(T, NIN, D, F.G, (int)blockIdx.x, F.ws + WS_XB, F.ws + WS_WIN);
            EpiIn E{(const float*)(F.ws + WS_RS1), (bf16*)(F.ws + WS_Q), (bf16*)(F.ws + WS_K), (bf16*)(F.ws + WS_V), (bf16*)(F.ws + WS_BQ), (bf16*)(F.ws + WS_BK), (bf16*)(F.ws + WS_BV), (bf16*)(F.ws + WS_BR),
                    (bf16*)(F.ws + WS_R), (bf16*)(F.ws + WS_GB), (float*)(F.ws + WS_LA), ap->in[3] + l * 512, ap->in[4] + l * 512, ap->in[7] + l * 256};
            pg8::gemm_phase<EpiIn, pg8::DenseOrder, PG8_ALIGN, PG8_SP2>(F.lds, D, S, E, F.tid);
        }
        SEAM(P + 1);
        if (IN(P + 2)) { REP(11) { ArgsP ap = get_args(); const Frame F = make_frame(ap, wave0); phase_gla(F, ap, l); } if (PH_MASK & 0x10000) REP(12) { ArgsP ap = get_args(); const Frame F = make_frame(ap, wave0); phase_attn(F, ap, l); } }
        SEAM(P + 2);
        if (IN(P + 3)) REP(3) {
            ArgsP ap = get_args(); const Frame F = make_frame(ap, wave0);
            pg8::DenseOrder S; S.init(T, D, 512, F.G, (int)blockIdx.x, F.ws + WS_YA, F.ws + WS_PA);
            EpiTmp E{(const bf16*)(F.ws + WS_R), (bf16*)(F.ws + WS_TMP)};
            pg8::gemm_phase<EpiTmp, pg8::DenseOrder, PG8_ALIGN, PG8_SP2>(F.lds, 512, S, E, F.tid);
        }
        SEAM(P + 3);
        if (IN(P + 4)) REP(4) {
            ArgsP ap = get_args(); const Frame F = make_frame(ap, wave0);
            pg8::DenseOrder S; S.init(T, D, 512, F.G, (int)blockIdx.x, F.ws + WS_YB, F.ws + WS_PB);
            EpiMrg E{(const bf16*)(F.ws + WS_GB), (const bf16*)(F.ws + WS_TMP), (bf16*)(F.ws + WS_MRG)};
            pg8::gemm_phase<EpiMrg, pg8::DenseOrder, PG8_ALIGN, PG8_SP2>(F.lds, 512, S, E, F.tid);
        }
        SEAM(P + 4);
        if (IN(P + 5)) {
            ArgsP ap = get_args(); const Frame F = make_frame(ap, wave0);
            pg8::DenseOrder S; S.init(T, D, D, F.G, (int)blockIdx.x, F.ws + WS_MRG, F.ws + WS_WOUT);
            EpiOut E{(l == 0) ? ap->in[0] : (const float*)ap->out, ap->out};
            pg8::gemm_phase<EpiOut, pg8::DenseOrder, PG8_ALIGN, PG8_SP2>(F.lds, D, S, E, F.tid);
        }
        SEAM(P + 5);
        if (IN(P + 6)) { ArgsP ap = get_args(); const Frame F = make_frame(ap, wave0); phase_router(F, ap, l, ap->out); }
        SEAM(P + 6);
        if (IN(P + 7)) REP(7) { ArgsP ap = get_args(); const Frame F = make_frame(ap, wave0); phase_copy(F, ap, l, ap->out); }
        SEAM(P + 7);
        if (IN(P + 8)) REP(8) {
            ArgsP ap = get_args(); const Frame F = make_frame(ap, wave0);
            build_tiles(F, l);
            pg8::ExpertOrder S; S.tile_e = (const LAS int*)(F.lds + LC_TILEE); S.ntiles = __builtin_amdgcn_readfirstlane(*(const LAS int*)(F.lds + LC_TBASE + 4 * NE)); S.NPN = 2; S.G = F.G; S.c = (int)blockIdx.x;
            S.A = (const char*)(F.ws + WS_XS); S.B = (const char*)(F.ws + WS_WGU); S.a_tile = (size_t)256 * D * 2; S.b_exp = (size_t)512 * D * 2; S.b_pn = (size_t)256 * D * 2;
            EpiGU E{(bf16*)(F.ws + WS_H)};
            pg8::gemm_phase<EpiGU, pg8::ExpertOrder, PG8_ALIGN, PG8_SP2>(F.lds, D, S, E, F.tid);
        }
        SEAM(P + 8);
        if (IN(P + 9)) REP(9) {
            ArgsP ap = get_args(); const Frame F = make_frame(ap, wave0);
            build_tiles(F, l);
            pg8::ExpertOrder S; S.tile_e = (const LAS int*)(F.lds + LC_TILEE); S.ntiles = __builtin_amdgcn_readfirstlane(*(const LAS int*)(F.lds + LC_TBASE + 4 * NE)); S.NPN = 4; S.G = F.G; S.c = (int)blockIdx.x;
            S.A = (const char*)(F.ws + WS_H); S.B = (const char*)(F.ws + WS_WD); S.a_tile = (size_t)256 * DE * 2; S.b_exp = (size_t)D * DE * 2; S.b_pn = (size_t)256 * DE * 2;
            EpiDown E{(const float*)(F.ws + WS_SW), (bf16*)(F.ws + WS_Y)};
            pg8::gemm_phase<EpiDown, pg8::ExpertOrder, PG8_ALIGN, PG8_SP2>(F.lds, DE, S, E, F.tid);
        }
        SEAM(P + 9);
        if (IN(P + 10)) { ArgsP ap = get_args(); const Frame F = make_frame(ap, wave0); phase_final(F, ap->out, l + 1 < DEPTH); }
        if (l + 1 < DEPTH) { if (IN(P + 10) && IN(P + PH_PER_LAYER)) GRID_BAR(); }
    }
#undef IN
#undef SEAM
}

extern "C" void kernel_launch(void* const* d_in, const int* in_sizes, int n_in, void* d_out, int out_size, void* d_ws, size_t ws_size, hipStream_t stream) {
    static int grid = 0;
    if (grid == 0) {
        if (n_in != 20 || in_sizes[0] != T * D || out_size != T * D || ws_size < WS_END) { fprintf(stderr, "kernel_launch: unexpected shapes (n_in %d, in0 %d, out %d, ws %zu); nothing launched\n", n_in, n_in > 0 ? in_sizes[0] : -1, out_size, ws_size); grid = -1; return; }
        int dev = 0, cus = 0;
        if (hipGetDevice(&dev) != hipSuccess || hipDeviceGetAttribute(&cus, hipDeviceAttributeMultiprocessorCount, dev) != hipSuccess) { grid = -1; return; }
        if (hipFuncSetAttribute((const void*)fwd_kernel, hipFuncAttributeMaxDynamicSharedMemorySize, LDS_BYTES) != hipSuccess) { fprintf(stderr, "kernel_launch: hipFuncSetAttribute failed\n"); grid = -1; return; }
        grid = cus;
    }
    if (grid < 0) return;
    (void)hipMemsetAsync((char*)d_ws + WS_CTL, 0, CTL_ZERO_BYTES, stream);
    Args a{};
    for (int i = 0; i < 20; ++i) a.in[i] = (const float*)d_in[i];
    a.out = (float*)d_out; a.ws = (unsigned char*)d_ws;
#if MK_ONE_LAUNCH
    a.ph_lo = 0; a.ph_hi = NPH;
    hipLaunchKernelGGL(fwd_kernel, dim3(grid), dim3(512), LDS_BYTES, stream, a);
#else
    for (int l = 0; l < DEPTH; ++l)
        for (int p = 0; p <= 10; ++p) { a.ph_lo = l * PH_PER_LAYER + p; a.ph_hi = a.ph_lo + 1; hipLaunchKernelGGL(fwd_kernel, dim3(grid), dim3(512), LDS_BYTES, stream, a); }
#endif
}
```

```cpp
#include <hip/hip_runtime.h>
#include <cstdio>
#include <cstdint>

#ifndef PROBE_PHASE
#define PROBE_PHASE -1
#endif
#ifndef MK_ONE_LAUNCH
#define MK_ONE_LAUNCH 1
#endif

#define LAS __attribute__((address_space(3)))
#define GAS __attribute__((address_space(1)))
typedef unsigned short bf16;
typedef short bf16x8 __attribute__((ext_vector_type(8)));
typedef float f32x4 __attribute__((ext_vector_type(4)));
typedef float f32x2 __attribute__((ext_vector_type(2)));
typedef unsigned u32x4 __attribute__((ext_vector_type(4)));
typedef unsigned u32x2 __attribute__((ext_vector_type(2)));

constexpr int T = 32768, D = 1024, SEQ = 2048, DEPTH = 2;
constexpr int IN_COLS = 5136, NIN = 5376;
constexpr int NE = 32, DE = 256;
constexpr int MAXTILES = 288;
constexpr float EPS = 1e-6f, LOG2E = 1.4426950408889634f;

namespace pg8 {
constexpr int BM = 256, BK = 64, HALF = 128, HTB = HALF * BK * 2  , STAGE_BYTES = 8 * HTB, NXCD = 8, WGM = 8;
__host__ __device__ __forceinline__ int lds_byte(int r, int c) { const int st = (r >> 4) * 2 + (c >> 5), rr = r & 15, cc = c & 31, ob = rr * 64 + cc * 2; return st * 1024 + (ob ^ (((ob >> 9) & 1) << 5)); }
__host__ __device__ __forceinline__ void stage_rc(int b, int& R, int& C) { const int st = b / 1024, sb = b % 1024, swz = sb ^ (((sb >> 9) & 1) << 5); R = (st >> 1) * 16 + swz / 64; C = (st & 1) * 32 + (swz % 64) / 2; }
__host__ __device__ __forceinline__ int perm32(int rho) { const int n = rho >> 4, i = rho & 15; return 8 * (i >> 2) + 4 * n + (i & 3); }

struct Unit { int pm, pn; const char* A; const char* B; int sub, aux; };

struct DenseOrder {
    static constexpr bool GATHER = false;
    int nM, nN, nwg, G, c; const char* A; const char* Bt; size_t tstep;
    __device__ void init(int M, int N, int K, int G_, int c_, const void* A_, const void* Bt_) { nM = M / BM; nN = N / BM; nwg = nM * nN; G = G_; c = c_; A = (const char*)A_; Bt = (const char*)Bt_; tstep = (size_t)BM * K * 2; }
    __device__ bool next(int i, Unit& u) const {
        const long L = (long)i * G + c; if (L >= nwg) return false;
        int wgid = (int)L; { const int q = nwg / NXCD, r = nwg % NXCD, xcd = wgid % NXCD, off = wgid / NXCD; wgid = (xcd < r ? xcd * (q + 1) : r * (q + 1) + (xcd - r) * q) + off; }
        const int nig = WGM * nN, gid = wgid / nig, fm = gid * WGM, gsz = (nM - fm) < WGM ? (nM - fm) : WGM;
        u.pm = fm + ((wgid % nig) % gsz); u.pn = (wgid % nig) / gsz; u.A = A + (size_t)u.pm * tstep; u.B = Bt + (size_t)u.pn * tstep; u.sub = 0; return true;
    }
    __device__ __forceinline__ void a_ready(const Unit&) const {}
    __device__ __forceinline__ void done(const Unit&) const {}
};
struct ChainOrder {
    static constexpr bool GATHER = false;
    DenseOrder d0, d1;
    __device__ bool next(int i, Unit& u) const { const bool ok = (i & 1) ? d1.next(i >> 1, u) : d0.next(i >> 1, u); u.sub = i & 1; return ok; }
    __device__ __forceinline__ void a_ready(const Unit&) const {}
    __device__ __forceinline__ void done(const Unit&) const {}
};
template <bool GATHER_> struct ExpertOrderT {
    static constexpr bool GATHER = GATHER_;
    const LAS int* tile_e; const LAS int* tbase; const LAS unsigned* tab; int ntiles, NPN, G, c; const char* A; const char* B; size_t a_tile, b_exp, b_pn;
    __device__ bool next(int i, Unit& u) const {
        const long L = (long)i * G + c; if (L >= (long)ntiles * NPN) return false;
        const int tile = (int)(L / NPN), pn = (int)(L % NPN); const int e = __builtin_amdgcn_readfirstlane(tile_e[tile]); const int k = tile - __builtin_amdgcn_readfirstlane(tbase[e]);
        u.pm = tile; u.pn = pn; u.A = GATHER_ ? A : A + (size_t)tile * a_tile; u.B = B + (size_t)e * b_exp + (size_t)pn * b_pn; u.sub = 0; u.aux = e * 32768 + 256 * k; return true;
    }
    __device__ __forceinline__ unsigned row_off(int i, int row) const { return tab[i * 256 + row]; }
    __device__ __forceinline__ void a_ready(const Unit&) const {}
    __device__ __forceinline__ void done(const Unit&) const {}
};
__device__ __forceinline__ unsigned cvt_pk_bf16(float lo, float hi) { unsigned r; asm volatile("v_cvt_pk_bf16_f32 %0, %1, %2" : "=v"(r) : "v"(lo), "v"(hi)); return r; }

template <class Epi, class Sched, bool ALIGN_EPI = false, bool SP2 = false>
__device__ __forceinline__ void gemm_phase(LAS unsigned char* lds, const int K, const Sched& S, const Epi& E, int tid_) {
    asm volatile("" : "+v"(tid_));
    const int tid = tid_, wid = __builtin_amdgcn_readfirstlane(tid >> 6), lane = tid & 63, wr = wid >> 2, wc = wid & 3, fr = lane & 15, fq = lane >> 4;
    const int nt = K / BK;
    unsigned voffA[2], voffB[2];
#pragma unroll
    for (int i = 0; i < 2; ++i) { int R, C; stage_rc(tid * 16 + i * 8192, R, C); const int Rb = Epi::PERM ? ((R & ~31) + perm32(R & 31)) : R;
        voffA[i] = (unsigned)(R * K + C) * 2u; voffB[i] = (unsigned)(Rb * K + C) * 2u; }
    const size_t kstep = (size_t)(BK * 2);
    const size_t hstep = (size_t)HALF * K * 2;
    const unsigned ldsw = (unsigned)wid * 1024u;
    unsigned gc[2][2] = {{0u, 0u}, {0u, 0u}}, gn[2][2] = {{0u, 0u}, {0u, 0u}}; int gR[2] = {0, 0}; unsigned gC[2] = {0u, 0u};
    if constexpr (Sched::GATHER) {
#pragma unroll
        for (int i = 0; i < 2; ++i) { int R, C; stage_rc(tid * 16 + i * 8192, R, C); gR[i] = R; gC[i] = (unsigned)C * 2u; }
    }
    const int aoff = lds_byte(wr * 64 + fr, fq * 8), boff = lds_byte(wc * 32 + fr, fq * 8);
#define PG8_SA(b, h) (((b) * 2 + (h)) * HTB)
#define PG8_SB(b, h) ((4 + (b) * 2 + (h)) * HTB)
#define PG8_STAGE(bufoff, gbase, voff) do { _Pragma("unroll") for (int _i = 0; _i < 2; ++_i) \
        __builtin_amdgcn_global_load_lds((const unsigned*)((const char*)(gbase) + (voff)[_i]), (LAS unsigned*)(lds + (bufoff) + ldsw + _i * 8192), 16, 0, 0); } while (0)
#define PG8_STAGE_A(bufoff, gbase, half, nx) do { if constexpr (Sched::GATHER) { _Pragma("unroll") for (int _i = 0; _i < 2; ++_i) \
        __builtin_amdgcn_global_load_lds((const unsigned*)((const char*)(gbase) + ((nx) ? gn[half][_i] : gc[half][_i])), (LAS unsigned*)(lds + (bufoff) + ldsw + _i * 8192), 16, 0, 0); } \
        else { PG8_STAGE(bufoff, (gbase) + (half) * hstep, voffA); } } while (0)
#define PG8_LDA(dst, b, h) do { _Pragma("unroll") for (int m = 0; m < 4; ++m) _Pragma("unroll") for (int k = 0; k < 2; ++k) dst[m][k] = *(const LAS bf16x8*)(lds + PG8_SA(b, h) + aoff + m * 2048 + k * 1024); } while (0)
#define PG8_LDB(dst, b, h) do { _Pragma("unroll") for (int n = 0; n < 2; ++n) _Pragma("unroll") for (int k = 0; k < 2; ++k) dst[n][k] = *(const LAS bf16x8*)(lds + PG8_SB(b, h) + boff + n * 2048 + k * 1024); } while (0)
#define PG8_MMA(ai, bj, At, Bt) do { __builtin_amdgcn_s_setprio(1); _Pragma("unroll") for (int m = 0; m < 4; ++m) _Pragma("unroll") for (int n = 0; n < 2; ++n) _Pragma("unroll") for (int k = 0; k < 2; ++k) \
        acc[ai][bj][m][n] = __builtin_amdgcn_mfma_f32_16x16x32_bf16(Bt[n][k], At[m][k], acc[ai][bj][m][n], 0, 0, 0); __builtin_amdgcn_s_setprio(0); } while (0)
#define PG8_WAIT_V(n) asm volatile("s_waitcnt vmcnt(" #n ")" ::: "memory")
#define PG8_WAIT_L(n) asm volatile("s_waitcnt lgkmcnt(" #n ")" ::: "memory")
#define PG8_BAR __builtin_amdgcn_s_barrier()
#define PG8_SCHED __builtin_amdgcn_sched_barrier(0)
    Unit cur, nxt; int ui = 0;
    if (!S.next(0, cur)) return;
    f32x4 acc[2][2][4][2];
#pragma unroll
    for (int a = 0; a < 2; ++a)
#pragma unroll
        for (int b = 0; b < 2; ++b)
#pragma unroll
            for (int m = 0; m < 4; ++m)
#pragma unroll
                for (int n = 0; n < 2; ++n) acc[a][b][m][n] = (f32x4){0.f, 0.f, 0.f, 0.f};
    bf16x8 At[4][2], B0[2][2], B1[2][2];
    const char* cA = cur.A; const char* cB = cur.B;
    if constexpr (Sched::GATHER) {
#pragma unroll
        for (int h = 0; h < 2; ++h)
#pragma unroll
            for (int i = 0; i < 2; ++i) gc[h][i] = S.row_off(0, 128 * h + gR[i]) + gC[i];
    }
    S.a_ready(cur);
    if constexpr (SP2) {
        PG8_STAGE(PG8_SB(0, 0), cB, voffB); PG8_STAGE(PG8_SB(0, 1), cB + hstep, voffB); PG8_STAGE_A(PG8_SA(0, 0), cA, 0, false); PG8_STAGE_A(PG8_SA(0, 1), cA, 1, false);
        if (wr == 1) PG8_BAR;
        PG8_WAIT_V(2); PG8_BAR;
        PG8_STAGE(PG8_SB(1, 0), cB + kstep, voffB); PG8_STAGE_A(PG8_SA(1, 0), cA + kstep, 0, false); PG8_STAGE(PG8_SB(1, 1), cB + hstep + kstep, voffB);
        PG8_WAIT_V(6); PG8_BAR;
    } else {
        PG8_STAGE(PG8_SB(0, 0), cB, voffB); PG8_STAGE_A(PG8_SA(0, 0), cA, 0, false); PG8_STAGE(PG8_SB(0, 1), cB + hstep, voffB); PG8_STAGE_A(PG8_SA(0, 1), cA, 1, false);
        if (wr == 1) PG8_BAR;
        PG8_WAIT_V(4); PG8_BAR;
        PG8_STAGE(PG8_SB(1, 0), cB + kstep, voffB); PG8_STAGE_A(PG8_SA(1, 0), cA + kstep, 0, false); PG8_STAGE(PG8_SB(1, 1), cB + hstep + kstep, voffB);
        PG8_WAIT_V(6); PG8_BAR;
    }
    for (;;) {
        const bool has_next = S.next(ui + 1, nxt);
        const char* nA = has_next ? nxt.A : cA; const char* nB = has_next ? nxt.B : cB;
        if constexpr (Sched::GATHER) {
#pragma unroll
            for (int h = 0; h < 2; ++h)
#pragma unroll
                for (int i = 0; i < 2; ++i) gn[h][i] = has_next ? S.row_off(ui + 1, 128 * h + gR[i]) + gC[i] : gc[h][i];
        }
        for (int t = 0; t < nt; t += 2) {
            const bool last = (t == nt - 2);
            const char* a1 = cA + (size_t)(t + 1) * kstep;
            const char* a2 = last ? nA : cA + (size_t)(t + 2) * kstep; const char* b2 = last ? nB : cB + (size_t)(t + 2) * kstep;
            const char* a3 = a2 + kstep; const char* b3 = b2 + kstep;
            if (last && has_next) S.a_ready(nxt);
            if constexpr (SP2) {
            PG8_LDB(B0, 0, 0); PG8_LDB(B1, 0, 1); PG8_SCHED; PG8_LDA(At, 0, 0); PG8_STAGE_A(PG8_SA(1, 1), a1, 1, false);
            PG8_WAIT_V(8); PG8_WAIT_L(0); PG8_BAR; PG8_MMA(0, 0, At, B0); PG8_MMA(0, 1, At, B1); PG8_BAR; PG8_SCHED;
            PG8_LDA(At, 0, 1); PG8_STAGE(PG8_SB(0, 0), b2, voffB); PG8_STAGE(PG8_SB(0, 1), b2 + hstep, voffB); PG8_STAGE_A(PG8_SA(0, 0), a2, 0, last);
            PG8_WAIT_V(8); PG8_WAIT_L(0); PG8_BAR; PG8_MMA(1, 0, At, B0); PG8_MMA(1, 1, At, B1); PG8_BAR; PG8_SCHED;
            PG8_LDB(B0, 1, 0); PG8_LDB(B1, 1, 1); PG8_SCHED; PG8_LDA(At, 1, 0); PG8_STAGE_A(PG8_SA(0, 1), a2, 1, last);
            PG8_WAIT_V(8); PG8_WAIT_L(0); PG8_BAR; PG8_MMA(0, 0, At, B0); PG8_MMA(0, 1, At, B1); PG8_BAR; PG8_SCHED;
            PG8_LDA(At, 1, 1); PG8_STAGE(PG8_SB(1, 0), b3, voffB); PG8_STAGE(PG8_SB(1, 1), b3 + hstep, voffB); PG8_STAGE_A(PG8_SA(1, 0), a3, 0, last);
            PG8_WAIT_V(8); PG8_WAIT_L(0); PG8_BAR; PG8_MMA(1, 0, At, B0); PG8_MMA(1, 1, At, B1); PG8_BAR; PG8_SCHED;
            } else {
            PG8_LDB(B0, 0, 0); PG8_SCHED; PG8_LDA(At, 0, 0); PG8_STAGE_A(PG8_SA(1, 1), a1, 1, false);
            PG8_WAIT_L(8); PG8_BAR; PG8_WAIT_L(0); PG8_MMA(0, 0, At, B0); PG8_BAR; PG8_SCHED;
            PG8_LDB(B1, 0, 1); PG8_STAGE(PG8_SB(0, 0), b2, voffB);
            PG8_BAR; PG8_WAIT_L(0); PG8_MMA(0, 1, At, B1); PG8_BAR;
            PG8_LDA(At, 0, 1); PG8_STAGE_A(PG8_SA(0, 0), a2, 0, last);
            PG8_BAR; PG8_WAIT_L(0); PG8_MMA(1, 0, At, B0); PG8_BAR; PG8_SCHED;
            PG8_STAGE(PG8_SB(0, 1), b2 + hstep, voffB);
            PG8_WAIT_V(6); PG8_BAR; PG8_MMA(1, 1, At, B1); PG8_BAR;
            PG8_LDB(B0, 1, 0); PG8_SCHED; PG8_LDA(At, 1, 0); PG8_STAGE_A(PG8_SA(0, 1), a2, 1, last);
            PG8_WAIT_L(8); PG8_BAR; PG8_WAIT_L(0); PG8_MMA(0, 0, At, B0); PG8_BAR; PG8_SCHED;
            PG8_LDB(B1, 1, 1); PG8_STAGE(PG8_SB(1, 0), b3, voffB);
            PG8_BAR; PG8_WAIT_L(0); PG8_MMA(0, 1, At, B1); PG8_BAR;
            PG8_LDA(At, 1, 1); PG8_STAGE_A(PG8_SA(1, 0), a3, 0, last);
            PG8_BAR; PG8_WAIT_L(0); PG8_MMA(1, 0, At, B0); PG8_BAR; PG8_SCHED;
            PG8_STAGE(PG8_SB(1, 1), b3 + hstep, voffB);
            PG8_WAIT_V(6); PG8_BAR; PG8_MMA(1, 1, At, B1); PG8_BAR;
            }
        }
        if constexpr (ALIGN_EPI) { if (wr == 0) PG8_BAR; }
        E(acc, cur, wr, wc, fr, fq); S.done(cur);
        if (!has_next) break;
        if (!(Epi::CHAIN && cur.sub == 0)) {
#pragma unroll
        for (int a = 0; a < 2; ++a)
#pragma unroll
            for (int b = 0; b < 2; ++b)
#pragma unroll
                for (int m = 0; m < 4; ++m)
#pragma unroll
                    for (int n = 0; n < 2; ++n) acc[a][b][m][n] = (f32x4){0.f, 0.f, 0.f, 0.f};
        }
        cur = nxt; cA = nA; cB = nB; ++ui;
        if constexpr (Sched::GATHER) {
#pragma unroll
            for (int h = 0; h < 2; ++h)
#pragma unroll
                for (int i = 0; i < 2; ++i) gc[h][i] = gn[h][i];
        }
        if constexpr (ALIGN_EPI) { if (wr == 1) PG8_BAR; }
    }
    PG8_WAIT_V(0);
    if constexpr (!ALIGN_EPI) { if (wr == 0) PG8_BAR; }
    PG8_BAR;
#undef PG8_SA
#undef PG8_SB
#undef PG8_STAGE
#undef PG8_STAGE_A
#undef PG8_LDA
#undef PG8_LDB
#undef PG8_MMA
#undef PG8_WAIT_V
#undef PG8_WAIT_L
#undef PG8_BAR
#undef PG8_SCHED
}
}

#define PG8_SP2 true
#define PG8_ALIGN true

constexpr size_t MiB = 1u << 20;
constexpr size_t WS_CTL = 0, CTL_ZERO_BYTES = 1 * MiB;
constexpr size_t WS_WIN = 1 * MiB;
constexpr size_t WS_WR = WS_WIN + (size_t)NIN * D * 2;
constexpr size_t WS_PA = 12 * MiB, WS_PB = 13 * MiB, WS_WOUT = 14 * MiB, WS_WGU = 16 * MiB, WS_WD = 48 * MiB;
constexpr size_t WS_XB2 = 64 * MiB;
constexpr size_t WS_XB = 64 * MiB;
constexpr size_t WS_YA = 64 * MiB, WS_YB = 96 * MiB;
constexpr size_t WS_SMALL = 128 * MiB;
constexpr size_t WS_RS1 = WS_SMALL, WS_RS2 = WS_SMALL + 128 * 1024, WS_TREC = WS_SMALL + 256 * 1024, WS_TW = WS_SMALL + 512 * 1024, WS_TSLOT = WS_SMALL + 768 * 1024, WS_SW = WS_SMALL + 1024 * 1024, WS_SRS = WS_SMALL + 1024 * 1024 + 512 * 1024;
constexpr size_t WS_Q = 130 * MiB, WS_K = 162 * MiB, WS_V = 194 * MiB, WS_BQ = 226 * MiB, WS_BK = 242 * MiB, WS_BV = 258 * MiB, WS_BR = 290 * MiB, WS_LA = 322 * MiB, WS_R = 354 * MiB, WS_GB = 418 * MiB;
constexpr size_t WS_TMP = 130 * MiB, WS_MRG = 194 * MiB;
constexpr size_t WS_TOKL = 130 * MiB, WS_TWL = 134 * MiB, WS_RSLL = 138 * MiB;
constexpr size_t WS_H = 274 * MiB, WS_Y = 310 * MiB;
constexpr size_t WS_END = 482 * MiB;
constexpr int CW_TMO = 0, CW_CODE = 1, CW_BAR = 4096, CW_GCNT = 8192;

constexpr int SCR_BYTES = 155648;
constexpr int LC_OFF = SCR_BYTES;
constexpr int LC_MISC = LC_OFF, LC_TBASE = LC_OFF + 128, LC_TILEE = LC_OFF + 512, LC_LCNT = LC_OFF + 1792, LC_LBASE = LC_OFF + 1920, LC_REC = LC_OFF + 2048, LC_RECW = LC_OFF + 3072, LC_RECRS = LC_OFF + 4096;
constexpr int LDS_BYTES = 163840;

#define RLX_AGENT __ATOMIC_RELAXED, __HIP_MEMORY_SCOPE_AGENT
#define LDS_WAIT() asm volatile("s_waitcnt lgkmcnt(0)" ::: "memory")
__device__ __forceinline__ unsigned f2bf(float f) { unsigned u = __builtin_bit_cast(unsigned, f); return (u + 0x7fffu + ((u >> 16) & 1u)) >> 16; }
__device__ __forceinline__ unsigned pk2(float lo, float hi) { return f2bf(lo) | (f2bf(hi) << 16); }
__device__ __forceinline__ float bflo(unsigned w) { return __uint_as_float(w << 16); }
__device__ __forceinline__ float bfhi(unsigned w) { return __uint_as_float(w & 0xffff0000u); }
__device__ __forceinline__ float bf2f(bf16 b) { return __uint_as_float(((unsigned)b) << 16); }
__device__ __forceinline__ float wave_sum(float v) {
#pragma unroll
    for (int o = 1; o < 64; o <<= 1) v += __shfl_xor(v, o);
    return v;
}
__device__ __forceinline__ float rdlane(float v, int i) { return __uint_as_float((unsigned)__builtin_amdgcn_readlane((int)__float_as_uint(v), i)); }
__device__ __forceinline__ float wave_max(float v) {
#pragma unroll
    for (int o = 1; o < 64; o <<= 1) v = fmaxf(v, __shfl_xor(v, o));
    return v;
}

#define XB_TMO      128
#define XB_XCNT(j)  (256  + 64 * (j))
#define XB_XSUB(j)  (1280 + 64 * (j))
#define XB_XGEN(j)  (2304 + 64 * (j))
#define XB_TOP      3328
#define XB_TOPGEN   3392
#define XCD_BAR_WORDS 3456
#define XB_SPIN_CAP (1u << 18)
__device__ __forceinline__ unsigned xb_ld(unsigned* p)              { return __hip_atomic_load(p, __ATOMIC_RELAXED, __HIP_MEMORY_SCOPE_AGENT); }
__device__ __forceinline__ unsigned xb_add(unsigned* p, unsigned v) { return __hip_atomic_fetch_add(p, v, __ATOMIC_RELAXED, __HIP_MEMORY_SCOPE_AGENT); }
__device__ __forceinline__ unsigned xb_xcc_id() { return (unsigned)__builtin_amdgcn_s_getreg((3 << 11) | 20) & 0xFu; }
#define XB_SPIN(cond, bar) do { unsigned _sp = 0; while (cond) { __builtin_amdgcn_s_sleep(1); \
    if ((++_sp & 255u) == 0u) { if (xb_ld(&(bar)[XB_TMO])) break; if (_sp > XB_SPIN_CAP) { atomicAdd(&(bar)[XB_TMO], 1u); break; } } } } while (0)
struct XcdBarrier { unsigned* bar; unsigned x; volatile LAS unsigned* st; };
__device__ __forceinline__ XcdBarrier xcd_barrier_post(unsigned* bar, volatile LAS unsigned* st) {
    XcdBarrier b; b.bar = bar; b.x = xb_xcc_id(); b.st = st;
    if (threadIdx.x == 0) (void)xb_add(&bar[XB_XCNT(b.x)], 1u);
    return b;
}
__device__ __forceinline__ void xcd_barrier_complete(unsigned* bar, unsigned x, unsigned& nloc, unsigned& nx) {
    const unsigned G = gridDim.x * gridDim.y * gridDim.z;
    unsigned sum, cnt, mine, sp = 0u;
    for (;;) {
        sum = 0u; cnt = 0u; mine = 0u;
#pragma unroll
        for (unsigned j = 0; j < 16; ++j) { const unsigned c = xb_ld(&bar[XB_XCNT(j)]); sum += c; cnt += (c > 0u) ? 1u : 0u; mine = (j == x) ? c : mine; }
        if (sum == G) break;
        __builtin_amdgcn_s_sleep(1);
        if ((++sp & 255u) == 0u) { if (xb_ld(&bar[XB_TMO])) break; if (sp > XB_SPIN_CAP) { atomicAdd(&bar[XB_TMO], 1u); break; } }
    }
    nloc = mine > 0u ? mine : 1u; nx = cnt > 0u ? cnt : 1u;
}
__device__ __forceinline__ void xcd_barrier(const XcdBarrier& b) {
    asm volatile("s_waitcnt vmcnt(0)" ::: "memory");
    __syncthreads();
    if (threadIdx.x == 0) {
        unsigned* bar = b.bar;
        __builtin_amdgcn_s_waitcnt(0);
        unsigned nloc = b.st[0], nx = b.st[1];
        if (nloc == 0u) { xcd_barrier_complete(bar, b.x, nloc, nx); b.st[0] = nloc; b.st[1] = nx; }
        const unsigned old = xb_add(&bar[XB_XSUB(b.x)], 1u);
        const unsigned gen = old / nloc;
        if (old + 1u == (gen + 1u) * nloc) {
            __builtin_amdgcn_fence(__ATOMIC_RELEASE, "agent");
            asm volatile("s_waitcnt vmcnt(0)" ::: "memory");
            const unsigned og = xb_add(&bar[XB_TOP], 1u);
            const unsigned tg = og / nx;
            if (og + 1u == (tg + 1u) * nx) xb_add(&bar[XB_TOPGEN], 1u);
            else XB_SPIN(xb_ld(&bar[XB_TOPGEN]) == tg, bar);
            __builtin_amdgcn_fence(__ATOMIC_ACQUIRE, "agent");
            xb_add(&bar[XB_XGEN(b.x)], 1u);
            asm volatile("s_waitcnt vmcnt(0)" ::: "memory");
        } else {
            XB_SPIN(xb_ld(&bar[XB_XGEN(b.x)]) == gen, bar);
            __builtin_amdgcn_fence(__ATOMIC_ACQUIRE, "agent");
            asm volatile("s_waitcnt vmcnt(0)" ::: "memory");
        }
    }
    __syncthreads();
}

struct Args { const float* in[20]; float* out; unsigned char* ws; int ph_lo, ph_hi; };
typedef const __attribute__((address_space(4))) Args* ArgsP;
struct Frame {
    LAS unsigned char* lds; unsigned* ctl; unsigned char* ws;
    int tid, lane, wave, vcu, G;
};
__device__ __forceinline__ ArgsP get_args() { ArgsP p = (ArgsP)__builtin_amdgcn_kernarg_segment_ptr(); asm volatile("" : "+s"(p)); return p; }
__device__ __forceinline__ Frame make_frame(ArgsP ap, int wave0) {
    extern __shared__ __attribute__((aligned(16))) unsigned char lds_raw[];
    Frame F; F.lds = (LAS unsigned char*)lds_raw; F.ws = ap->ws; F.ctl = (unsigned*)(F.ws + WS_CTL);
    unsigned z = 0u; asm volatile("" : "+v"(z));
    int t = wave0 * 64 + (int)__builtin_amdgcn_mbcnt_hi(~0u, __builtin_amdgcn_mbcnt_lo(~0u, z)); asm volatile("" : "+v"(t));
    F.tid = t; F.lane = t & 63; F.wave = __builtin_amdgcn_readfirstlane(t >> 6);
    F.G = gridDim.x; { const int bx = blockIdx.x; F.vcu = (F.G % 8 == 0) ? (bx % 8) * (F.G / 8) + bx / 8 : bx; }
    return F;
}

using pg8::cvt_pk_bf16;
__device__ __forceinline__ u32x4 pack8(f32x4 a, f32x4 b) { u32x4 w; w.x = cvt_pk_bf16(a[0], a[1]); w.y = cvt_pk_bf16(a[2], a[3]); w.z = cvt_pk_bf16(b[0], b[1]); w.w = cvt_pk_bf16(b[2], b[3]); return w; }
__device__ __forceinline__ void unpack8(u32x4 w, f32x4& a, f32x4& b) { a = (f32x4){bflo(w.x), bfhi(w.x), bflo(w.y), bfhi(w.y)}; b = (f32x4){bflo(w.z), bfhi(w.z), bflo(w.w), bfhi(w.w)}; }
__device__ __forceinline__ float sigmoidf_(float z) { return __builtin_amdgcn_rcpf(1.0f + __builtin_amdgcn_exp2f(-LOG2E * z)); }

struct EpiIn {
    static constexpr bool PERM = true, CHAIN = false;
    const float* rowscale; bf16 *Q, *K, *V, *BQ, *BK, *BV, *BR, *R, *GB; float* LOGA; const float *qg, *kg, *lbias;
    __device__ __forceinline__ void operator()(f32x4 (&acc)[2][2][4][2], const pg8::Unit& u, int wr, int wc, int fr, int fq) const {
        const int pn = u.pn, row0 = u.pm * 256 + wr * 64 + fr;
        if (pn < 4) {
            const bool isq = pn < 2; const int hh = 4 * (pn & 1) + wc;
            const float* g = (isq ? qg : kg) + hh * 64 + 8 * fq;
            f32x4 g0[2], g1[2];
#pragma unroll
            for (int bj = 0; bj < 2; ++bj) { g0[bj] = *(const f32x4*)(g + 32 * bj); g1[bj] = *(const f32x4*)(g + 32 * bj + 4); }
            const float sc = isq ? 0.125f * LOG2E : 1.0f; bf16* O = isq ? Q : K;
#pragma unroll
            for (int ai = 0; ai < 2; ++ai)
#pragma unroll
                for (int m = 0; m < 4; ++m) {
                    const int row = row0 + ai * 128 + m * 16; const float rs = rowscale[row];
                    f32x4 v[2][2]; float ss = 0.f;
#pragma unroll
                    for (int bj = 0; bj < 2; ++bj)
#pragma unroll
                        for (int n = 0; n < 2; ++n) { v[bj][n] = acc[ai][bj][m][n] * rs; const f32x4 q = v[bj][n] * v[bj][n]; ss += (q[0] + q[1]) + (q[2] + q[3]); }
                    ss += __shfl_xor(ss, 16); ss += __shfl_xor(ss, 32);
                    const float rn = rsqrtf(ss * (1.0f / 64.0f) + EPS) * sc;
#pragma unroll
                    for (int bj = 0; bj < 2; ++bj) *(u32x4*)(O + (size_t)row * 512 + hh * 64 + 32 * bj + 8 * fq) = pack8(v[bj][0] * g0[bj] * rn, v[bj][1] * g1[bj] * rn);
                }
        } else if (pn < 12) {
            bf16* O; int ld, cb; float sc = 1.0f; bool act = false;
            if (pn < 6) { O = V; ld = 512; cb = 256 * (pn - 4); }
            else if (pn == 6) { O = BQ; ld = 256; cb = 0; sc = 0.125f; }
            else if (pn == 7) { O = BK; ld = 256; cb = 0; }
            else if (pn < 10) { O = BV; ld = 512; cb = 256 * (pn - 8); }
            else { O = BR; ld = 512; cb = 256 * (pn - 10); act = true; }
#pragma unroll
            for (int ai = 0; ai < 2; ++ai)
#pragma unroll
                for (int m = 0; m < 4; ++m) {
                    const int row = row0 + ai * 128 + m * 16; const float rs = rowscale[row] * sc;
#pragma unroll
                    for (int bj = 0; bj < 2; ++bj) {
                        f32x4 a = acc[ai][bj][m][0] * rs, b = acc[ai][bj][m][1] * rs;
                        if (act) {
#pragma unroll
                            for (int e = 0; e < 4; ++e) { a[e] = a[e] * sigmoidf_(a[e]); b[e] = b[e] * sigmoidf_(b[e]); }
                        }
                        *(u32x4*)(O + (size_t)row * ld + cb + 64 * wc + 32 * bj + 8 * fq) = pack8(a, b);
                    }
                }
        } else if (pn == 12) {
            f32x4 b0[2], b1[2];
#pragma unroll
            for (int bj = 0; bj < 2; ++bj) { b0[bj] = *(const f32x4*)(lbias + 64 * wc + 32 * bj + 8 * fq); b1[bj] = *(const f32x4*)(lbias + 64 * wc + 32 * bj + 8 * fq + 4); }
            const int l15 = ((fq << 4) | 15);
#pragma unroll
            for (int ai = 0; ai < 2; ++ai)
#pragma unroll
                for (int bj = 0; bj < 2; ++bj)
#pragma unroll
                    for (int n = 0; n < 2; ++n) {
                        f32x4 v[4];
#pragma unroll
                        for (int m = 0; m < 4; ++m) { const float rs = rowscale[row0 + ai * 128 + m * 16];
                            f32x4 z = acc[ai][bj][m][n] * rs + (n ? b1[bj] : b0[bj]);
#pragma unroll
                            for (int e = 0; e < 4; ++e) z[e] = (fminf(z[e], 0.f) - __logf(1.0f + __expf(-fabsf(z[e])))) * 0.0625f;
                            v[m] = z; }
#pragma unroll
                        for (int e = 0; e < 4; ++e) {
                            float x[4];
#pragma unroll
                            for (int m = 0; m < 4; ++m) { float t = v[m][e];
                                t += __uint_as_float(__builtin_amdgcn_update_dpp(0, (int)__float_as_uint(t), 0x111, 0xf, 0xf, true));
                                t += __uint_as_float(__builtin_amdgcn_update_dpp(0, (int)__float_as_uint(t), 0x112, 0xf, 0xf, true));
                                t += __uint_as_float(__builtin_amdgcn_update_dpp(0, (int)__float_as_uint(t), 0x114, 0xf, 0xf, true));
                                t += __uint_as_float(__builtin_amdgcn_update_dpp(0, (int)__float_as_uint(t), 0x118, 0xf, 0xf, true));
                                x[m] = t; }
                            x[1] += __shfl(x[0], l15); x[2] += __shfl(x[1], l15); x[3] += __shfl(x[2], l15);
#pragma unroll
                            for (int m = 0; m < 4; ++m) v[m][e] = x[m];
                        }
#pragma unroll
                        for (int m = 0; m < 4; ++m) *(f32x4*)(LOGA + (size_t)(row0 + ai * 128 + m * 16) * 256 + 64 * wc + 32 * bj + 8 * fq + 4 * n) = v[m];
                    }
        } else {
            const int cb = 128 * (pn - 13) + 32 * wc + 8 * fq;
#pragma unroll
            for (int ai = 0; ai < 2; ++ai)
#pragma unroll
                for (int m = 0; m < 4; ++m) {
                    const int row = row0 + ai * 128 + m * 16; const float rs = rowscale[row];
                    f32x4 ra, rb_, ga, gb_;
#pragma unroll
                    for (int e = 0; e < 4; ++e) {
                        float za = fminf(fmaxf(acc[ai][0][m][0][e] * rs, -30.f), 30.f), zb = fminf(fmaxf(acc[ai][1][m][0][e] * rs, -30.f), 30.f);
                        float ea = __builtin_amdgcn_exp2f(-LOG2E * za), eb = __builtin_amdgcn_exp2f(-LOG2E * zb); ga[e] = __builtin_amdgcn_rcpf(1.0f + eb); ra[e] = (1.0f + eb) * __builtin_amdgcn_rcpf(1.0f + ea);
                        za = fminf(fmaxf(acc[ai][0][m][1][e] * rs, -30.f), 30.f); zb = fminf(fmaxf(acc[ai][1][m][1][e] * rs, -30.f), 30.f);
                        ea = __builtin_amdgcn_exp2f(-LOG2E * za); eb = __builtin_amdgcn_exp2f(-LOG2E * zb); gb_[e] = __builtin_amdgcn_rcpf(1.0f + eb); rb_[e] = (1.0f + eb) * __builtin_amdgcn_rcpf(1.0f + ea);
                    }
                    *(u32x4*)(R + (size_t)row * 1024 + cb) = pack8(ra, rb_);
                    *(u32x4*)(GB + (size_t)row * 1024 + cb) = pack8(ga, gb_);
                }
        }
    }
};
struct EpiMerge {
    static constexpr bool PERM = true, CHAIN = true;
    const bf16* R; const bf16* GB; bf16* MRG;
    __device__ __forceinline__ void operator()(f32x4 (&acc)[2][2][4][2], const pg8::Unit& u, int wr, int wc, int fr, int fq) const {
        const int row0 = u.pm * 256 + wr * 64 + fr, col0 = u.pn * 256 + wc * 32 + 8 * fq;
        if (u.sub == 0) {
#pragma unroll
            for (int ai = 0; ai < 2; ++ai)
#pragma unroll
                for (int m = 0; m < 4; ++m)
#pragma unroll
                    for (int bj = 0; bj < 2; ++bj) {
                        const size_t off = (size_t)(row0 + ai * 128 + m * 16) * 1024 + col0 + bj * 128;
                        f32x4 ra, rb_; unpack8(*(const u32x4*)(R + off), ra, rb_);
                        acc[ai][bj][m][0] *= ra; acc[ai][bj][m][1] *= rb_;
                    }
        } else {
#pragma unroll
            for (int ai = 0; ai < 2; ++ai)
#pragma unroll
                for (int m = 0; m < 4; ++m)
#pragma unroll
                    for (int bj = 0; bj < 2; ++bj) {
                        const size_t off = (size_t)(row0 + ai * 128 + m * 16) * 1024 + col0 + bj * 128;
                        f32x4 ga, gb_; unpack8(*(const u32x4*)(GB + off), ga, gb_);
                        *(u32x4*)(MRG + off) = pack8(acc[ai][bj][m][0] * ga, acc[ai][bj][m][1] * gb_);
                    }
        }
    }
};
struct EpiOut {
    static constexpr bool PERM = false, CHAIN = false;
    const float* xres; float* xnew; bf16* xb2;
    __device__ __forceinline__ void operator()(f32x4 (&acc)[2][2][4][2], const pg8::Unit& u, int wr, int wc, int fr, int fq) const {
        const int row0 = u.pm * 256 + wr * 64 + fr, col0 = u.pn * 256 + wc * 32 + 4 * fq;
#pragma unroll
        for (int ai = 0; ai < 2; ++ai)
#pragma unroll
            for (int m = 0; m < 4; ++m) {
                const size_t off = (size_t)(row0 + ai * 128 + m * 16) * 1024 + col0;
#pragma unroll
                for (int bj = 0; bj < 2; ++bj)
#pragma unroll
                    for (int n = 0; n < 2; ++n) { const f32x4 xr = *(const f32x4*)(xres + off + bj * 128 + n * 16); const f32x4 v = xr + acc[ai][bj][m][n]; *(f32x4*)(xnew + off + bj * 128 + n * 16) = v;
                        *(u32x2*)(xb2 + off + bj * 128 + n * 16) = (u32x2){cvt_pk_bf16(v[0], v[1]), cvt_pk_bf16(v[2], v[3])}; }
            }
    }
};
struct EpiGU {
    static constexpr bool PERM = true, CHAIN = false;
    const float* srs; bf16* H;
    __device__ __forceinline__ void operator()(f32x4 (&acc)[2][2][4][2], const pg8::Unit& u, int wr, int wc, int fr, int fq) const {
        const int row0 = u.pm * 256 + wr * 64 + fr, col0 = u.pn * 128 + wc * 32 + 8 * fq;
#pragma unroll
        for (int ai = 0; ai < 2; ++ai)
#pragma unroll
            for (int m = 0; m < 4; ++m) {
                const int row = row0 + ai * 128 + m * 16; const float rs = srs[u.aux + (row - u.pm * 256)];
                f32x4 a, b;
#pragma unroll
                for (int e = 0; e < 4; ++e) { const float g0 = acc[ai][0][m][0][e] * rs, g1 = acc[ai][0][m][1][e] * rs; a[e] = g0 * sigmoidf_(g0) * (acc[ai][1][m][0][e] * rs); b[e] = g1 * sigmoidf_(g1) * (acc[ai][1][m][1][e] * rs); }
                *(u32x4*)(H + (size_t)row * 256 + col0) = pack8(a, b);
            }
    }
};
struct EpiDown {
    static constexpr bool PERM = true, CHAIN = false;
    const float* sw; bf16* Y;
    __device__ __forceinline__ void operator()(f32x4 (&acc)[2][2][4][2], const pg8::Unit& u, int wr, int wc, int fr, int fq) const {
        const int row0 = u.pm * 256 + wr * 64 + fr, col0 = u.pn * 256 + wc * 32 + 8 * fq;
#pragma unroll
        for (int ai = 0; ai < 2; ++ai)
#pragma unroll
            for (int m = 0; m < 4; ++m) {
                const int row = row0 + ai * 128 + m * 16; const float w = sw[u.aux + (row - u.pm * 256)];
#pragma unroll
                for (int bj = 0; bj < 2; ++bj) *(u32x4*)(Y + (size_t)row * 1024 + col0 + bj * 128) = pack8(acc[ai][bj][m][0] * w, acc[ai][bj][m][1] * w);
            }
    }
};

__device__ __forceinline__ void cvt_item(const float* src, int ldn, const float* kscale, bf16* dst, int Kd, int drow0, int k0, LAS float* scr, int lane) {
#pragma unroll 8
    for (int i = 0; i < 32; ++i) { const int kk = 2 * i + (lane >> 5); float v = src[(size_t)(k0 + kk) * ldn + (lane & 31)]; if (kscale) v *= kscale[k0 + kk]; scr[kk * 33 + (lane & 31)] = v; }
    LDS_WAIT(); asm volatile("" ::: "memory");
    const int c = lane & 7;
#pragma unroll
    for (int j = 0; j < 4; ++j) { const int n = (lane >> 3) + 8 * j; const LAS float* s = scr + (8 * c) * 33 + n;
        u32x4 o; o.x = pk2(s[0 * 33], s[1 * 33]); o.y = pk2(s[2 * 33], s[3 * 33]); o.z = pk2(s[4 * 33], s[5 * 33]); o.w = pk2(s[6 * 33], s[7 * 33]);
        *(u32x4*)(dst + (size_t)(drow0 + n) * Kd + k0 + 8 * c) = o; }
    LDS_WAIT(); asm volatile("" ::: "memory");
}
__device__ __forceinline__ void cvt_item_lr(const float* win, const float* gup, int c0, const float* kscale, bf16* dst, int drow0, int k0, LAS float* scr, int lane) {
    float gu[16];
#pragma unroll
    for (int r = 0; r < 16; ++r) gu[r] = gup[r * 256 + c0 + (lane & 31)];
#pragma unroll 4
    for (int i = 0; i < 32; ++i) { const int kk = 2 * i + (lane >> 5); const float* wr_ = win + (size_t)(k0 + kk) * IN_COLS + 3072; float v = 0.f;
#pragma unroll
        for (int r = 0; r < 16; ++r) v += wr_[r] * gu[r];
        scr[kk * 33 + (lane & 31)] = v * kscale[k0 + kk]; }
    LDS_WAIT(); asm volatile("" ::: "memory");
    const int c = lane & 7;
#pragma unroll
    for (int j = 0; j < 4; ++j) { const int n = (lane >> 3) + 8 * j; const LAS float* s = scr + (8 * c) * 33 + n;
        u32x4 o; o.x = pk2(s[0 * 33], s[1 * 33]); o.y = pk2(s[2 * 33], s[3 * 33]); o.z = pk2(s[4 * 33], s[5 * 33]); o.w = pk2(s[6 * 33], s[7 * 33]);
        *(u32x4*)(dst + (size_t)(drow0 + n) * D + k0 + 8 * c) = o; }
    LDS_WAIT(); asm volatile("" ::: "memory");
}
__device__ __forceinline__ void phase_weights(const Frame& F, ArgsP a, int l) {
    LAS float* scr = (LAS float*)(F.lds + F.wave * 16384);
    const int gw = F.vcu * 8 + F.wave, NGW = F.G * 8, lane = F.lane;
    const float* win = a->in[2] + (size_t)l * D * IN_COLS; const float* gmix = a->in[1] + l * D; const float* gup = a->in[6] + l * 16 * 256;
    bf16* WIN = (bf16*)(F.ws + WS_WIN); bf16* PA = (bf16*)(F.ws + WS_PA); bf16* PB = (bf16*)(F.ws + WS_PB); bf16* WOUT = (bf16*)(F.ws + WS_WOUT); bf16* WGU = (bf16*)(F.ws + WS_WGU); bf16* WD = (bf16*)(F.ws + WS_WD);
    constexpr int I0 = (NIN / 32) * 16, I1 = 32 * 8, I2 = 32 * 8, I3 = 32 * 16, I4 = NE * 16 * 16, I5 = NE * 32 * 4;
    for (int it = gw; it < I0 + I1 + I2 + I3 + I4 + I5; it += NGW) {
        int r = it;
        if (r < I0) { const int nb = r >> 4, kb = r & 15, P = nb * 32, pn = P >> 8, p = P & 255;
            if (pn == 12) { const int c0 = 64 * ((p >> 5) & 3) + 32 * (p >> 7); cvt_item_lr(win, gup, c0, gmix, WIN, P, kb * 64, scr, lane); }
            else { const int src = pn < 12 ? 256 * pn + 64 * ((p >> 5) & 3) + 32 * (p >> 7) : 3088 + 1024 * (p >> 7) + 128 * (pn - 13) + (p & 127);
                   cvt_item(win + src, IN_COLS, gmix, WIN, D, P, kb * 64, scr, lane); }
            continue; } r -= I0;
        if (r < I1) { const int nb = r >> 3, kb = r & 7; cvt_item(a->in[9] + (size_t)l * 512 * D + nb * 32, D, nullptr, PA, 512, nb * 32, kb * 64, scr, lane); continue; } r -= I1;
        if (r < I2) { const int nb = r >> 3, kb = r & 7; cvt_item(a->in[10] + (size_t)l * 512 * D + nb * 32, D, nullptr, PB, 512, nb * 32, kb * 64, scr, lane); continue; } r -= I2;
        if (r < I3) { const int nb = r >> 4, kb = r & 15; cvt_item(a->in[11] + (size_t)l * D * D + nb * 32, D, nullptr, WOUT, D, nb * 32, kb * 64, scr, lane); continue; } r -= I3;
        if (r < I4) { const int e = r >> 8, nb = (r >> 4) & 15, kb = r & 15, p0 = nb * 32; const int j0 = 128 * (p0 >> 8) + (p0 & 127);
            const float* src = ((p0 >> 7) & 1 ? a->in[18] : a->in[17]) + ((size_t)(l * NE + e) * D) * DE + j0;
            cvt_item(src, DE, a->in[12] + l * D, WGU + (size_t)e * 512 * D, D, p0, kb * 64, scr, lane); continue; } r -= I4;
        { const int e = r >> 7, nb = (r >> 2) & 31, kb = r & 3;
            cvt_item(a->in[19] + ((size_t)(l * NE + e) * DE) * D + nb * 32, D, nullptr, WD + (size_t)e * D * DE, DE, nb * 32, kb * 64, scr, lane); }
    }
    bf16* WRh = (bf16*)(F.ws + WS_WR); bf16* WRl = WRh + 48 * D; const float* gf = a->in[12] + l * D; const float* wg = a->in[13] + (size_t)l * D * 4; const float* wrt = a->in[15] + (size_t)l * D * 32;
    for (int i = (F.vcu * 512 + F.tid); i < 48 * D; i += F.G * 512) { const int n = i >> 10, k = i & 1023; const float v = n < 36 ? gf[k] * (n < 4 ? wg[k * 4 + n] : wrt[k * 32 + n - 4]) : 0.f;
        const unsigned hi = f2bf(v); WRh[i] = (bf16)hi; WRl[i] = (bf16)f2bf(v - __uint_as_float(hi << 16)); }
}
__device__ __forceinline__ void phase_x_to_xb(const Frame& F, const float* x) {
    bf16* XB = (bf16*)(F.ws + WS_XB); float* RS = (float*)(F.ws + WS_RS1);
    const int gw = F.vcu * 8 + F.wave, NGW = F.G * 8;
    for (int m = gw; m < T; m += NGW) {
        const f32x4* xr = (const f32x4*)(x + (size_t)m * D) + F.lane; f32x4 v[4]; float s = 0.f;
#pragma unroll
        for (int j = 0; j < 4; ++j) { v[j] = xr[64 * j]; s += (v[j][0] * v[j][0] + v[j][1] * v[j][1]) + (v[j][2] * v[j][2] + v[j][3] * v[j][3]); }
        s = wave_sum(s);
        u32x2* o = (u32x2*)(XB + (size_t)m * D) + F.lane;
#pragma unroll
        for (int j = 0; j < 4; ++j) { u32x2 w; w.x = pk2(v[j][0], v[j][1]); w.y = pk2(v[j][2], v[j][3]); o[64 * j] = w; }
        if (F.lane == 0) RS[m] = rsqrtf(s * (1.0f / D) + EPS);
    }
}

__device__ __forceinline__ void phase_attn_naive(const Frame& F, ArgsP a, int l) {
    constexpr int KP = 136, VP = 128;
    LAS unsigned char* Ks = F.lds; LAS unsigned char* Vs = F.lds + 576 * KP;
    const bf16* Qb = (const bf16*)(F.ws + WS_Q); const bf16* Kb = (const bf16*)(F.ws + WS_K); const bf16* Vb = (const bf16*)(F.ws + WS_V); bf16* YA = (bf16*)(F.ws + WS_YA);
    const float* rb = a->in[5]; const int lane = F.lane;
    for (int u = F.vcu; u < 4096; u += F.G) {
        const int c = u & 31, h = (u >> 5) & 7, b = u >> 8, t0 = b * SEQ + c * 64;
        __syncthreads();
        for (int i = F.tid; i < 576 * 8; i += 512) { const int kk = i >> 3, ch = i & 7, jb = kk >> 6; u32x4 kv = (u32x4){0u, 0u, 0u, 0u}, vv = kv;
            if (c - 8 + jb >= 0) { const size_t off = (size_t)(t0 - 512 + kk) * 512 + h * 64 + ch * 8; kv = *(const u32x4*)(Kb + off); vv = *(const u32x4*)(Vb + off); }
            *(LAS u32x2*)(Ks + kk * KP + ch * 16) = (u32x2){kv.x, kv.y}; *(LAS u32x2*)(Ks + kk * KP + ch * 16 + 8) = (u32x2){kv.z, kv.w};
            *(LAS u32x4*)(Vs + kk * VP + ch * 16) = vv; }
        __syncthreads();
        const float mq = wave_max(fabsf(a->in[3][(l * 8 + h) * 64 + lane])), mk = wave_max(fabsf(a->in[4][(l * 8 + h) * 64 + lane]));
        float mb = 0.f; for (int i = lane; i < 257; i += 64) mb = fmaxf(mb, fabsf(rb[i * 8 + h])); mb = wave_max(mb);
        const float M2 = LOG2E * (8.0f * mq * mk + mb);
        for (int qq = 0; qq < 8; ++qq) {
            const int qi = 8 * F.wave + qq, t = t0 + qi;
            const float qv = bf2f(Qb[(size_t)t * 512 + h * 64 + lane]);
            float p[9]; float lsum = 0.f;
#pragma unroll
            for (int j = 0; j < 9; ++j) {
                float s = 0.f; const LAS unsigned char* kr = Ks + (64 * j + lane) * KP;
#pragma unroll
                for (int d4 = 0; d4 < 16; ++d4) { const u32x2 w = *(const LAS u32x2*)(kr + d4 * 8);
                    s += rdlane(qv, 4 * d4) * bflo(w.x) + rdlane(qv, 4 * d4 + 1) * bfhi(w.x) + rdlane(qv, 4 * d4 + 2) * bflo(w.y) + rdlane(qv, 4 * d4 + 3) * bfhi(w.y); }
                int idx = 64 * (8 - j) + qi - lane; idx = (idx > 128 ? 128 : idx) + 128;
                const float bias = rb[idx * 8 + h] * LOG2E;
                p[j] = (c - 8 + j >= 0) ? exp2f(s + bias - M2) : 0.f; lsum += p[j];
            }
            lsum = wave_sum(lsum);
            float o = 0.f;
#pragma unroll
            for (int j = 0; j < 9; ++j)
                for (int i = 0; i < 64; ++i) o += rdlane(p[j], i) * bf2f(*(const LAS bf16*)(Vs + (64 * j + i) * VP + lane * 2));
            YA[(size_t)t * 512 + h * 64 + lane] = (bf16)f2bf(o / lsum);
        }
    }
}


typedef float f32x16 __attribute__((ext_vector_type(16)));
typedef short s16x4 __attribute__((ext_vector_type(4)));
#define MFMA32(a, b, c) __builtin_amdgcn_mfma_f32_32x32x16_bf16((a), (b), (c), 0, 0, 0)
__device__ __forceinline__ unsigned cvtpk(float lo, float hi) { typedef float f2_ __attribute__((ext_vector_type(2))); typedef __bf16 b2_ __attribute__((ext_vector_type(2))); f2_ v = {lo, hi}; b2_ b = __builtin_convertvector(v, b2_); return __builtin_bit_cast(unsigned, b); }
__device__ __forceinline__ u32x4 pack8c(f32x4 a, f32x4 b) { u32x4 w; w.x = cvtpk(a[0], a[1]); w.y = cvtpk(a[2], a[3]); w.z = cvtpk(b[0], b[1]); w.w = cvtpk(b[2], b[3]); return w; }
__device__ __forceinline__ s16x4 tr_read(const LAS unsigned char* p) { return __builtin_amdgcn_ds_read_tr16_b64_v4i16((LAS s16x4*)p); }
__device__ __forceinline__ bf16x8 pack_step(const f32x16& x, int s) {
    u32x4 p; p.x = cvtpk(x[8 * s], x[8 * s + 1]); p.y = cvtpk(x[8 * s + 2], x[8 * s + 3]); p.z = cvtpk(x[8 * s + 4], x[8 * s + 5]); p.w = cvtpk(x[8 * s + 6], x[8 * s + 7]);
    return __builtin_bit_cast(bf16x8, p);
}
constexpr int ATT_K = 0, ATT_V = 16384, ATT_TBL = 32768;
__device__ __forceinline__ void attn_unit(const Frame& F, ArgsP a, int l, int u) {
    const int lane = F.lane, w = F.wave, r = lane & 31, hl = lane >> 5;
    const int ci = (w < 4) ? (w >> 1) : (3 - ((w - 4) >> 1));
    const int qh = w & 1;
    const int cq = u & 7, h = (u >> 3) & 7, b = u >> 6, c0 = 4 * cq, t0 = b * SEQ + c0 * 64;
    const bf16* Qb = (const bf16*)(F.ws + WS_Q); const bf16* Kb = (const bf16*)(F.ws + WS_K); const bf16* Vb = (const bf16*)(F.ws + WS_V); bf16* YA = (bf16*)(F.ws + WS_YA);
    LAS unsigned char* Ks = F.lds + ATT_K; LAS unsigned char* Vs = F.lds + ATT_V; LAS float* tbl = (LAS float*)(F.lds + ATT_TBL);
    const float* rb = a->in[5];
    const float mq = wave_max(fabsf(a->in[3][(l * 8 + h) * 64 + lane])), mk = wave_max(fabsf(a->in[4][(l * 8 + h) * 64 + lane]));
    float mb = 0.f; for (int i = lane; i < 257; i += 64) mb = fmaxf(mb, fabsf(rb[i * 8 + h])); mb = wave_max(mb);
    const float M2 = LOG2E * (8.0f * mq * mk + mb);
    __syncthreads();
    for (int i = F.tid; i < 257; i += 512) tbl[i] = rb[i * 8 + h] * LOG2E - M2;
    const int qrow = t0 + ci * 64 + qh * 32 + r;
    bf16x8 qf[4];
#pragma unroll
    for (int s = 0; s < 4; ++s) qf[s] = *(const bf16x8*)(Qb + (size_t)qrow * 512 + h * 64 + 16 * s + 8 * hl);
    const int jmin = (8 - c0) > 0 ? (8 - c0) : 0;
    const int key = F.tid >> 3, ch = F.tid & 7;
    const long g0 = (long)(t0 - 512 + key) * 512 + h * 64 + ch * 8;
    const int kst = key * 128 + ((ch ^ ((key >> 1) & 7)) << 4);
    const int vst = ((key >> 3) * 2 + (ch >> 2)) * 512 + (key & 7) * 64 + (ch & 3) * 16;
    u32x4 kreg = *(const u32x4*)(Kb + g0 + (long)jmin * 64 * 512), vreg = *(const u32x4*)(Vb + g0 + (long)jmin * 64 * 512);
    *(LAS u32x4*)(Ks + kst) = kreg; *(LAS u32x4*)(Vs + vst) = vreg;
    __syncthreads();
    const float cb = tbl[256];
    const int qi = 32 * qh + r;
    const int kro = r * 128, ksw = (r >> 1) & 7;
    const int g16 = lane >> 4, i16 = lane & 15;
    const int vro = (4 * (g16 >> 1) + (i16 >> 2)) * 64 + (16 * (g16 & 1) + 4 * (i16 & 3)) * 2;
    f32x16 o[2]; float lsum = 0.f;
#pragma unroll
    for (int i = 0; i < 16; ++i) { o[0][i] = 0.f; o[1][i] = 0.f; }
    for (int j = jmin; j < 12; ++j) {
        const int cur = (j - jmin) & 1;
        if (j + 1 < 12) { kreg = *(const u32x4*)(Kb + g0 + (long)(j + 1) * 64 * 512); vreg = *(const u32x4*)(Vb + g0 + (long)(j + 1) * 64 * 512); }
        if (j >= ci && j <= ci + 8) {
            const LAS unsigned char* Kt = Ks + cur * 8192; const LAS unsigned char* Vt = Vs + cur * 8192;
            f32x16 pr[2];
#pragma unroll
            for (int kh = 0; kh < 2; ++kh) {
                f32x16 acc;
#pragma unroll
                for (int i = 0; i < 16; ++i) acc[i] = 0.f;
#pragma unroll
                for (int s = 0; s < 4; ++s) { const bf16x8 kf = *(const LAS bf16x8*)(Kt + kh * 4096 + kro + (((2 * s + hl) ^ ksw) << 4)); acc = MFMA32(kf, qf[s], acc); }
                pr[kh] = acc;
            }
            const int jp = j - ci;
            if (jp <= 5) {
#pragma unroll
                for (int kh = 0; kh < 2; ++kh)
#pragma unroll
                    for (int i = 0; i < 16; ++i) { const float p = __builtin_amdgcn_exp2f(pr[kh][i] + cb); pr[kh][i] = p; lsum += p; }
            } else {
                const int base = 64 * (8 - jp) + qi - 4 * hl;
#pragma unroll
                for (int kh = 0; kh < 2; ++kh)
#pragma unroll
                    for (int i = 0; i < 16; ++i) { int d = base - 32 * kh - ((i & 3) + 8 * (i >> 2)); d = (d > 128 ? 128 : d) + 128;
                        const float p = __builtin_amdgcn_exp2f(pr[kh][i] + tbl[d]); pr[kh][i] = p; lsum += p; }
            }
#pragma unroll
            for (int s16 = 0; s16 < 4; ++s16) {
                const bf16x8 pb = pack_step(pr[s16 >> 1], s16 & 1);
#pragma unroll
                for (int dh = 0; dh < 2; ++dh) {
                    const s16x4 lo = tr_read(Vt + vro + dh * 512 + (2 * s16) * 1024), hi = tr_read(Vt + vro + dh * 512 + (2 * s16 + 1) * 1024);
                    const bf16x8 va = __builtin_shufflevector(lo, hi, 0, 1, 2, 3, 4, 5, 6, 7);
                    o[dh] = MFMA32(va, pb, o[dh]);
                }
            }
        }
        if (j + 1 < 12) { *(LAS u32x4*)(Ks + (cur ^ 1) * 8192 + kst) = kreg; *(LAS u32x4*)(Vs + (cur ^ 1) * 8192 + vst) = vreg; }
        __syncthreads();
    }
    lsum += __shfl_xor(lsum, 32);
    const float inv = 1.0f / lsum;
    bf16* yo = YA + (size_t)qrow * 512 + h * 64 + 4 * hl;
#pragma unroll
    for (int dh = 0; dh < 2; ++dh)
#pragma unroll
        for (int g = 0; g < 4; ++g) { u32x2 wv; wv.x = cvtpk(o[dh][4 * g] * inv, o[dh][4 * g + 1] * inv); wv.y = cvtpk(o[dh][4 * g + 2] * inv, o[dh][4 * g + 3] * inv); *(u32x2*)(yo + 32 * dh + 8 * g) = wv; }
}
__device__ __forceinline__ void phase_attn(const Frame& F, ArgsP a, int l) {
    const int bx = blockIdx.x, G = F.G;
    if (G >= 8) { if ((bx & 3) == 0) return; const int k = bx - (bx >> 2) - 1, NA = G - ((G + 3) >> 2); for (int u = k; u < 1024; u += NA) attn_unit(F, a, l, u); }
    else for (int u = bx; u < 1024; u += G) attn_unit(F, a, l, u);
}

constexpr int GL_QT = 0, GL_KH = 8704, GL_AT = 16896, GL_V = 25088, GL_D = 41472, GL_BUF = 41728, GL_SS = 2 * GL_BUF, GL_GN = GL_SS + 2048;
#define GL_BARRIER() do { asm volatile("s_waitcnt lgkmcnt(0)" ::: "memory"); __builtin_amdgcn_s_barrier(); asm volatile("" ::: "memory"); } while (0)
#define GL_AMP(k, t0) do { if (PROBE_PHASE == (k)) { const unsigned long long t1_ = __builtin_amdgcn_s_memrealtime(); const unsigned long long dt_ = t1_ - (t0); while (__builtin_amdgcn_s_memrealtime() - t1_ < dt_) __builtin_amdgcn_s_sleep(2); } } while (0)
template <bool DIAG>
__device__ __forceinline__ void gla_prep_qk(LAS unsigned char* L, const bf16* BQ, const bf16* BK, const float* CB, int b, int h, int it, int jt, int lane_) {
    asm volatile("" : "+v"(lane_));
    const int r = lane_ & 31, hl = lane_ >> 5;
    u32x4 qraw[4], kraw[4]; f32x4 bq[4][2], bx[4][2];
    auto load = [&](int c) {
        const size_t tb_ = (size_t)b * SEQ + (size_t)c * 64; const size_t qo = (tb_ + 32 * it + r) * 256 + h * 64 + 8 * hl, ko = (tb_ + 32 * jt + r) * 256 + h * 64 + 8 * hl, xo = DIAG ? (tb_ + 63) * 256 + h * 64 + 8 * hl : ko;
#pragma unroll
        for (int s = 0; s < 4; ++s) { qraw[s] = *(const u32x4*)(BQ + qo + 16 * s); kraw[s] = *(const u32x4*)(BK + ko + 16 * s);
            bq[s][0] = *(const f32x4*)(CB + qo + 16 * s); bq[s][1] = *(const f32x4*)(CB + qo + 16 * s + 4); bx[s][0] = *(const f32x4*)(CB + xo + 16 * s); bx[s][1] = *(const f32x4*)(CB + xo + 16 * s + 4); }
    };
    auto prep = [&](int c) {
        LAS unsigned char* B_ = L + (c & 1) * GL_BUF; bf16x8 qt[4], kt[4];
#pragma unroll
        for (int s = 0; s < 4; ++s) {
            f32x4 q0, q1, k0, k1; unpack8(qraw[s], q0, q1); unpack8(kraw[s], k0, k1); f32x4 eq0, eq1, ek0, ek1;
#pragma unroll
            for (int e = 0; e < 4; ++e) { eq0[e] = __expf(bq[s][0][e]); eq1[e] = __expf(bq[s][1][e]); ek0[e] = __expf(DIAG ? -bq[s][0][e] : -bx[s][0][e]); ek1[e] = __expf(DIAG ? -bq[s][1][e] : -bx[s][1][e]); }
            const u32x4 qp = pack8c(q0 * eq0, q1 * eq1), kp = pack8c(k0 * ek0, k1 * ek1); qt[s] = __builtin_bit_cast(bf16x8, qp); kt[s] = __builtin_bit_cast(bf16x8, kp);
            if (DIAG) {
                f32x4 eh0, eh1;
#pragma unroll
                for (int e = 0; e < 4; ++e) { eh0[e] = __expf(bx[s][0][e] - bq[s][0][e]); eh1[e] = __expf(bx[s][1][e] - bq[s][1][e]); }
                const int t_ = 32 * it + r, dk_ = 16 * s + 8 * hl;
                *(LAS u32x2*)(B_ + GL_QT + t_ * 136 + dk_ * 2) = (u32x2){qp.x, qp.y}; *(LAS u32x2*)(B_ + GL_QT + t_ * 136 + dk_ * 2 + 8) = (u32x2){qp.z, qp.w};
                *(LAS u32x4*)(B_ + GL_KH + ((t_ >> 3) * 2 + (dk_ >> 5)) * 512 + (t_ & 7) * 64 + (dk_ & 31) * 2) = pack8c(k0 * eh0, k1 * eh1);
            }
        }
        f32x16 at_;
#pragma unroll
        for (int i = 0; i < 16; ++i) at_[i] = 0.f;
#pragma unroll
        for (int s = 0; s < 4; ++s) at_ = MFMA32(kt[s], qt[s], at_);
        const int i_ = 32 * it + r;
#pragma unroll
        for (int g = 0; g < 4; ++g) { float x0 = at_[4 * g], x1 = at_[4 * g + 1], x2 = at_[4 * g + 2], x3 = at_[4 * g + 3];
            if (DIAG) { const int j0 = 8 * g + 4 * hl; x0 = (r >= j0) ? x0 : 0.f; x1 = (r >= j0 + 1) ? x1 : 0.f; x2 = (r >= j0 + 2) ? x2 : 0.f; x3 = (r >= j0 + 3) ? x3 : 0.f; }
            *(LAS u32x2*)(B_ + GL_AT + i_ * 128 + (((4 * jt + g) ^ ((i_ >> 1) & 7)) << 4) + 8 * hl) = (u32x2){cvtpk(x0, x1), cvtpk(x2, x3)}; }
    };
    load(0); prep(0); load(1);
    GL_BARRIER();
    for (int c = 0; c < 32; ++c) {
        const unsigned long long tq0 = (PROBE_PHASE == 21) ? __builtin_amdgcn_s_memrealtime() : 0ull;
        if (c + 1 < 32) { prep(c + 1); if (c + 2 < 32) load(c + 2); }
        GL_AMP(21, tq0);
        GL_BARRIER();
    }
}
__device__ __forceinline__ void gla_prep_v(LAS unsigned char* L, const bf16* BV, const float* CB, int b, int h, int lane) {
    asm volatile("" : "+v"(lane));
    u32x4 vraw[16]; float draw;
    auto load = [&](int c) { const size_t tb_ = (size_t)b * SEQ + (size_t)c * 64;
#pragma unroll
        for (int k = 0; k < 16; ++k) { const int pi = lane + 64 * k; vraw[k] = *(const u32x4*)(BV + (tb_ + (pi >> 4)) * 512 + h * 128 + (pi & 15) * 8); }
        draw = CB[(tb_ + 63) * 256 + h * 64 + lane]; };
    auto prep = [&](int c) { LAS unsigned char* B_ = L + (c & 1) * GL_BUF;
#pragma unroll
        for (int k = 0; k < 16; ++k) { const int pi = lane + 64 * k, t_ = pi >> 4, c16 = pi & 15; *(LAS u32x4*)(B_ + GL_V + ((t_ >> 3) * 4 + (c16 >> 2)) * 512 + (t_ & 7) * 64 + (c16 & 3) * 16) = vraw[k]; }
        *(LAS float*)(B_ + GL_D + 4 * lane) = __expf(draw); };
    load(0); prep(0); load(1);
    GL_BARRIER();
    for (int c = 0; c < 32; ++c) {
        if (c + 1 < 32) { prep(c + 1); if (c + 2 < 32) load(c + 2); }
        GL_BARRIER();
    }
}
__device__ __forceinline__ void gla_state(LAS unsigned char* L, const bf16* BR, bf16* YB, int b, int h, int n, int lane) {
    asm volatile("" : "+v"(lane));
    const int r = lane & 31, hl = lane >> 5, g16 = lane >> 4, i16 = lane & 15;
    const int tro = (i16 >> 2) * 64 + (16 * (g16 & 1) + 4 * (i16 & 3)) * 2;
    f32x16 S[2], o[2]; u32x2 op[2][4], brp[2][4];
#pragma unroll
    for (int i = 0; i < 16; ++i) { S[0][i] = 0.f; S[1][i] = 0.f; }
    const size_t yo0 = ((size_t)b * SEQ + r) * 512 + h * 128 + 32 * n + 4 * hl;
    LAS float* SSb = (LAS float*)(L + GL_SS); const LAS float* GN = (const LAS float*)(L + GL_GN) + 32 * n + 4 * hl;
    GL_BARRIER();
    for (int c = 0; c <= 32; ++c) {
        if (c > 0) {
            const int par = (c - 1) & 1;
#pragma unroll
            for (int tt = 0; tt < 2; ++tt) { const int t_ = 32 * tt + r; const float tot = SSb[par * 256 + t_] + SSb[par * 256 + 64 + t_] + SSb[par * 256 + 128 + t_] + SSb[par * 256 + 192 + t_];
                const float rn = rsqrtf(tot * (1.0f / 128.0f) + EPS);
#pragma unroll
                for (int g = 0; g < 4; ++g) { const u32x2 rr = brp[tt][g], ov = op[tt][g]; const f32x4 gn = *(const LAS f32x4*)(GN + 8 * g);
                    u32x2 wv; wv.x = cvtpk(bflo(ov.x) * rn * gn[0] * bflo(rr.x), bfhi(ov.x) * rn * gn[1] * bfhi(rr.x)); wv.y = cvtpk(bflo(ov.y) * rn * gn[2] * bflo(rr.y), bfhi(ov.y) * rn * gn[3] * bfhi(rr.y));
                    *(u32x2*)(YB + yo0 + (size_t)(64 * (c - 1) + 32 * tt) * 512 + 8 * g) = wv; } }
        }
        if (c == 32) break;
        const unsigned long long ts0 = (PROBE_PHASE == 22) ? __builtin_amdgcn_s_memrealtime() : 0ull;
        const LAS unsigned char* B_ = L + (c & 1) * GL_BUF;
#pragma unroll
        for (int tt = 0; tt < 2; ++tt)
#pragma unroll
            for (int g = 0; g < 4; ++g) brp[tt][g] = *(const u32x2*)(BR + yo0 + (size_t)(64 * c + 32 * tt) * 512 + 8 * g);
        bf16x8 sp[2][2];
#pragma unroll
        for (int dkt = 0; dkt < 2; ++dkt) { sp[dkt][0] = pack_step(S[dkt], 0); sp[dkt][1] = pack_step(S[dkt], 1); }
#pragma unroll
        for (int tt = 0; tt < 2; ++tt) {
            f32x16 acc;
#pragma unroll
            for (int i = 0; i < 16; ++i) acc[i] = 0.f;
#pragma unroll
            for (int dkt = 0; dkt < 2; ++dkt)
#pragma unroll
                for (int s = 0; s < 2; ++s) { const LAS unsigned char* qp_ = B_ + GL_QT + (32 * tt + r) * 136 + (32 * dkt + 16 * s + 4 * hl) * 2;
                    const u32x2 lo = *(const LAS u32x2*)qp_, hi = *(const LAS u32x2*)(qp_ + 16); const u32x4 qv = (u32x4){lo.x, lo.y, hi.x, hi.y};
                    acc = MFMA32(sp[dkt][s], __builtin_bit_cast(bf16x8, qv), acc); }
            o[tt] = acc;
        }
        bf16x8 vf[4];
#pragma unroll
        for (int s = 0; s < 4; ++s) { const LAS unsigned char* vp_ = B_ + GL_V + ((2 * s + hl) * 4 + n) * 512 + tro; const s16x4 lo = tr_read(vp_), hi = tr_read(vp_ + 256); vf[s] = __builtin_shufflevector(lo, hi, 0, 1, 2, 3, 4, 5, 6, 7); }
#pragma unroll
        for (int tt = 0; tt < 2; ++tt)
#pragma unroll
            for (int s = 0; s < 4; ++s) { if (tt == 0 && s >= 2) continue;
                const int i_ = 32 * tt + r; const bf16x8 af = *(const LAS bf16x8*)(B_ + GL_AT + i_ * 128 + (((2 * s + hl) ^ ((i_ >> 1) & 7)) << 4));
                o[tt] = MFMA32(vf[s], af, o[tt]); }
#pragma unroll
        for (int dkt = 0; dkt < 2; ++dkt) {
#pragma unroll
            for (int g = 0; g < 4; ++g) { const f32x4 d4 = *(const LAS f32x4*)(B_ + GL_D + (32 * dkt + 8 * g + 4 * hl) * 4);
                S[dkt][4 * g] *= d4[0]; S[dkt][4 * g + 1] *= d4[1]; S[dkt][4 * g + 2] *= d4[2]; S[dkt][4 * g + 3] *= d4[3]; }
#pragma unroll
            for (int s = 0; s < 4; ++s) { const LAS unsigned char* kp_ = B_ + GL_KH + ((2 * s + hl) * 2 + dkt) * 512 + tro; const s16x4 lo = tr_read(kp_), hi = tr_read(kp_ + 256);
                S[dkt] = MFMA32(__builtin_shufflevector(lo, hi, 0, 1, 2, 3, 4, 5, 6, 7), vf[s], S[dkt]); }
        }
#pragma unroll
        for (int tt = 0; tt < 2; ++tt) { float q = 0.f;
#pragma unroll
            for (int i = 0; i < 16; ++i) q += o[tt][i] * o[tt][i];
            q += __shfl_xor(q, 32);
            if (hl == 0) SSb[(c & 1) * 256 + n * 64 + 32 * tt + r] = q;
#pragma unroll
            for (int g = 0; g < 4; ++g) op[tt][g] = (u32x2){cvtpk(o[tt][4 * g], o[tt][4 * g + 1]), cvtpk(o[tt][4 * g + 2], o[tt][4 * g + 3])}; }
        GL_AMP(22, ts0);
        GL_BARRIER();
    }
}
__device__ __forceinline__ void gla_unit(const Frame& F, ArgsP a, int l, int u) {
    const int lane = F.lane, w = __builtin_amdgcn_readfirstlane(F.wave), h = u & 3, b = u >> 2;
    const bf16* BQ = (const bf16*)(F.ws + WS_BQ); const bf16* BK = (const bf16*)(F.ws + WS_BK); const bf16* BV = (const bf16*)(F.ws + WS_BV); const bf16* BR = (const bf16*)(F.ws + WS_BR);
    const float* CB = (const float*)(F.ws + WS_LA); bf16* YB = (bf16*)(F.ws + WS_YB);
    __syncthreads();
    if (F.tid < 128) *(LAS float*)(F.lds + GL_GN + 4 * F.tid) = a->in[8][l * 512 + h * 128 + F.tid];
#ifndef GLA_ROLES
#define GLA_ROLES 31
#endif
    if (w == 4) { if (GLA_ROLES & 1) gla_prep_qk<true>(F.lds, BQ, BK, CB, b, h, 0, 0, lane); }
    else if (w == 5) { if (GLA_ROLES & 2) gla_prep_qk<true>(F.lds, BQ, BK, CB, b, h, 1, 1, lane); }
    else if (w == 6) { if (GLA_ROLES & 4) gla_prep_qk<false>(F.lds, BQ, BK, CB, b, h, 1, 0, lane); }
    else if (w == 7) { if (GLA_ROLES & 8) gla_prep_v(F.lds, BV, CB, b, h, lane); }
    else { if (GLA_ROLES & 16) gla_state(F.lds, BR, YB, b, h, w, lane); }
    __syncthreads();
}
__device__ __forceinline__ void phase_gla(const Frame& F, ArgsP a, int l) {
    const int bx = blockIdx.x;
    if ((bx & 3) == 0) for (int u = bx >> 2; u < 64; u += (F.G + 3) >> 2) gla_unit(F, a, l, u);
}

__device__ __forceinline__ void phase_gla_naive(const Frame& F, ArgsP a, int l) {
    LAS float* qs = (LAS float*)F.lds; LAS float* ks = qs + 4096; LAS float* as = ks + 4096; LAS float* vs = as + 4096; LAS float* os = vs + 8192;
    const bf16* BQ = (const bf16*)(F.ws + WS_BQ); const bf16* BK = (const bf16*)(F.ws + WS_BK); const bf16* BV = (const bf16*)(F.ws + WS_BV); const bf16* BR = (const bf16*)(F.ws + WS_BR);
    const float* LA = (const float*)(F.ws + WS_LA); bf16* YB = (bf16*)(F.ws + WS_YB); const float* og = a->in[8] + l * 512;
    const int j = F.tid >> 2, kq = F.tid & 3;
    for (int u = F.vcu; u < 64; u += F.G) {
        const int h = u & 3, b = u >> 2;
        float S[16];
#pragma unroll
        for (int i = 0; i < 16; ++i) S[i] = 0.f;
        for (int c = 0; c < 32; ++c) {
            const int tb = b * SEQ + c * 64;
            __syncthreads();
            for (int i = F.tid; i < 4096; i += 512) { const int t = i >> 6, dk = i & 63; const size_t off = (size_t)(tb + t) * 256 + h * 64 + dk;
                qs[i] = bf2f(BQ[off]); ks[i] = bf2f(BK[off]); as[i] = __expf(LA[off]); }
            for (int i = F.tid; i < 8192; i += 512) { const int t = i >> 7, dv = i & 127; vs[i] = bf2f(BV[(size_t)(tb + t) * 512 + h * 128 + dv]); }
            __syncthreads();
            for (int t = 0; t < 64; ++t) {
                const float v = vs[t * 128 + j]; float o = 0.f;
#pragma unroll
                for (int i4 = 0; i4 < 4; ++i4) {
                    const f32x4 a4 = *(const LAS f32x4*)(as + t * 64 + 16 * kq + 4 * i4), k4 = *(const LAS f32x4*)(ks + t * 64 + 16 * kq + 4 * i4), q4 = *(const LAS f32x4*)(qs + t * 64 + 16 * kq + 4 * i4);
#pragma unroll
                    for (int e = 0; e < 4; ++e) { S[4 * i4 + e] = a4[e] * S[4 * i4 + e] + k4[e] * v; o += q4[e] * S[4 * i4 + e]; }
                }
                o += __shfl_xor(o, 1); o += __shfl_xor(o, 2);
                if (kq == 0) os[t * 128 + j] = o;
            }
            __syncthreads();
            for (int r = 0; r < 8; ++r) { const int t = 8 * F.wave + r; const float o1 = os[t * 128 + F.lane], o2 = os[t * 128 + 64 + F.lane];
                const float rn = rsqrtf(wave_sum(o1 * o1 + o2 * o2) * (1.0f / 128.0f) + EPS);
                const size_t off = (size_t)(tb + t) * 512 + h * 128 + F.lane;
                YB[off] = (bf16)f2bf(o1 * rn * og[h * 128 + F.lane] * bf2f(BR[off])); YB[off + 64] = (bf16)f2bf(o2 * rn * og[h * 128 + 64 + F.lane] * bf2f(BR[off + 64])); }
        }
    }
}

typedef float f32x4_t __attribute__((ext_vector_type(4)));
constexpr int RT_LG = 0, RT_RS = 8 * 16 * 48 * 4;
__device__ __forceinline__ void phase_router(const Frame& F, ArgsP a, int l, const float* xnew) {
    volatile LAS unsigned* lcnt = (volatile LAS unsigned*)(F.lds + LC_LCNT); volatile LAS unsigned* lbase = (volatile LAS unsigned*)(F.lds + LC_LBASE);
    LAS unsigned* rec = (LAS unsigned*)(F.lds + LC_REC); LAS float* recw = (LAS float*)(F.lds + LC_RECW); LAS float* recrs = (LAS float*)(F.lds + LC_RECRS);
    unsigned* gcnt = F.ctl + CW_GCNT + l * 64; unsigned* TREC = (unsigned*)(F.ws + WS_TREC); int* TOKL = (int*)(F.ws + WS_TOKL); float* TWL = (float*)(F.ws + WS_TWL); float* RSLL = (float*)(F.ws + WS_RSLL);
    const bf16* WRh = (const bf16*)(F.ws + WS_WR); const bf16* WRl = WRh + 48 * D;
    const float* bg = a->in[14] + l * 4; const float* br = a->in[16] + l * 32; const int lane = F.lane, row = lane & 15, kq = lane >> 4;
    LAS float* LG = (LAS float*)(F.lds + RT_LG) + F.wave * 16 * 48; LAS float* RSL = (LAS float*)(F.lds + RT_RS) + F.wave * 16;
    for (int blk = F.vcu; blk < T / 128; blk += F.G) {
        __syncthreads();
        if (F.tid < 32) lcnt[F.tid] = 0u;
        __syncthreads();
        const int t0 = blk * 128 + F.wave * 16;
        const float* xr = xnew + (size_t)(t0 + row) * D + 8 * kq; const bf16* wh = WRh + (size_t)row * D + 8 * kq; const bf16* wl = WRl + (size_t)row * D + 8 * kq;
        f32x4 acc[3]; float ss = 0.f;
#pragma unroll
        for (int nt = 0; nt < 3; ++nt) acc[nt] = (f32x4){0.f, 0.f, 0.f, 0.f};
#pragma unroll 4
        for (int ks = 0; ks < 32; ++ks) {
            const f32x4 x0 = *(const f32x4*)(xr + 32 * ks), x1 = *(const f32x4*)(xr + 32 * ks + 4);
            ss += (x0[0] * x0[0] + x0[1] * x0[1]) + (x0[2] * x0[2] + x0[3] * x0[3]) + (x1[0] * x1[0] + x1[1] * x1[1]) + (x1[2] * x1[2] + x1[3] * x1[3]);
            const u32x4 hp = pack8c(x0, x1); f32x4 h0, h1; unpack8(hp, h0, h1); const u32x4 lp = pack8c(x0 - h0, x1 - h1);
            const bf16x8 ah = __builtin_bit_cast(bf16x8, hp), al = __builtin_bit_cast(bf16x8, lp);
#pragma unroll
            for (int nt = 0; nt < 3; ++nt) { const bf16x8 bh = *(const bf16x8*)(wh + (size_t)nt * 16 * D + 32 * ks), bl = *(const bf16x8*)(wl + (size_t)nt * 16 * D + 32 * ks);
                acc[nt] = __builtin_amdgcn_mfma_f32_16x16x32_bf16(ah, bh, acc[nt], 0, 0, 0); acc[nt] = __builtin_amdgcn_mfma_f32_16x16x32_bf16(al, bh, acc[nt], 0, 0, 0); acc[nt] = __builtin_amdgcn_mfma_f32_16x16x32_bf16(ah, bl, acc[nt], 0, 0, 0); }
        }
        ss += __shfl_xor(ss, 16); ss += __shfl_xor(ss, 32);
        if (kq == 0) RSL[row] = rsqrtf(ss * (1.0f / D) + EPS);
#pragma unroll
        for (int nt = 0; nt < 3; ++nt)
#pragma unroll
            for (int e = 0; e < 4; ++e) LG[(4 * kq + e) * 48 + 16 * nt + row] = acc[nt][e];
        LDS_WAIT(); asm volatile("" ::: "memory");
        if (lane < 16) {
            const int tl = F.wave * 16 + lane, t = t0 + lane; const float rs = RSL[lane]; const LAS float* lg = LG + lane * 48;
            float gl[4];
#pragma unroll
            for (int g = 0; g < 4; ++g) gl[g] = lg[g] * rs + bg[g];
            int gi = 0; float gm = gl[0];
#pragma unroll
            for (int g = 1; g < 4; ++g) if (gl[g] > gm) { gm = gl[g]; gi = g; }
            float Z = 0.f;
#pragma unroll
            for (int g = 0; g < 4; ++g) Z += __expf(gl[g] - gm);
            const float gtop = 1.0f / Z;
            float el[8];
#pragma unroll
            for (int i = 0; i < 8; ++i) el[i] = lg[4 + 8 * gi + i] * rs + br[8 * gi + i];
            int i1 = 0; float m1 = el[0];
#pragma unroll
            for (int i = 1; i < 8; ++i) if (el[i] > m1) { m1 = el[i]; i1 = i; }
            int i2 = -1; float m2 = -3.0e38f;
#pragma unroll
            for (int i = 0; i < 8; ++i) if (i != i1 && el[i] > m2) { m2 = el[i]; i2 = i; }
            const float w1 = 1.0f / (1.0f + __expf(m2 - m1)), w2 = 1.0f - w1;
            const int e1 = gi * 8 + i1, e2 = gi * 8 + i2;
            const unsigned p1 = __hip_atomic_fetch_add((LAS unsigned*)(F.lds + LC_LCNT) + e1, 1u, __ATOMIC_RELAXED, __HIP_MEMORY_SCOPE_WORKGROUP), p2 = __hip_atomic_fetch_add((LAS unsigned*)(F.lds + LC_LCNT) + e2, 1u, __ATOMIC_RELAXED, __HIP_MEMORY_SCOPE_WORKGROUP);
            rec[2 * tl] = ((unsigned)e1 << 16) | p1; rec[2 * tl + 1] = ((unsigned)e2 << 16) | p2; recw[2 * tl] = w1 * gtop; recw[2 * tl + 1] = w2 * gtop;
            recrs[tl] = rs;
        }
        __syncthreads();
        if (F.tid < 32) lbase[F.tid] = __hip_atomic_fetch_add(gcnt + F.tid, lcnt[F.tid], RLX_AGENT);
        __syncthreads();
        if (F.tid < 256) { const unsigned rc = rec[F.tid], e = rc >> 16, pos = (rc & 0xffffu) + lbase[e]; TREC[(size_t)blk * 256 + F.tid] = (e << 16) | pos;
            const size_t li = (size_t)e * 32768 + pos; TOKL[li] = blk * 128 + (F.tid >> 1); TWL[li] = recw[F.tid]; RSLL[li] = recrs[F.tid >> 1]; }
    }
}
__device__ __forceinline__ void build_tiles(const Frame& F, int l) {
    volatile LAS int* tbase = (volatile LAS int*)(F.lds + LC_TBASE); volatile LAS int* tile_e = (volatile LAS int*)(F.lds + LC_TILEE);
    __syncthreads();
    if (F.tid == 0) { int s = 0; for (int e = 0; e < NE; ++e) { tbase[e] = s; const int n = (int)__hip_atomic_load(F.ctl + CW_GCNT + l * 64 + e, RLX_AGENT); s += (n + 255) >> 8; } tbase[NE] = s; }
    __syncthreads();
    if (F.tid < NE) { const int t0 = tbase[F.tid], t1 = tbase[F.tid + 1]; for (int t = t0; t < t1 && t < MAXTILES; ++t) tile_e[t] = F.tid; }
    __syncthreads();
}
constexpr int GT_OFF = 131072;
__device__ __forceinline__ void build_gather(const Frame& F, int l, int NPN) {
    const volatile LAS int* tbase = (const volatile LAS int*)(F.lds + LC_TBASE); const volatile LAS int* tile_e = (const volatile LAS int*)(F.lds + LC_TILEE);
    LAS unsigned* tab = (LAS unsigned*)(F.lds + GT_OFF); const int* TOKL = (const int*)(F.ws + WS_TOKL);
    const int ntiles = tbase[NE];
    for (int i = 0; i < 4; ++i) { const long L = (long)i * F.G + blockIdx.x; if (L >= (long)ntiles * NPN) break;
        const int tile = (int)(L / NPN), e = tile_e[tile], k = tile - tbase[e]; const int ne = (int)__hip_atomic_load(F.ctl + CW_GCNT + l * 64 + e, RLX_AGENT);
        if (F.tid < 256) { const int pos = 256 * k + F.tid; tab[i * 256 + F.tid] = pos < ne ? (unsigned)TOKL[(size_t)e * 32768 + pos] * (unsigned)(D * 2) : 0u; } }
    __syncthreads();
}
__device__ __forceinline__ void phase_final(const Frame& F, float* x, bool make_xb, int lprev) {
    build_tiles(F, lprev);
    const volatile LAS int* tbase = (const volatile LAS int*)(F.lds + LC_TBASE);
    const unsigned* TREC = (const unsigned*)(F.ws + WS_TREC); const bf16* Y = (const bf16*)(F.ws + WS_Y); bf16* XB = (bf16*)(F.ws + WS_XB); float* RS = (float*)(F.ws + WS_RS1);
    const int gw = F.vcu * 8 + F.wave, NGW = F.G * 8;
    for (int t = gw; t < T; t += NGW) {
        const unsigned r0 = TREC[2 * t], r1 = TREC[2 * t + 1];
        const int s0 = 256 * tbase[r0 >> 16] + (int)(r0 & 0xffffu), s1 = 256 * tbase[r1 >> 16] + (int)(r1 & 0xffffu);
        f32x4* xr = (f32x4*)(x + (size_t)t * D) + F.lane; const u32x2* y0 = (const u32x2*)(Y + (size_t)s0 * D) + F.lane; const u32x2* y1 = (const u32x2*)(Y + (size_t)s1 * D) + F.lane;
        f32x4 v[4]; float s = 0.f;
#pragma unroll
        for (int j = 0; j < 4; ++j) { const u32x2 a0 = y0[64 * j], a1 = y1[64 * j]; v[j] = xr[64 * j] + (f32x4){bflo(a0.x), bfhi(a0.x), bflo(a0.y), bfhi(a0.y)} + (f32x4){bflo(a1.x), bfhi(a1.x), bflo(a1.y), bfhi(a1.y)};
            xr[64 * j] = v[j]; s += (v[j][0] * v[j][0] + v[j][1] * v[j][1]) + (v[j][2] * v[j][2] + v[j][3] * v[j][3]); }
        if (make_xb) {
            s = wave_sum(s);
            u32x2* o = (u32x2*)(XB + (size_t)t * D) + F.lane;
#pragma unroll
            for (int j = 0; j < 4; ++j) { u32x2 w; w.x = pk2(v[j][0], v[j][1]); w.y = pk2(v[j][2], v[j][3]); o[64 * j] = w; }
            if (F.lane == 0) RS[t] = rsqrtf(s * (1.0f / D) + EPS);
        }
    }
}

constexpr int PH_PER_LAYER = 16, NPH = DEPTH * PH_PER_LAYER;
#ifndef PH_MASK
#define PH_MASK 0x1ffff
#endif
#ifndef DUP_MASK
#define DUP_MASK 0
#endif
#define PB(k) const unsigned long long pb_t0_ = (PROBE_PHASE == (k)) ? __builtin_amdgcn_s_memrealtime() : 0ull
#define PE(k) do { if (PROBE_PHASE == (k)) { const unsigned long long t1_ = __builtin_amdgcn_s_memrealtime(); const unsigned long long dt_ = t1_ - pb_t0_; while (__builtin_amdgcn_s_memrealtime() - t1_ < dt_) __builtin_amdgcn_s_sleep(8); } } while (0)
#define REP(k) for (int rep_ = 0; rep_ < 1 + ((DUP_MASK >> (k)) & 1); ++rep_)
__global__ void __launch_bounds__(512, 2) fwd_kernel(Args args_unused) {
    extern __shared__ __attribute__((aligned(16))) unsigned char lds_raw[];
    const int wave0 = __builtin_amdgcn_readfirstlane((int)threadIdx.x >> 6);
    {
        LAS unsigned char* lds0 = (LAS unsigned char*)lds_raw;
        for (int u = threadIdx.x; u < (LDS_BYTES - LC_OFF) / 4; u += 512) ((LAS unsigned*)(lds0 + LC_OFF))[u] = 0u;
        __syncthreads();
    }
#if MK_ONE_LAUNCH
    XcdBarrier bar; { ArgsP ap = get_args(); bar = xcd_barrier_post((unsigned*)(ap->ws + WS_CTL) + CW_BAR, (volatile LAS unsigned*)((LAS unsigned char*)lds_raw + LC_MISC) + 8); }
#define GRID_BAR() do { PB(14); xcd_barrier(bar); PE(14); } while (0)
#else
#define GRID_BAR() do { } while (0)
#endif
    int lo, hi; { ArgsP ap = get_args(); lo = ap->ph_lo; hi = ap->ph_hi; }
#define IN(k) (((PH_MASK >> ((k) % PH_PER_LAYER)) & 1) && lo <= (k) && (k) < hi)
#define SEAM(k) GRID_BAR()
    for (int l = 0; l < DEPTH; ++l) {
        const int P = l * PH_PER_LAYER;
        if (IN(P + 0)) REP(0) { PB(0); ArgsP ap = get_args(); const Frame F = make_frame(ap, wave0); if (l == 0) phase_x_to_xb(F, ap->in[0]); else phase_final(F, ap->out, true, l - 1); phase_weights(F, ap, l); PE(0); }
        SEAM(P + 0);
        if (IN(P + 1)) REP(1) { PB(1);
            ArgsP ap = get_args(); const Frame F = make_frame(ap, wave0);
            pg8::DenseOrder S; S.init(T, NIN, D, F.G, (int)blockIdx.x, F.ws + WS_XB, F.ws + WS_WIN);
            EpiIn E{(const float*)(F.ws + WS_RS1), (bf16*)(F.ws + WS_Q), (bf16*)(F.ws + WS_K), (bf16*)(F.ws + WS_V), (bf16*)(F.ws + WS_BQ), (bf16*)(F.ws + WS_BK), (bf16*)(F.ws + WS_BV), (bf16*)(F.ws + WS_BR),
                    (bf16*)(F.ws + WS_R), (bf16*)(F.ws + WS_GB), (float*)(F.ws + WS_LA), ap->in[3] + l * 512, ap->in[4] + l * 512, ap->in[7] + l * 256};
            pg8::gemm_phase<EpiIn, pg8::DenseOrder, PG8_ALIGN, PG8_SP2>(F.lds, D, S, E, F.tid); PE(1);
        }
        SEAM(P + 1);
        if (IN(P + 2)) { PB(2); REP(11) { PB(11); ArgsP ap = get_args(); const Frame F = make_frame(ap, wave0); phase_gla(F, ap, l); PE(11); } if (PH_MASK & 0x10000) REP(12) { PB(12); ArgsP ap = get_args(); const Frame F = make_frame(ap, wave0); phase_attn(F, ap, l); PE(12); } PE(2); }
        SEAM(P + 2);
        if (IN(P + 3)) REP(3) { PB(3);
            ArgsP ap = get_args(); const Frame F = make_frame(ap, wave0);
            pg8::ChainOrder S; S.d0.init(T, D, 512, F.G, (int)blockIdx.x, F.ws + WS_YA, F.ws + WS_PA); S.d1.init(T, D, 512, F.G, (int)blockIdx.x, F.ws + WS_YB, F.ws + WS_PB);
            EpiMerge E{(const bf16*)(F.ws + WS_R), (const bf16*)(F.ws + WS_GB), (bf16*)(F.ws + WS_MRG)};
            pg8::gemm_phase<EpiMerge, pg8::ChainOrder, PG8_ALIGN, PG8_SP2>(F.lds, 512, S, E, F.tid); PE(3);
        }
        SEAM(P + 3);
        if (IN(P + 5)) { PB(5);
            ArgsP ap = get_args(); const Frame F = make_frame(ap, wave0);
            pg8::DenseOrder S; S.init(T, D, D, F.G, (int)blockIdx.x, F.ws + WS_MRG, F.ws + WS_WOUT);
            EpiOut E{(l == 0) ? ap->in[0] : (const float*)ap->out, ap->out, (bf16*)(F.ws + WS_XB2)};
            pg8::gemm_phase<EpiOut, pg8::DenseOrder, PG8_ALIGN, PG8_SP2>(F.lds, D, S, E, F.tid); PE(5);
        }
        SEAM(P + 5);
        if (IN(P + 6)) { PB(6); ArgsP ap = get_args(); const Frame F = make_frame(ap, wave0); phase_router(F, ap, l, ap->out); PE(6); }
        SEAM(P + 6);
        if (IN(P + 8)) REP(8) { PB(8);
            ArgsP ap = get_args(); const Frame F = make_frame(ap, wave0);
            build_tiles(F, l); build_gather(F, l, 2);
            pg8::ExpertOrderT<true> S; S.tile_e = (const LAS int*)(F.lds + LC_TILEE); S.tbase = (const LAS int*)(F.lds + LC_TBASE); S.tab = (const LAS unsigned*)(F.lds + GT_OFF);
            S.ntiles = __builtin_amdgcn_readfirstlane(*(const LAS int*)(F.lds + LC_TBASE + 4 * NE)); S.NPN = 2; S.G = F.G; S.c = (int)blockIdx.x;
            S.A = (const char*)(F.ws + WS_XB2); S.B = (const char*)(F.ws + WS_WGU); S.a_tile = 0; S.b_exp = (size_t)512 * D * 2; S.b_pn = (size_t)256 * D * 2;
            EpiGU E{(const float*)(F.ws + WS_RSLL), (bf16*)(F.ws + WS_H)};
            pg8::gemm_phase<EpiGU, pg8::ExpertOrderT<true>, PG8_ALIGN, PG8_SP2>(F.lds, D, S, E, F.tid); PE(8);
        }
        SEAM(P + 8);
        if (IN(P + 9)) REP(9) { PB(9);
            ArgsP ap = get_args(); const Frame F = make_frame(ap, wave0);
            build_tiles(F, l);
            pg8::ExpertOrderT<false> S; S.tile_e = (const LAS int*)(F.lds + LC_TILEE); S.tbase = (const LAS int*)(F.lds + LC_TBASE); S.tab = nullptr;
            S.ntiles = __builtin_amdgcn_readfirstlane(*(const LAS int*)(F.lds + LC_TBASE + 4 * NE)); S.NPN = 4; S.G = F.G; S.c = (int)blockIdx.x;
            S.A = (const char*)(F.ws + WS_H); S.B = (const char*)(F.ws + WS_WD); S.a_tile = (size_t)256 * DE * 2; S.b_exp = (size_t)D * DE * 2; S.b_pn = (size_t)256 * DE * 2;
            EpiDown E{(const float*)(F.ws + WS_TWL), (bf16*)(F.ws + WS_Y)};
            pg8::gemm_phase<EpiDown, pg8::ExpertOrderT<false>, PG8_ALIGN, PG8_SP2>(F.lds, DE, S, E, F.tid); PE(9);
        }
        GRID_BAR();
    }
    { PB(15); ArgsP ap = get_args(); const Frame F = make_frame(ap, wave0); phase_final(F, ap->out, false, DEPTH - 1); PE(15); }
#undef IN
#undef SEAM
}

extern "C" void kernel_launch(void* const* d_in, const int* in_sizes, int n_in, void* d_out, int out_size, void* d_ws, size_t ws_size, hipStream_t stream) {
    static int grid = 0;
    if (grid == 0) {
        if (n_in != 20 || in_sizes[0] != T * D || out_size != T * D || ws_size < WS_END) { fprintf(stderr, "kernel_launch: unexpected shapes (n_in %d, in0 %d, out %d, ws %zu); nothing launched\n", n_in, n_in > 0 ? in_sizes[0] : -1, out_size, ws_size); grid = -1; return; }
        int dev = 0, cus = 0;
        if (hipGetDevice(&dev) != hipSuccess || hipDeviceGetAttribute(&cus, hipDeviceAttributeMultiprocessorCount, dev) != hipSuccess) { grid = -1; return; }
        if (hipFuncSetAttribute((const void*)fwd_kernel, hipFuncAttributeMaxDynamicSharedMemorySize, LDS_BYTES) != hipSuccess) { fprintf(stderr, "kernel_launch: hipFuncSetAttribute failed\n"); grid = -1; return; }
        grid = cus;
    }
    if (grid < 0) return;
    (void)hipMemsetAsync((char*)d_ws + WS_CTL, 0, CTL_ZERO_BYTES, stream);
    Args a{};
    for (int i = 0; i < 20; ++i) a.in[i] = (const float*)d_in[i];
    a.out = (float*)d_out; a.ws = (unsigned char*)d_ws;
#if MK_ONE_LAUNCH
    a.ph_lo = 0; a.ph_hi = NPH;
    hipLaunchKernelGGL(fwd_kernel, dim3(grid), dim3(512), LDS_BYTES, stream, a);
#else
    for (int l = 0; l < DEPTH; ++l)
        for (int p = 0; p <= 10; ++p) { a.ph_lo = l * PH_PER_LAYER + p; a.ph_hi = a.ph_lo + 1; hipLaunchKernelGGL(fwd_kernel, dim3(grid), dim3(512), LDS_BYTES, stream, a); }
#endif
}
```

```cpp
#include <hip/hip_runtime.h>
#include <cstdio>
#include <cstdint>

#ifndef PROBE_PHASE
#define PROBE_PHASE -1
#endif
#ifndef MK_ONE_LAUNCH
#define MK_ONE_LAUNCH 1
#endif

#define LAS __attribute__((address_space(3)))
#define GAS __attribute__((address_space(1)))
typedef unsigned short bf16;
typedef short bf16x8 __attribute__((ext_vector_type(8)));
typedef float f32x4 __attribute__((ext_vector_type(4)));
typedef float f32x2 __attribute__((ext_vector_type(2)));
typedef unsigned u32x4 __attribute__((ext_vector_type(4)));
typedef unsigned u32x2 __attribute__((ext_vector_type(2)));

constexpr int T = 32768, D = 1024, SEQ = 2048, DEPTH = 2;
constexpr int IN_COLS = 5136, NIN = 5376;
constexpr int NE = 32, DE = 256;
constexpr int MAXTILES = 288;
constexpr float EPS = 1e-6f, LOG2E = 1.4426950408889634f;

namespace pg8 {
constexpr int BM = 256, BK = 64, HALF = 128, HTB = HALF * BK * 2  , STAGE_BYTES = 8 * HTB, NXCD = 8, WGM = 8;
__host__ __device__ __forceinline__ int lds_byte(int r, int c) { const int st = (r >> 4) * 2 + (c >> 5), rr = r & 15, cc = c & 31, ob = rr * 64 + cc * 2; return st * 1024 + (ob ^ (((ob >> 9) & 1) << 5)); }
__host__ __device__ __forceinline__ void stage_rc(int b, int& R, int& C) { const int st = b / 1024, sb = b % 1024, swz = sb ^ (((sb >> 9) & 1) << 5); R = (st >> 1) * 16 + swz / 64; C = (st & 1) * 32 + (swz % 64) / 2; }
__host__ __device__ __forceinline__ int perm32(int rho) { const int n = rho >> 4, i = rho & 15; return 8 * (i >> 2) + 4 * n + (i & 3); }

struct Unit { int pm, pn; const char* A; const char* B; int sub, aux; };

struct DenseOrder {
    static constexpr bool GATHER = false;
    int nM, nN, nwg, G, c; const char* A; const char* Bt; size_t tstep;
    __device__ void init(int M, int N, int K, int G_, int c_, const void* A_, const void* Bt_) { nM = M / BM; nN = N / BM; nwg = nM * nN; G = G_; c = c_; A = (const char*)A_; Bt = (const char*)Bt_; tstep = (size_t)BM * K * 2; }
    __device__ bool next(int i, Unit& u) const {
        const long L = (long)i * G + c; if (L >= nwg) return false;
        int wgid = (int)L; { const int q = nwg / NXCD, r = nwg % NXCD, xcd = wgid % NXCD, off = wgid / NXCD; wgid = (xcd < r ? xcd * (q + 1) : r * (q + 1) + (xcd - r) * q) + off; }
        const int nig = WGM * nN, gid = wgid / nig, fm = gid * WGM, gsz = (nM - fm) < WGM ? (nM - fm) : WGM;
        u.pm = fm + ((wgid % nig) % gsz); u.pn = (wgid % nig) / gsz; u.A = A + (size_t)u.pm * tstep; u.B = Bt + (size_t)u.pn * tstep; u.sub = 0; return true;
    }
    __device__ __forceinline__ void a_ready(const Unit&) const {}
    __device__ __forceinline__ void done(const Unit&) const {}
};
struct ChainOrder {
    static constexpr bool GATHER = false;
    DenseOrder d0, d1;
    __device__ bool next(int i, Unit& u) const { const bool ok = (i & 1) ? d1.next(i >> 1, u) : d0.next(i >> 1, u); u.sub = i & 1; return ok; }
    __device__ __forceinline__ void a_ready(const Unit&) const {}
    __device__ __forceinline__ void done(const Unit&) const {}
};
template <bool GATHER_> struct ExpertOrderT {
    static constexpr bool GATHER = GATHER_;
    const LAS int* tile_e; const LAS int* tbase; const LAS unsigned* tab; int ntiles, NPN, G, c; const char* A; const char* B; size_t a_tile, b_exp, b_pn;
    __device__ bool next(int i, Unit& u) const {
        const long L = (long)i * G + c; if (L >= (long)ntiles * NPN) return false;
        const int tile = (int)(L / NPN), pn = (int)(L % NPN); const int e = __builtin_amdgcn_readfirstlane(tile_e[tile]); const int k = tile - __builtin_amdgcn_readfirstlane(tbase[e]);
        u.pm = tile; u.pn = pn; u.A = GATHER_ ? A : A + (size_t)tile * a_tile; u.B = B + (size_t)e * b_exp + (size_t)pn * b_pn; u.sub = 0; u.aux = e * 32768 + 256 * k; return true;
    }
    __device__ __forceinline__ unsigned row_off(int i, int row) const { return tab[i * 256 + row]; }
    __device__ __forceinline__ void a_ready(const Unit&) const {}
    __device__ __forceinline__ void done(const Unit&) const {}
};
__device__ __forceinline__ unsigned cvt_pk_bf16(float lo, float hi) { unsigned r; asm volatile("v_cvt_pk_bf16_f32 %0, %1, %2" : "=v"(r) : "v"(lo), "v"(hi)); return r; }

template <class Epi, class Sched, bool ALIGN_EPI = false, bool SP2 = false>
__device__ __forceinline__ void gemm_phase(LAS unsigned char* lds, const int K, const Sched& S, const Epi& E, int tid_) {
    asm volatile("" : "+v"(tid_));
    const int tid = tid_, wid = __builtin_amdgcn_readfirstlane(tid >> 6), lane = tid & 63, wr = wid >> 2, wc = wid & 3, fr = lane & 15, fq = lane >> 4;
    const int nt = K / BK;
    unsigned voffA[2], voffB[2];
#pragma unroll
    for (int i = 0; i < 2; ++i) { int R, C; stage_rc(tid * 16 + i * 8192, R, C); const int Rb = Epi::PERM ? ((R & ~31) + perm32(R & 31)) : R;
        voffA[i] = (unsigned)(R * K + C) * 2u; voffB[i] = (unsigned)(Rb * K + C) * 2u; }
    const size_t kstep = (size_t)(BK * 2);
    const size_t hstep = (size_t)HALF * K * 2;
    const unsigned ldsw = (unsigned)wid * 1024u;
    unsigned gc[2][2] = {{0u, 0u}, {0u, 0u}}, gn[2][2] = {{0u, 0u}, {0u, 0u}}; int gR[2] = {0, 0}; unsigned gC[2] = {0u, 0u};
    if constexpr (Sched::GATHER) {
#pragma unroll
        for (int i = 0; i < 2; ++i) { int R, C; stage_rc(tid * 16 + i * 8192, R, C); gR[i] = R; gC[i] = (unsigned)C * 2u; }
    }
    const int aoff = lds_byte(wr * 64 + fr, fq * 8), boff = lds_byte(wc * 32 + fr, fq * 8);
#define PG8_SA(b, h) (((b) * 2 + (h)) * HTB)
#define PG8_SB(b, h) ((4 + (b) * 2 + (h)) * HTB)
#define PG8_STAGE(bufoff, gbase, voff) do { _Pragma("unroll") for (int _i = 0; _i < 2; ++_i) \
        __builtin_amdgcn_global_load_lds((const unsigned*)((const char*)(gbase) + (voff)[_i]), (LAS unsigned*)(lds + (bufoff) + ldsw + _i * 8192), 16, 0, 0); } while (0)
#define PG8_STAGE_A(bufoff, gbase, half, nx) do { if constexpr (Sched::GATHER) { _Pragma("unroll") for (int _i = 0; _i < 2; ++_i) \
        __builtin_amdgcn_global_load_lds((const unsigned*)((const char*)(gbase) + ((nx) ? gn[half][_i] : gc[half][_i])), (LAS unsigned*)(lds + (bufoff) + ldsw + _i * 8192), 16, 0, 0); } \
        else { PG8_STAGE(bufoff, (gbase) + (half) * hstep, voffA); } } while (0)
#define PG8_LDA(dst, b, h) do { _Pragma("unroll") for (int m = 0; m < 4; ++m) _Pragma("unroll") for (int k = 0; k < 2; ++k) dst[m][k] = *(const LAS bf16x8*)(lds + PG8_SA(b, h) + aoff + m * 2048 + k * 1024); } while (0)
#define PG8_LDB(dst, b, h) do { _Pragma("unroll") for (int n = 0; n < 2; ++n) _Pragma("unroll") for (int k = 0; k < 2; ++k) dst[n][k] = *(const LAS bf16x8*)(lds + PG8_SB(b, h) + boff + n * 2048 + k * 1024); } while (0)
#define PG8_MMA(ai, bj, At, Bt) do { __builtin_amdgcn_s_setprio(1); _Pragma("unroll") for (int m = 0; m < 4; ++m) _Pragma("unroll") for (int n = 0; n < 2; ++n) _Pragma("unroll") for (int k = 0; k < 2; ++k) \
        acc[ai][bj][m][n] = __builtin_amdgcn_mfma_f32_16x16x32_bf16(Bt[n][k], At[m][k], acc[ai][bj][m][n], 0, 0, 0); __builtin_amdgcn_s_setprio(0); } while (0)
#define PG8_WAIT_V(n) asm volatile("s_waitcnt vmcnt(" #n ")" ::: "memory")
#define PG8_WAIT_L(n) asm volatile("s_waitcnt lgkmcnt(" #n ")" ::: "memory")
#define PG8_BAR __builtin_amdgcn_s_barrier()
#define PG8_SCHED __builtin_amdgcn_sched_barrier(0)
    Unit cur, nxt; int ui = 0;
    if (!S.next(0, cur)) return;
    f32x4 acc[2][2][4][2];
#pragma unroll
    for (int a = 0; a < 2; ++a)
#pragma unroll
        for (int b = 0; b < 2; ++b)
#pragma unroll
            for (int m = 0; m < 4; ++m)
#pragma unroll
                for (int n = 0; n < 2; ++n) acc[a][b][m][n] = (f32x4){0.f, 0.f, 0.f, 0.f};
    bf16x8 At[4][2], B0[2][2], B1[2][2];
    const char* cA = cur.A; const char* cB = cur.B;
    if constexpr (Sched::GATHER) {
#pragma unroll
        for (int h = 0; h < 2; ++h)
#pragma unroll
            for (int i = 0; i < 2; ++i) gc[h][i] = S.row_off(0, 128 * h + gR[i]) + gC[i];
    }
    S.a_ready(cur);
    if constexpr (SP2) {
        PG8_STAGE(PG8_SB(0, 0), cB, voffB); PG8_STAGE(PG8_SB(0, 1), cB + hstep, voffB); PG8_STAGE_A(PG8_SA(0, 0), cA, 0, false); PG8_STAGE_A(PG8_SA(0, 1), cA, 1, false);
        if (wr == 1) PG8_BAR;
        PG8_WAIT_V(2); PG8_BAR;
        PG8_STAGE(PG8_SB(1, 0), cB + kstep, voffB); PG8_STAGE_A(PG8_SA(1, 0), cA + kstep, 0, false); PG8_STAGE(PG8_SB(1, 1), cB + hstep + kstep, voffB);
        PG8_WAIT_V(6); PG8_BAR;
    } else {
        PG8_STAGE(PG8_SB(0, 0), cB, voffB); PG8_STAGE_A(PG8_SA(0, 0), cA, 0, false); PG8_STAGE(PG8_SB(0, 1), cB + hstep, voffB); PG8_STAGE_A(PG8_SA(0, 1), cA, 1, false);
        if (wr == 1) PG8_BAR;
        PG8_WAIT_V(4); PG8_BAR;
        PG8_STAGE(PG8_SB(1, 0), cB + kstep, voffB); PG8_STAGE_A(PG8_SA(1, 0), cA + kstep, 0, false); PG8_STAGE(PG8_SB(1, 1), cB + hstep + kstep, voffB);
        PG8_WAIT_V(6); PG8_BAR;
    }
    for (;;) {
        const bool has_next = S.next(ui + 1, nxt);
        const char* nA = has_next ? nxt.A : cA; const char* nB = has_next ? nxt.B : cB;
        if constexpr (Sched::GATHER) {
#pragma unroll
            for (int h = 0; h < 2; ++h)
#pragma unroll
                for (int i = 0; i < 2; ++i) gn[h][i] = has_next ? S.row_off(ui + 1, 128 * h + gR[i]) + gC[i] : gc[h][i];
        }
        for (int t = 0; t < nt; t += 2) {
            const bool last = (t == nt - 2);
            const char* a1 = cA + (size_t)(t + 1) * kstep;
            const char* a2 = last ? nA : cA + (size_t)(t + 2) * kstep; const char* b2 = last ? nB : cB + (size_t)(t + 2) * kstep;
            const char* a3 = a2 + kstep; const char* b3 = b2 + kstep;
            if (last && has_next) S.a_ready(nxt);
            if constexpr (SP2) {
            PG8_LDB(B0, 0, 0); PG8_LDB(B1, 0, 1); PG8_SCHED; PG8_LDA(At, 0, 0); PG8_STAGE_A(PG8_SA(1, 1), a1, 1, false);
            PG8_WAIT_V(8); PG8_WAIT_L(0); PG8_BAR; PG8_MMA(0, 0, At, B0); PG8_MMA(0, 1, At, B1); PG8_BAR; PG8_SCHED;
            PG8_LDA(At, 0, 1); PG8_STAGE(PG8_SB(0, 0), b2, voffB); PG8_STAGE(PG8_SB(0, 1), b2 + hstep, voffB); PG8_STAGE_A(PG8_SA(0, 0), a2, 0, last);
            PG8_WAIT_V(8); PG8_WAIT_L(0); PG8_BAR; PG8_MMA(1, 0, At, B0); PG8_MMA(1, 1, At, B1); PG8_BAR; PG8_SCHED;
            PG8_LDB(B0, 1, 0); PG8_LDB(B1, 1, 1); PG8_SCHED; PG8_LDA(At, 1, 0); PG8_STAGE_A(PG8_SA(0, 1), a2, 1, last);
            PG8_WAIT_V(8); PG8_WAIT_L(0); PG8_BAR; PG8_MMA(0, 0, At, B0); PG8_MMA(0, 1, At, B1); PG8_BAR; PG8_SCHED;
            PG8_LDA(At, 1, 1); PG8_STAGE(PG8_SB(1, 0), b3, voffB); PG8_STAGE(PG8_SB(1, 1), b3 + hstep, voffB); PG8_STAGE_A(PG8_SA(1, 0), a3, 0, last);
            PG8_WAIT_V(8); PG8_WAIT_L(0); PG8_BAR; PG8_MMA(1, 0, At, B0); PG8_MMA(1, 1, At, B1); PG8_BAR; PG8_SCHED;
            } else {
            PG8_LDB(B0, 0, 0); PG8_SCHED; PG8_LDA(At, 0, 0); PG8_STAGE_A(PG8_SA(1, 1), a1, 1, false);
            PG8_WAIT_L(8); PG8_BAR; PG8_WAIT_L(0); PG8_MMA(0, 0, At, B0); PG8_BAR; PG8_SCHED;
            PG8_LDB(B1, 0, 1); PG8_STAGE(PG8_SB(0, 0), b2, voffB);
            PG8_BAR; PG8_WAIT_L(0); PG8_MMA(0, 1, At, B1); PG8_BAR;
            PG8_LDA(At, 0, 1); PG8_STAGE_A(PG8_SA(0, 0), a2, 0, last);
            PG8_BAR; PG8_WAIT_L(0); PG8_MMA(1, 0, At, B0); PG8_BAR; PG8_SCHED;
            PG8_STAGE(PG8_SB(0, 1), b2 + hstep, voffB);
            PG8_WAIT_V(6); PG8_BAR; PG8_MMA(1, 1, At, B1); PG8_BAR;
            PG8_LDB(B0, 1, 0); PG8_SCHED; PG8_LDA(At, 1, 0); PG8_STAGE_A(PG8_SA(0, 1), a2, 1, last);
            PG8_WAIT_L(8); PG8_BAR; PG8_WAIT_L(0); PG8_MMA(0, 0, At, B0); PG8_BAR; PG8_SCHED;
            PG8_LDB(B1, 1, 1); PG8_STAGE(PG8_SB(1, 0), b3, voffB);
            PG8_BAR; PG8_WAIT_L(0); PG8_MMA(0, 1, At, B1); PG8_BAR;
            PG8_LDA(At, 1, 1); PG8_STAGE_A(PG8_SA(1, 0), a3, 0, last);
            PG8_BAR; PG8_WAIT_L(0); PG8_MMA(1, 0, At, B0); PG8_BAR; PG8_SCHED;
            PG8_STAGE(PG8_SB(1, 1), b3 + hstep, voffB);
            PG8_WAIT_V(6); PG8_BAR; PG8_MMA(1, 1, At, B1); PG8_BAR;
            }
        }
        if constexpr (ALIGN_EPI) { if (wr == 0) PG8_BAR; }
        E(acc, cur, wr, wc, fr, fq); S.done(cur);
        if (!has_next) break;
        if (!(Epi::CHAIN && cur.sub == 0)) {
#pragma unroll
        for (int a = 0; a < 2; ++a)
#pragma unroll
            for (int b = 0; b < 2; ++b)
#pragma unroll
                for (int m = 0; m < 4; ++m)
#pragma unroll
                    for (int n = 0; n < 2; ++n) acc[a][b][m][n] = (f32x4){0.f, 0.f, 0.f, 0.f};
        }
        cur = nxt; cA = nA; cB = nB; ++ui;
        if constexpr (Sched::GATHER) {
#pragma unroll
            for (int h = 0; h < 2; ++h)
#pragma unroll
                for (int i = 0; i < 2; ++i) gc[h][i] = gn[h][i];
        }
        if constexpr (ALIGN_EPI) { if (wr == 1) PG8_BAR; }
    }
    PG8_WAIT_V(0);
    if constexpr (!ALIGN_EPI) { if (wr == 0) PG8_BAR; }
    PG8_BAR;
#undef PG8_SA
#undef PG8_SB
#undef PG8_STAGE
#undef PG8_STAGE_A
#undef PG8_LDA
#undef PG8_LDB
#undef PG8_MMA
#undef PG8_WAIT_V
#undef PG8_WAIT_L
#undef PG8_BAR
#undef PG8_SCHED
}
}

#define PG8_SP2 true
#define PG8_ALIGN true

constexpr size_t MiB = 1u << 20;
constexpr size_t WS_CTL = 0, CTL_ZERO_BYTES = 1 * MiB;
constexpr size_t WS_WIN = 1 * MiB;
constexpr size_t WS_WR = WS_WIN + (size_t)NIN * D * 2;
constexpr size_t WS_PA = 12 * MiB, WS_PB = 13 * MiB, WS_WOUT = 14 * MiB, WS_WGU = 16 * MiB, WS_WD = 48 * MiB;
constexpr size_t WS_XB2 = 64 * MiB;
constexpr size_t WS_XB = 64 * MiB;
constexpr size_t YB_OFF = 32 * MiB;
constexpr size_t WS_SMALL = 128 * MiB;
constexpr size_t WS_RS1 = WS_SMALL, WS_RS2 = WS_SMALL + 128 * 1024, WS_TREC = WS_SMALL + 256 * 1024, WS_TW = WS_SMALL + 512 * 1024, WS_TSLOT = WS_SMALL + 768 * 1024, WS_SW = WS_SMALL + 1024 * 1024, WS_SRS = WS_SMALL + 1024 * 1024 + 512 * 1024;
constexpr size_t WS_Q = 130 * MiB, WS_K = 162 * MiB, WS_V = 194 * MiB, WS_BQ = 226 * MiB, WS_BK = 242 * MiB, WS_BV = 258 * MiB, WS_BR = 290 * MiB, WS_LA = 322 * MiB, WS_R = 354 * MiB, WS_GB = 418 * MiB;
constexpr size_t WS_TMP = 130 * MiB, WS_MRG = 194 * MiB;
constexpr size_t WS_TOKL = 130 * MiB, WS_TWL = 134 * MiB, WS_RSLL = 138 * MiB;
constexpr size_t WS_H = 274 * MiB, WS_Y = 310 * MiB;
constexpr size_t WS_END = 482 * MiB;
constexpr int CW_TMO = 0, CW_CODE = 1, CW_BAR = 4096, CW_GCNT = 8192;

constexpr int SCR_BYTES = 155648;
constexpr int LC_OFF = SCR_BYTES;
constexpr int LC_MISC = LC_OFF, LC_TBASE = LC_OFF + 128, LC_TILEE = LC_OFF + 512, LC_LCNT = LC_OFF + 1792, LC_LBASE = LC_OFF + 1920, LC_REC = LC_OFF + 2048, LC_RECW = LC_OFF + 3072, LC_RECRS = LC_OFF + 4096;
constexpr int LDS_BYTES = 163840;

#define RLX_AGENT __ATOMIC_RELAXED, __HIP_MEMORY_SCOPE_AGENT
#define LDS_WAIT() asm volatile("s_waitcnt lgkmcnt(0)" ::: "memory")
__device__ __forceinline__ unsigned f2bf(float f) { unsigned u = __builtin_bit_cast(unsigned, f); return (u + 0x7fffu + ((u >> 16) & 1u)) >> 16; }
__device__ __forceinline__ unsigned pk2(float lo, float hi) { return f2bf(lo) | (f2bf(hi) << 16); }
__device__ __forceinline__ float bflo(unsigned w) { return __uint_as_float(w << 16); }
__device__ __forceinline__ float bfhi(unsigned w) { return __uint_as_float(w & 0xffff0000u); }
__device__ __forceinline__ float bf2f(bf16 b) { return __uint_as_float(((unsigned)b) << 16); }
__device__ __forceinline__ float wave_sum(float v) {
#pragma unroll
    for (int o = 1; o < 64; o <<= 1) v += __shfl_xor(v, o);
    return v;
}
__device__ __forceinline__ float rdlane(float v, int i) { return __uint_as_float((unsigned)__builtin_amdgcn_readlane((int)__float_as_uint(v), i)); }
__device__ __forceinline__ float wave_max(float v) {
#pragma unroll
    for (int o = 1; o < 64; o <<= 1) v = fmaxf(v, __shfl_xor(v, o));
    return v;
}

#define XB_TMO      128
#define XB_XCNT(j)  (256  + 64 * (j))
#define XB_XSUB(j)  (1280 + 64 * (j))
#define XB_XGEN(j)  (2304 + 64 * (j))
#define XB_TOP      3328
#define XB_TOPGEN   3392
#define XCD_BAR_WORDS 3456
#define XB_SPIN_CAP (1u << 18)
__device__ __forceinline__ unsigned xb_ld(unsigned* p)              { return __hip_atomic_load(p, __ATOMIC_RELAXED, __HIP_MEMORY_SCOPE_AGENT); }
__device__ __forceinline__ unsigned xb_add(unsigned* p, unsigned v) { return __hip_atomic_fetch_add(p, v, __ATOMIC_RELAXED, __HIP_MEMORY_SCOPE_AGENT); }
__device__ __forceinline__ unsigned xb_xcc_id() { return (unsigned)__builtin_amdgcn_s_getreg((3 << 11) | 20) & 0xFu; }
#define XB_SPIN(cond, bar) do { unsigned _sp = 0; while (cond) { __builtin_amdgcn_s_sleep(1); \
    if ((++_sp & 255u) == 0u) { if (xb_ld(&(bar)[XB_TMO])) break; if (_sp > XB_SPIN_CAP) { atomicAdd(&(bar)[XB_TMO], 1u); break; } } } } while (0)
struct XcdBarrier { unsigned* bar; unsigned x; volatile LAS unsigned* st; };
__device__ __forceinline__ XcdBarrier xcd_barrier_post(unsigned* bar, volatile LAS unsigned* st) {
    XcdBarrier b; b.bar = bar; b.x = xb_xcc_id(); b.st = st;
    if (threadIdx.x == 0) (void)xb_add(&bar[XB_XCNT(b.x)], 1u);
    return b;
}
__device__ __forceinline__ void xcd_barrier_complete(unsigned* bar, unsigned x, unsigned& nloc, unsigned& nx) {
    const unsigned G = gridDim.x * gridDim.y * gridDim.z;
    unsigned sum, cnt, mine, sp = 0u;
    for (;;) {
        sum = 0u; cnt = 0u; mine = 0u;
#pragma unroll
        for (unsigned j = 0; j < 16; ++j) { const unsigned c = xb_ld(&bar[XB_XCNT(j)]); sum += c; cnt += (c > 0u) ? 1u : 0u; mine = (j == x) ? c : mine; }
        if (sum == G) break;
        __builtin_amdgcn_s_sleep(1);
        if ((++sp & 255u) == 0u) { if (xb_ld(&bar[XB_TMO])) break; if (sp > XB_SPIN_CAP) { atomicAdd(&bar[XB_TMO], 1u); break; } }
    }
    nloc = mine > 0u ? mine : 1u; nx = cnt > 0u ? cnt : 1u;
}
__device__ __forceinline__ void xcd_barrier(const XcdBarrier& b) {
    asm volatile("s_waitcnt vmcnt(0)" ::: "memory");
    __syncthreads();
    if (threadIdx.x == 0) {
        unsigned* bar = b.bar;
        __builtin_amdgcn_s_waitcnt(0);
        unsigned nloc = b.st[0], nx = b.st[1];
        if (nloc == 0u) { xcd_barrier_complete(bar, b.x, nloc, nx); b.st[0] = nloc; b.st[1] = nx; }
        const unsigned old = xb_add(&bar[XB_XSUB(b.x)], 1u);
        const unsigned gen = old / nloc;
        if (old + 1u == (gen + 1u) * nloc) {
            __builtin_amdgcn_fence(__ATOMIC_RELEASE, "agent");
            asm volatile("s_waitcnt vmcnt(0)" ::: "memory");
            const unsigned og = xb_add(&bar[XB_TOP], 1u);
            const unsigned tg = og / nx;
            if (og + 1u == (tg + 1u) * nx) xb_add(&bar[XB_TOPGEN], 1u);
            else XB_SPIN(xb_ld(&bar[XB_TOPGEN]) == tg, bar);
            __builtin_amdgcn_fence(__ATOMIC_ACQUIRE, "agent");
            xb_add(&bar[XB_XGEN(b.x)], 1u);
            asm volatile("s_waitcnt vmcnt(0)" ::: "memory");
        } else {
            XB_SPIN(xb_ld(&bar[XB_XGEN(b.x)]) == gen, bar);
            __builtin_amdgcn_fence(__ATOMIC_ACQUIRE, "agent");
            asm volatile("s_waitcnt vmcnt(0)" ::: "memory");
        }
    }
    __syncthreads();
}

struct Args { const float* in[20]; float* out; unsigned char* ws; int ph_lo, ph_hi; };
typedef const __attribute__((address_space(4))) Args* ArgsP;
struct Frame {
    LAS unsigned char* lds; unsigned* ctl; unsigned char* ws; unsigned char* yab;
    int tid, lane, wave, vcu, G;
};
__device__ __forceinline__ ArgsP get_args() { ArgsP p = (ArgsP)__builtin_amdgcn_kernarg_segment_ptr(); asm volatile("" : "+s"(p)); return p; }
__device__ __forceinline__ Frame make_frame(ArgsP ap, int wave0) {
    extern __shared__ __attribute__((aligned(16))) unsigned char lds_raw[];
    Frame F; F.lds = (LAS unsigned char*)lds_raw; F.ws = ap->ws; F.ctl = (unsigned*)(F.ws + WS_CTL); F.yab = (unsigned char*)ap->out;
    unsigned z = 0u; asm volatile("" : "+v"(z));
    int t = wave0 * 64 + (int)__builtin_amdgcn_mbcnt_hi(~0u, __builtin_amdgcn_mbcnt_lo(~0u, z)); asm volatile("" : "+v"(t));
    F.tid = t; F.lane = t & 63; F.wave = __builtin_amdgcn_readfirstlane(t >> 6);
    F.G = gridDim.x; { const int bx = blockIdx.x; F.vcu = (F.G % 8 == 0) ? (bx % 8) * (F.G / 8) + bx / 8 : bx; }
    return F;
}

using pg8::cvt_pk_bf16;
__device__ __forceinline__ u32x4 pack8(f32x4 a, f32x4 b) { u32x4 w; w.x = cvt_pk_bf16(a[0], a[1]); w.y = cvt_pk_bf16(a[2], a[3]); w.z = cvt_pk_bf16(b[0], b[1]); w.w = cvt_pk_bf16(b[2], b[3]); return w; }
__device__ __forceinline__ void unpack8(u32x4 w, f32x4& a, f32x4& b) { a = (f32x4){bflo(w.x), bfhi(w.x), bflo(w.y), bfhi(w.y)}; b = (f32x4){bflo(w.z), bfhi(w.z), bflo(w.w), bfhi(w.w)}; }
__device__ __forceinline__ float sigmoidf_(float z) { return __builtin_amdgcn_rcpf(1.0f + __builtin_amdgcn_exp2f(-LOG2E * z)); }

struct EpiIn {
    static constexpr bool PERM = true, CHAIN = false;
    const float* rowscale; bf16 *Q, *K, *V, *BQ, *BK, *BV, *BR, *R, *GB; float* LOGA; const float *qg, *kg, *lbias;
    __device__ __forceinline__ void operator()(f32x4 (&acc)[2][2][4][2], const pg8::Unit& u, int wr, int wc, int fr, int fq) const {
        const int pn = u.pn, row0 = u.pm * 256 + wr * 64 + fr;
        if (pn < 4) {
            const bool isq = pn < 2; const int hh = 4 * (pn & 1) + wc;
            const float* g = (isq ? qg : kg) + hh * 64 + 8 * fq;
            f32x4 g0[2], g1[2];
#pragma unroll
            for (int bj = 0; bj < 2; ++bj) { g0[bj] = *(const f32x4*)(g + 32 * bj); g1[bj] = *(const f32x4*)(g + 32 * bj + 4); }
            const float sc = isq ? 0.125f * LOG2E : 1.0f; bf16* O = isq ? Q : K;
#pragma unroll
            for (int ai = 0; ai < 2; ++ai)
#pragma unroll
                for (int m = 0; m < 4; ++m) {
                    const int row = row0 + ai * 128 + m * 16; const float rs = rowscale[row];
                    f32x4 v[2][2]; float ss = 0.f;
#pragma unroll
                    for (int bj = 0; bj < 2; ++bj)
#pragma unroll
                        for (int n = 0; n < 2; ++n) { v[bj][n] = acc[ai][bj][m][n] * rs; const f32x4 q = v[bj][n] * v[bj][n]; ss += (q[0] + q[1]) + (q[2] + q[3]); }
                    ss += __shfl_xor(ss, 16); ss += __shfl_xor(ss, 32);
                    const float rn = rsqrtf(ss * (1.0f / 64.0f) + EPS) * sc;
#pragma unroll
                    for (int bj = 0; bj < 2; ++bj) *(u32x4*)(O + (size_t)row * 512 + hh * 64 + 32 * bj + 8 * fq) = pack8(v[bj][0] * g0[bj] * rn, v[bj][1] * g1[bj] * rn);
                }
        } else if (pn < 12) {
            bf16* O; int ld, cb; float sc = 1.0f; bool act = false;
            if (pn < 6) { O = V; ld = 512; cb = 256 * (pn - 4); }
            else if (pn == 6) { O = BQ; ld = 256; cb = 0; sc = 0.125f; }
            else if (pn == 7) { O = BK; ld = 256; cb = 0; }
            else if (pn < 10) { O = BV; ld = 512; cb = 256 * (pn - 8); }
            else { O = BR; ld = 512; cb = 256 * (pn - 10); act = true; }
#pragma unroll
            for (int ai = 0; ai < 2; ++ai)
#pragma unroll
                for (int m = 0; m < 4; ++m) {
                    const int row = row0 + ai * 128 + m * 16; const float rs = rowscale[row] * sc;
#pragma unroll
                    for (int bj = 0; bj < 2; ++bj) {
                        f32x4 a = acc[ai][bj][m][0] * rs, b = acc[ai][bj][m][1] * rs;
                        if (act) {
#pragma unroll
                            for (int e = 0; e < 4; ++e) { a[e] = a[e] * sigmoidf_(a[e]); b[e] = b[e] * sigmoidf_(b[e]); }
                        }
                        *(u32x4*)(O + (size_t)row * ld + cb + 64 * wc + 32 * bj + 8 * fq) = pack8(a, b);
                    }
                }
        } else if (pn == 12) {
            f32x4 b0[2], b1[2];
#pragma unroll
            for (int bj = 0; bj < 2; ++bj) { b0[bj] = *(const f32x4*)(lbias + 64 * wc + 32 * bj + 8 * fq); b1[bj] = *(const f32x4*)(lbias + 64 * wc + 32 * bj + 8 * fq + 4); }
            const int l15 = ((fq << 4) | 15);
#pragma unroll
            for (int ai = 0; ai < 2; ++ai)
#pragma unroll
                for (int bj = 0; bj < 2; ++bj)
#pragma unroll
                    for (int n = 0; n < 2; ++n) {
                        f32x4 v[4];
#pragma unroll
                        for (int m = 0; m < 4; ++m) { const float rs = rowscale[row0 + ai * 128 + m * 16];
                            f32x4 z = acc[ai][bj][m][n] * rs + (n ? b1[bj] : b0[bj]);
#pragma unroll
                            for (int e = 0; e < 4; ++e) z[e] = (fminf(z[e], 0.f) - __logf(1.0f + __expf(-fabsf(z[e])))) * 0.0625f;
                            v[m] = z; }
#pragma unroll
                        for (int e = 0; e < 4; ++e) {
                            float x[4];
#pragma unroll
                            for (int m = 0; m < 4; ++m) { float t = v[m][e];
                                t += __uint_as_float(__builtin_amdgcn_update_dpp(0, (int)__float_as_uint(t), 0x111, 0xf, 0xf, true));
                                t += __uint_as_float(__builtin_amdgcn_update_dpp(0, (int)__float_as_uint(t), 0x112, 0xf, 0xf, true));
                                t += __uint_as_float(__builtin_amdgcn_update_dpp(0, (int)__float_as_uint(t), 0x114, 0xf, 0xf, true));
                                t += __uint_as_float(__builtin_amdgcn_update_dpp(0, (int)__float_as_uint(t), 0x118, 0xf, 0xf, true));
                                x[m] = t; }
                            x[1] += __shfl(x[0], l15); x[2] += __shfl(x[1], l15); x[3] += __shfl(x[2], l15);
#pragma unroll
                            for (int m = 0; m < 4; ++m) v[m][e] = x[m];
                        }
#pragma unroll
                        for (int m = 0; m < 4; ++m) *(f32x4*)(LOGA + (size_t)(row0 + ai * 128 + m * 16) * 256 + 64 * wc + 32 * bj + 8 * fq + 4 * n) = v[m];
                    }
        } else {
            const int cb = 128 * (pn - 13) + 32 * wc + 8 * fq;
#pragma unroll
            for (int ai = 0; ai < 2; ++ai)
#pragma unroll
                for (int m = 0; m < 4; ++m) {
                    const int row = row0 + ai * 128 + m * 16; const float rs = rowscale[row];
                    f32x4 ra, rb_, ga, gb_;
#pragma unroll
                    for (int e = 0; e < 4; ++e) {
                        float za = fminf(fmaxf(acc[ai][0][m][0][e] * rs, -30.f), 30.f), zb = fminf(fmaxf(acc[ai][1][m][0][e] * rs, -30.f), 30.f);
                        float ea = __builtin_amdgcn_exp2f(-LOG2E * za), eb = __builtin_amdgcn_exp2f(-LOG2E * zb); ga[e] = __builtin_amdgcn_rcpf(1.0f + eb); ra[e] = (1.0f + eb) * __builtin_amdgcn_rcpf(1.0f + ea);
                        za = fminf(fmaxf(acc[ai][0][m][1][e] * rs, -30.f), 30.f); zb = fminf(fmaxf(acc[ai][1][m][1][e] * rs, -30.f), 30.f);
                        ea = __builtin_amdgcn_exp2f(-LOG2E * za); eb = __builtin_amdgcn_exp2f(-LOG2E * zb); gb_[e] = __builtin_amdgcn_rcpf(1.0f + eb); rb_[e] = (1.0f + eb) * __builtin_amdgcn_rcpf(1.0f + ea);
                    }
                    *(u32x4*)(R + (size_t)row * 1024 + cb) = pack8(ra, rb_);
                    *(u32x4*)(GB + (size_t)row * 1024 + cb) = pack8(ga, gb_);
                }
        }
    }
};
struct EpiMerge {
    static constexpr bool PERM = true, CHAIN = true;
    const bf16* R; const bf16* GB; bf16* MRG;
    __device__ __forceinline__ void operator()(f32x4 (&acc)[2][2][4][2], const pg8::Unit& u, int wr, int wc, int fr, int fq) const {
        const int row0 = u.pm * 256 + wr * 64 + fr, col0 = u.pn * 256 + wc * 32 + 8 * fq;
        if (u.sub == 0) {
#pragma unroll
            for (int ai = 0; ai < 2; ++ai)
#pragma unroll
                for (int m = 0; m < 4; ++m)
#pragma unroll
                    for (int bj = 0; bj < 2; ++bj) {
                        const size_t off = (size_t)(row0 + ai * 128 + m * 16) * 1024 + col0 + bj * 128;
                        f32x4 ra, rb_; unpack8(*(const u32x4*)(R + off), ra, rb_);
                        acc[ai][bj][m][0] *= ra; acc[ai][bj][m][1] *= rb_;
                    }
        } else {
#pragma unroll
            for (int ai = 0; ai < 2; ++ai)
#pragma unroll
                for (int m = 0; m < 4; ++m)
#pragma unroll
                    for (int bj = 0; bj < 2; ++bj) {
                        const size_t off = (size_t)(row0 + ai * 128 + m * 16) * 1024 + col0 + bj * 128;
                        f32x4 ga, gb_; unpack8(*(const u32x4*)(GB + off), ga, gb_);
                        *(u32x4*)(MRG + off) = pack8(acc[ai][bj][m][0] * ga, acc[ai][bj][m][1] * gb_);
                    }
        }
    }
};
struct EpiOut {
    static constexpr bool PERM = true, CHAIN = false;
    bf16* xb;
    __device__ __forceinline__ void operator()(f32x4 (&acc)[2][2][4][2], const pg8::Unit& u, int wr, int wc, int fr, int fq) const {
        const int row0 = u.pm * 256 + wr * 64 + fr, col0 = u.pn * 256 + wc * 32 + 8 * fq;
#pragma unroll
        for (int ai = 0; ai < 2; ++ai)
#pragma unroll
            for (int m = 0; m < 4; ++m)
#pragma unroll
                for (int bj = 0; bj < 2; ++bj) {
                    const size_t off = (size_t)(row0 + ai * 128 + m * 16) * 1024 + col0 + bj * 128;
                    f32x4 xa, xc; unpack8(*(const u32x4*)(xb + off), xa, xc);
                    *(u32x4*)(xb + off) = pack8(xa + acc[ai][bj][m][0], xc + acc[ai][bj][m][1]);
                }
    }
};
struct EpiGU {
    static constexpr bool PERM = true, CHAIN = false;
    const float* srs; bf16* H;
    __device__ __forceinline__ void operator()(f32x4 (&acc)[2][2][4][2], const pg8::Unit& u, int wr, int wc, int fr, int fq) const {
        const int row0 = u.pm * 256 + wr * 64 + fr, col0 = u.pn * 128 + wc * 32 + 8 * fq;
#pragma unroll
        for (int ai = 0; ai < 2; ++ai)
#pragma unroll
            for (int m = 0; m < 4; ++m) {
                const int row = row0 + ai * 128 + m * 16; const float rs = srs[u.aux + (row - u.pm * 256)];
                f32x4 a, b;
#pragma unroll
                for (int e = 0; e < 4; ++e) { const float g0 = acc[ai][0][m][0][e] * rs, g1 = acc[ai][0][m][1][e] * rs; a[e] = g0 * sigmoidf_(g0) * (acc[ai][1][m][0][e] * rs); b[e] = g1 * sigmoidf_(g1) * (acc[ai][1][m][1][e] * rs); }
                *(u32x4*)(H + (size_t)row * 256 + col0) = pack8(a, b);
            }
    }
};
struct EpiDown {
    static constexpr bool PERM = true, CHAIN = false;
    const float* sw; bf16* Y;
    __device__ __forceinline__ void operator()(f32x4 (&acc)[2][2][4][2], const pg8::Unit& u, int wr, int wc, int fr, int fq) const {
        const int row0 = u.pm * 256 + wr * 64 + fr, col0 = u.pn * 256 + wc * 32 + 8 * fq;
#pragma unroll
        for (int ai = 0; ai < 2; ++ai)
#pragma unroll
            for (int m = 0; m < 4; ++m) {
                const int row = row0 + ai * 128 + m * 16; const float w = sw[u.aux + (row - u.pm * 256)];
#pragma unroll
                for (int bj = 0; bj < 2; ++bj) *(u32x4*)(Y + (size_t)row * 1024 + col0 + bj * 128) = pack8(acc[ai][bj][m][0] * w, acc[ai][bj][m][1] * w);
            }
    }
};

__device__ __forceinline__ void cvt_item(const float* src, int ldn, const float* kscale, bf16* dst, int Kd, int drow0, int k0, LAS float* scr, int lane) {
#pragma unroll 8
    for (int i = 0; i < 32; ++i) { const int kk = 2 * i + (lane >> 5); float v = src[(size_t)(k0 + kk) * ldn + (lane & 31)]; if (kscale) v *= kscale[k0 + kk]; scr[kk * 33 + (lane & 31)] = v; }
    LDS_WAIT(); asm volatile("" ::: "memory");
    const int c = lane & 7;
#pragma unroll
    for (int j = 0; j < 4; ++j) { const int n = (lane >> 3) + 8 * j; const LAS float* s = scr + (8 * c) * 33 + n;
        u32x4 o; o.x = pk2(s[0 * 33], s[1 * 33]); o.y = pk2(s[2 * 33], s[3 * 33]); o.z = pk2(s[4 * 33], s[5 * 33]); o.w = pk2(s[6 * 33], s[7 * 33]);
        *(u32x4*)(dst + (size_t)(drow0 + n) * Kd + k0 + 8 * c) = o; }
    LDS_WAIT(); asm volatile("" ::: "memory");
}
__device__ __forceinline__ void cvt_item_lr(const float* win, const float* gup, int c0, const float* kscale, bf16* dst, int drow0, int k0, LAS float* scr, int lane) {
    float gu[16];
#pragma unroll
    for (int r = 0; r < 16; ++r) gu[r] = gup[r * 256 + c0 + (lane & 31)];
#pragma unroll 4
    for (int i = 0; i < 32; ++i) { const int kk = 2 * i + (lane >> 5); const float* wr_ = win + (size_t)(k0 + kk) * IN_COLS + 3072; float v = 0.f;
#pragma unroll
        for (int r = 0; r < 16; ++r) v += wr_[r] * gu[r];
        scr[kk * 33 + (lane & 31)] = v * kscale[k0 + kk]; }
    LDS_WAIT(); asm volatile("" ::: "memory");
    const int c = lane & 7;
#pragma unroll
    for (int j = 0; j < 4; ++j) { const int n = (lane >> 3) + 8 * j; const LAS float* s = scr + (8 * c) * 33 + n;
        u32x4 o; o.x = pk2(s[0 * 33], s[1 * 33]); o.y = pk2(s[2 * 33], s[3 * 33]); o.z = pk2(s[4 * 33], s[5 * 33]); o.w = pk2(s[6 * 33], s[7 * 33]);
        *(u32x4*)(dst + (size_t)(drow0 + n) * D + k0 + 8 * c) = o; }
    LDS_WAIT(); asm volatile("" ::: "memory");
}
__device__ __forceinline__ void phase_weights(const Frame& F, ArgsP a, int l) {
    LAS float* scr = (LAS float*)(F.lds + F.wave * 16384);
    const int gw = F.vcu * 8 + F.wave, NGW = F.G * 8, lane = F.lane;
    const float* win = a->in[2] + (size_t)l * D * IN_COLS; const float* gmix = a->in[1] + l * D; const float* gup = a->in[6] + l * 16 * 256;
    bf16* WIN = (bf16*)(F.ws + WS_WIN); bf16* PA = (bf16*)(F.ws + WS_PA); bf16* PB = (bf16*)(F.ws + WS_PB); bf16* WOUT = (bf16*)(F.ws + WS_WOUT); bf16* WGU = (bf16*)(F.ws + WS_WGU); bf16* WD = (bf16*)(F.ws + WS_WD);
    constexpr int I0 = (NIN / 32) * 16, I1 = 32 * 8, I2 = 32 * 8, I3 = 32 * 16, I4 = NE * 16 * 16, I5 = NE * 32 * 4;
    for (int it = gw; it < I0 + I1 + I2 + I3 + I4 + I5; it += NGW) {
        int r = it;
        if (r < I0) { const int nb = r >> 4, kb = r & 15, P = nb * 32, pn = P >> 8, p = P & 255;
            if (pn == 12) { const int c0 = 64 * ((p >> 5) & 3) + 32 * (p >> 7); cvt_item_lr(win, gup, c0, gmix, WIN, P, kb * 64, scr, lane); }
            else { const int src = pn < 12 ? 256 * pn + 64 * ((p >> 5) & 3) + 32 * (p >> 7) : 3088 + 1024 * (p >> 7) + 128 * (pn - 13) + (p & 127);
                   cvt_item(win + src, IN_COLS, gmix, WIN, D, P, kb * 64, scr, lane); }
            continue; } r -= I0;
        if (r < I1) { const int nb = r >> 3, kb = r & 7; cvt_item(a->in[9] + (size_t)l * 512 * D + nb * 32, D, nullptr, PA, 512, nb * 32, kb * 64, scr, lane); continue; } r -= I1;
        if (r < I2) { const int nb = r >> 3, kb = r & 7; cvt_item(a->in[10] + (size_t)l * 512 * D + nb * 32, D, nullptr, PB, 512, nb * 32, kb * 64, scr, lane); continue; } r -= I2;
        if (r < I3) { const int nb = r >> 4, kb = r & 15; cvt_item(a->in[11] + (size_t)l * D * D + nb * 32, D, nullptr, WOUT, D, nb * 32, kb * 64, scr, lane); continue; } r -= I3;
        if (r < I4) { const int e = r >> 8, nb = (r >> 4) & 15, kb = r & 15, p0 = nb * 32; const int j0 = 128 * (p0 >> 8) + (p0 & 127);
            const float* src = ((p0 >> 7) & 1 ? a->in[18] : a->in[17]) + ((size_t)(l * NE + e) * D) * DE + j0;
            cvt_item(src, DE, a->in[12] + l * D, WGU + (size_t)e * 512 * D, D, p0, kb * 64, scr, lane); continue; } r -= I4;
        { const int e = r >> 7, nb = (r >> 2) & 31, kb = r & 3;
            cvt_item(a->in[19] + ((size_t)(l * NE + e) * DE) * D + nb * 32, D, nullptr, WD + (size_t)e * D * DE, DE, nb * 32, kb * 64, scr, lane); }
    }
    bf16* WRh = (bf16*)(F.ws + WS_WR); bf16* WRl = WRh + 48 * D; const float* gf = a->in[12] + l * D; const float* wg = a->in[13] + (size_t)l * D * 4; const float* wrt = a->in[15] + (size_t)l * D * 32;
    for (int i = (F.vcu * 512 + F.tid); i < 48 * D; i += F.G * 512) { const int n = i >> 10, k = i & 1023; const float v = n < 36 ? gf[k] * (n < 4 ? wg[k * 4 + n] : wrt[k * 32 + n - 4]) : 0.f;
        const unsigned hi = f2bf(v); WRh[i] = (bf16)hi; WRl[i] = (bf16)f2bf(v - __uint_as_float(hi << 16)); }
}
__device__ __forceinline__ void phase_x_to_xb(const Frame& F, const float* x) {
    bf16* XB = (bf16*)(F.ws + WS_XB); float* RS = (float*)(F.ws + WS_RS1);
    const int gw = F.vcu * 8 + F.wave, NGW = F.G * 8;
    for (int m = gw; m < T; m += NGW) {
        const f32x4* xr = (const f32x4*)(x + (size_t)m * D) + F.lane; f32x4 v[4]; float s = 0.f;
#pragma unroll
        for (int j = 0; j < 4; ++j) { v[j] = xr[64 * j]; s += (v[j][0] * v[j][0] + v[j][1] * v[j][1]) + (v[j][2] * v[j][2] + v[j][3] * v[j][3]); }
        s = wave_sum(s);
        u32x2* o = (u32x2*)(XB + (size_t)m * D) + F.lane;
#pragma unroll
        for (int j = 0; j < 4; ++j) { u32x2 w; w.x = pk2(v[j][0], v[j][1]); w.y = pk2(v[j][2], v[j][3]); o[64 * j] = w; }
        if (F.lane == 0) RS[m] = rsqrtf(s * (1.0f / D) + EPS);
    }
}

typedef float f32x16 __attribute__((ext_vector_type(16)));
typedef short s16x4 __attribute__((ext_vector_type(4)));
#define MFMA32(a, b, c) __builtin_amdgcn_mfma_f32_32x32x16_bf16((a), (b), (c), 0, 0, 0)
__device__ __forceinline__ unsigned cvtpk(float lo, float hi) { typedef float f2_ __attribute__((ext_vector_type(2))); typedef __bf16 b2_ __attribute__((ext_vector_type(2))); f2_ v = {lo, hi}; b2_ b = __builtin_convertvector(v, b2_); return __builtin_bit_cast(unsigned, b); }
__device__ __forceinline__ u32x4 pack8c(f32x4 a, f32x4 b) { u32x4 w; w.x = cvtpk(a[0], a[1]); w.y = cvtpk(a[2], a[3]); w.z = cvtpk(b[0], b[1]); w.w = cvtpk(b[2], b[3]); return w; }
__device__ __forceinline__ s16x4 tr_read(const LAS unsigned char* p) { return __builtin_amdgcn_ds_read_tr16_b64_v4i16((LAS s16x4*)p); }
__device__ __forceinline__ bf16x8 pack_step(const f32x16& x, int s) {
    u32x4 p; p.x = cvtpk(x[8 * s], x[8 * s + 1]); p.y = cvtpk(x[8 * s + 2], x[8 * s + 3]); p.z = cvtpk(x[8 * s + 4], x[8 * s + 5]); p.w = cvtpk(x[8 * s + 6], x[8 * s + 7]);
    return __builtin_bit_cast(bf16x8, p);
}
constexpr int ATT_K = 0, ATT_V = 16384, ATT_TBL = 32768;
__device__ __forceinline__ void attn_unit(const Frame& F, ArgsP a, int l, int u) {
    const int lane = F.lane, w = F.wave, r = lane & 31, hl = lane >> 5;
    const int ci = (w < 4) ? (w >> 1) : (3 - ((w - 4) >> 1));
    const int qh = w & 1;
    const int cq = u & 7, h = (u >> 3) & 7, b = u >> 6, c0 = 4 * cq, t0 = b * SEQ + c0 * 64;
    const bf16* Qb = (const bf16*)(F.ws + WS_Q); const bf16* Kb = (const bf16*)(F.ws + WS_K); const bf16* Vb = (const bf16*)(F.ws + WS_V); bf16* YA = (bf16*)(F.yab);
    LAS unsigned char* Ks = F.lds + ATT_K; LAS unsigned char* Vs = F.lds + ATT_V; LAS float* tbl = (LAS float*)(F.lds + ATT_TBL);
    const float* rb = a->in[5];
    const float mq = wave_max(fabsf(a->in[3][(l * 8 + h) * 64 + lane])), mk = wave_max(fabsf(a->in[4][(l * 8 + h) * 64 + lane]));
    float mb = 0.f; for (int i = lane; i < 257; i += 64) mb = fmaxf(mb, fabsf(rb[i * 8 + h])); mb = wave_max(mb);
    const float M2 = LOG2E * (8.0f * mq * mk + mb);
    __syncthreads();
    for (int i = F.tid; i < 257; i += 512) tbl[i] = rb[i * 8 + h] * LOG2E - M2;
    const int qrow = t0 + ci * 64 + qh * 32 + r;
    bf16x8 qf[4];
#pragma unroll
    for (int s = 0; s < 4; ++s) qf[s] = *(const bf16x8*)(Qb + (size_t)qrow * 512 + h * 64 + 16 * s + 8 * hl);
    const int jmin = (8 - c0) > 0 ? (8 - c0) : 0;
    const int key = F.tid >> 3, ch = F.tid & 7;
    const long g0 = (long)(t0 - 512 + key) * 512 + h * 64 + ch * 8;
    const int kst = key * 128 + ((ch ^ ((key >> 1) & 7)) << 4);
    const int vst = ((key >> 3) * 2 + (ch >> 2)) * 512 + (key & 7) * 64 + (ch & 3) * 16;
    u32x4 kreg = *(const u32x4*)(Kb + g0 + (long)jmin * 64 * 512), vreg = *(const u32x4*)(Vb + g0 + (long)jmin * 64 * 512);
    *(LAS u32x4*)(Ks + kst) = kreg; *(LAS u32x4*)(Vs + vst) = vreg;
    __syncthreads();
    const float cb = tbl[256];
    const int qi = 32 * qh + r;
    const int kro = r * 128, ksw = (r >> 1) & 7;
    const int g16 = lane >> 4, i16 = lane & 15;
    const int vro = (4 * (g16 >> 1) + (i16 >> 2)) * 64 + (16 * (g16 & 1) + 4 * (i16 & 3)) * 2;
    f32x16 o[2]; float lsum = 0.f;
#pragma unroll
    for (int i = 0; i < 16; ++i) { o[0][i] = 0.f; o[1][i] = 0.f; }
    for (int j = jmin; j < 12; ++j) {
        const int cur = (j - jmin) & 1;
        if (j + 1 < 12) { kreg = *(const u32x4*)(Kb + g0 + (long)(j + 1) * 64 * 512); vreg = *(const u32x4*)(Vb + g0 + (long)(j + 1) * 64 * 512); }
        if (j >= ci && j <= ci + 8) {
            const LAS unsigned char* Kt = Ks + cur * 8192; const LAS unsigned char* Vt = Vs + cur * 8192;
            f32x16 pr[2];
#pragma unroll
            for (int kh = 0; kh < 2; ++kh) {
                f32x16 acc;
#pragma unroll
                for (int i = 0; i < 16; ++i) acc[i] = 0.f;
#pragma unroll
                for (int s = 0; s < 4; ++s) { const bf16x8 kf = *(const LAS bf16x8*)(Kt + kh * 4096 + kro + (((2 * s + hl) ^ ksw) << 4)); acc = MFMA32(kf, qf[s], acc); }
                pr[kh] = acc;
            }
            const int jp = j - ci;
            if (jp <= 5) {
#pragma unroll
                for (int kh = 0; kh < 2; ++kh)
#pragma unroll
                    for (int i = 0; i < 16; ++i) { const float p = __builtin_amdgcn_exp2f(pr[kh][i] + cb); pr[kh][i] = p; lsum += p; }
            } else {
                const int base = 64 * (8 - jp) + qi - 4 * hl;
#pragma unroll
                for (int kh = 0; kh < 2; ++kh)
#pragma unroll
                    for (int i = 0; i < 16; ++i) { int d = base - 32 * kh - ((i & 3) + 8 * (i >> 2)); d = (d > 128 ? 128 : d) + 128;
                        const float p = __builtin_amdgcn_exp2f(pr[kh][i] + tbl[d]); pr[kh][i] = p; lsum += p; }
            }
#pragma unroll
            for (int s16 = 0; s16 < 4; ++s16) {
                const bf16x8 pb = pack_step(pr[s16 >> 1], s16 & 1);
#pragma unroll
                for (int dh = 0; dh < 2; ++dh) {
                    const s16x4 lo = tr_read(Vt + vro + dh * 512 + (2 * s16) * 1024), hi = tr_read(Vt + vro + dh * 512 + (2 * s16 + 1) * 1024);
                    const bf16x8 va = __builtin_shufflevector(lo, hi, 0, 1, 2, 3, 4, 5, 6, 7);
                    o[dh] = MFMA32(va, pb, o[dh]);
                }
            }
        }
        if (j + 1 < 12) { *(LAS u32x4*)(Ks + (cur ^ 1) * 8192 + kst) = kreg; *(LAS u32x4*)(Vs + (cur ^ 1) * 8192 + vst) = vreg; }
        __syncthreads();
    }
    lsum += __shfl_xor(lsum, 32);
    const float inv = 1.0f / lsum;
    bf16* yo = YA + (size_t)qrow * 512 + h * 64 + 4 * hl;
#pragma unroll
    for (int dh = 0; dh < 2; ++dh)
#pragma unroll
        for (int g = 0; g < 4; ++g) { u32x2 wv; wv.x = cvtpk(o[dh][4 * g] * inv, o[dh][4 * g + 1] * inv); wv.y = cvtpk(o[dh][4 * g + 2] * inv, o[dh][4 * g + 3] * inv); *(u32x2*)(yo + 32 * dh + 8 * g) = wv; }
}
#ifndef ATT_PER_GLA
#define ATT_PER_GLA 0
#endif
__device__ __forceinline__ void phase_attn(const Frame& F, ArgsP a, int l) {
    const int bx = blockIdx.x, G = F.G;
    if (G == 256) {
        if ((bx & 3) == 0) { const int k = bx >> 2; for (int i = 0; i < ATT_PER_GLA; ++i) attn_unit(F, a, l, k + 64 * i); }
        else { const int k = bx - (bx >> 2) - 1; for (int u = 64 * ATT_PER_GLA + k; u < 1024; u += 192) attn_unit(F, a, l, u); }
    } else for (int u = bx; u < 1024; u += G) attn_unit(F, a, l, u);
}

constexpr int GL_QT = 0, GL_KT = 26112, GL_KH = 43520, GL_AT = 68096, GL_V = 84480, GL_D = 117248, GL_SS = 117760, GL_GN = 119808, GL_YL = 120320, GL_END = GL_YL + 2 * 64 * 264;
static_assert(GL_END <= SCR_BYTES, "GLA LDS map");
#define GL_BARRIER() do { asm volatile("s_waitcnt lgkmcnt(0)" ::: "memory"); __builtin_amdgcn_s_barrier(); asm volatile("" ::: "memory"); } while (0)
#define GL_AMP(k, t0) do { if (PROBE_PHASE == (k)) { const unsigned long long t1_ = __builtin_amdgcn_s_memrealtime(); const unsigned long long dt_ = t1_ - (t0); while (__builtin_amdgcn_s_memrealtime() - t1_ < dt_) __builtin_amdgcn_s_sleep(2); } } while (0)
__device__ __forceinline__ void gla_unit(const Frame& F, ArgsP a, int l, int u) {
    int lane = F.lane, tid = F.tid; asm volatile("" : "+v"(lane), "+v"(tid));
    const int w = __builtin_amdgcn_readfirstlane(F.wave), h = u & 3, b = u >> 2;
    const bf16* BQ = (const bf16*)(F.ws + WS_BQ); const bf16* BK = (const bf16*)(F.ws + WS_BK); const bf16* BV = (const bf16*)(F.ws + WS_BV); const bf16* BR = (const bf16*)(F.ws + WS_BR);
    const float* CB = (const float*)(F.ws + WS_LA); bf16* YB = (bf16*)(F.yab + YB_OFF);
    LAS unsigned char* L = F.lds;
    __syncthreads();
    if (tid < 128) *(LAS float*)(L + GL_GN + 4 * tid) = a->in[8][l * 512 + h * 128 + tid];
    if (w >= 4) {
        const int te = tid - 256, r = lane & 31, hl = lane >> 5;
        const int et = te >> 2, edk = (te & 3) * 16;
        const size_t ebase = ((size_t)b * SEQ + et) * 256 + h * 64 + edk, elast = ((size_t)b * SEQ + 63) * 256 + h * 64 + edk;
        u32x4 qraw[2], kraw[2], vraw[4], rraw[4]; f32x4 braw[4], lraw[4]; float draw = 0.f;
        auto loadE = [&](int c) { const size_t o = (size_t)c * 64 * 256;
#pragma unroll
            for (int j = 0; j < 2; ++j) { qraw[j] = *(const u32x4*)(BQ + ebase + o + 8 * j); kraw[j] = *(const u32x4*)(BK + ebase + o + 8 * j); }
#pragma unroll
            for (int j = 0; j < 4; ++j) { braw[j] = *(const f32x4*)(CB + ebase + o + 4 * j); lraw[j] = *(const f32x4*)(CB + elast + o + 4 * j); } };
        auto stageE = [&](int c) {
#pragma unroll
            for (int j = 0; j < 2; ++j) {
                f32x4 q0, q1, k0, k1; unpack8(qraw[j], q0, q1); unpack8(kraw[j], k0, k1); f32x4 eq0, eq1, ek0, ek1, eh0, eh1;
#pragma unroll
                for (int e = 0; e < 4; ++e) { eq0[e] = __expf(braw[2 * j][e]); eq1[e] = __expf(braw[2 * j + 1][e]); ek0[e] = __expf(-braw[2 * j][e]); ek1[e] = __expf(-braw[2 * j + 1][e]);
                    eh0[e] = __expf(lraw[2 * j][e] - braw[2 * j][e]); eh1[e] = __expf(lraw[2 * j + 1][e] - braw[2 * j + 1][e]); }
                const u32x4 qp = pack8c(q0 * eq0, q1 * eq1), kp = pack8c(k0 * ek0, k1 * ek1); const int dk_ = edk + 8 * j;
                LAS unsigned char* qd = L + GL_QT + (c % 3) * 8704 + et * 136 + dk_ * 2; *(LAS u32x2*)qd = (u32x2){qp.x, qp.y}; *(LAS u32x2*)(qd + 8) = (u32x2){qp.z, qp.w};
                LAS unsigned char* kd = L + GL_KT + (c & 1) * 8704 + et * 136 + dk_ * 2; *(LAS u32x2*)kd = (u32x2){kp.x, kp.y}; *(LAS u32x2*)(kd + 8) = (u32x2){kp.z, kp.w};
                *(LAS u32x4*)(L + GL_KH + (c % 3) * 8192 + ((et >> 3) * 2 + (dk_ >> 5)) * 512 + (et & 7) * 64 + (dk_ & 31) * 2) = pack8c(k0 * eh0, k1 * eh1);
            } };
        auto loadV = [&](int c) { const size_t tb_ = (size_t)b * SEQ + (size_t)c * 64;
#pragma unroll
            for (int k = 0; k < 4; ++k) { const int pi = te + 256 * k; vraw[k] = *(const u32x4*)(BV + (tb_ + (pi >> 4)) * 512 + h * 128 + (pi & 15) * 8); }
            if (te < 64) draw = CB[(tb_ + 63) * 256 + h * 64 + te]; };
        auto stageV = [&](int c) {
#pragma unroll
            for (int k = 0; k < 4; ++k) { const int pi = te + 256 * k, t_ = pi >> 4, c16 = pi & 15; *(LAS u32x4*)(L + GL_V + (c & 1) * 16384 + ((t_ >> 3) * 4 + (c16 >> 2)) * 512 + (t_ & 7) * 64 + (c16 & 3) * 16) = vraw[k]; }
            if (te < 64) *(LAS float*)(L + GL_D + (c & 1) * 256 + 4 * te) = __expf(draw); };
        auto loadR = [&](int c) { const size_t tb_ = (size_t)b * SEQ + (size_t)c * 64;
#pragma unroll
            for (int k = 0; k < 4; ++k) { const int pi = te + 256 * k; rraw[k] = *(const u32x4*)(BR + (tb_ + (pi >> 4)) * 512 + h * 128 + (pi & 15) * 8); } };
        auto stageW = [&](int c) { const size_t tb_ = (size_t)b * SEQ + (size_t)c * 64;
#pragma unroll
            for (int k = 0; k < 4; ++k) { const int pi = te + 256 * k, t_ = pi >> 4, c16 = pi & 15; const LAS unsigned char* yp = L + GL_YL + (c & 1) * 16896 + t_ * 264 + c16 * 16;
                const u32x2 y0 = *(const LAS u32x2*)yp, y1 = *(const LAS u32x2*)(yp + 8); f32x4 ya, yc, ra, rc; unpack8((u32x4){y0.x, y0.y, y1.x, y1.y}, ya, yc); unpack8(rraw[k], ra, rc);
                *(u32x4*)(YB + (tb_ + t_) * 512 + h * 128 + c16 * 8) = pack8c(ya * ra, yc * rc); } };
        auto stageA = [&](int c) {
            const LAS unsigned char* Qb_ = L + GL_QT + (c % 3) * 8704; const LAS unsigned char* Kb_ = L + GL_KT + (c & 1) * 8704; LAS unsigned char* Ab_ = L + GL_AT + (c & 1) * 8192;
            bf16x8 qf[2][4], kf[2][4];
#pragma unroll
            for (int tI = 0; tI < 2; ++tI)
#pragma unroll
                for (int s = 0; s < 4; ++s) { const int off = (32 * tI + r) * 136 + (16 * s + 8 * hl) * 2;
                    const u32x2 q0 = *(const LAS u32x2*)(Qb_ + off), q1 = *(const LAS u32x2*)(Qb_ + off + 8), k0 = *(const LAS u32x2*)(Kb_ + off), k1 = *(const LAS u32x2*)(Kb_ + off + 8);
                    qf[tI][s] = __builtin_bit_cast(bf16x8, (u32x4){q0.x, q0.y, q1.x, q1.y}); kf[tI][s] = __builtin_bit_cast(bf16x8, (u32x4){k0.x, k0.y, k1.x, k1.y}); }
#pragma unroll
            for (int tl = 0; tl < 3; ++tl) { const int it = tl == 0 ? 0 : 1, jt = tl == 1 ? 1 : 0;
                f32x16 at_;
#pragma unroll
                for (int i = 0; i < 16; ++i) at_[i] = 0.f;
#pragma unroll
                for (int s = 0; s < 4; ++s) at_ = MFMA32(kf[jt][s], qf[it][s], at_);
                const int i_ = 32 * it + r;
#pragma unroll
                for (int g = 0; g < 4; ++g) { float x0 = at_[4 * g], x1 = at_[4 * g + 1], x2 = at_[4 * g + 2], x3 = at_[4 * g + 3];
                    if (it == jt) { const int j0 = 8 * g + 4 * hl; x0 = (r >= j0) ? x0 : 0.f; x1 = (r >= j0 + 1) ? x1 : 0.f; x2 = (r >= j0 + 2) ? x2 : 0.f; x3 = (r >= j0 + 3) ? x3 : 0.f; }
                    *(LAS u32x2*)(Ab_ + i_ * 128 + (((4 * jt + g) ^ ((i_ >> 1) & 7)) << 4) + 8 * hl) = (u32x2){cvtpk(x0, x1), cvtpk(x2, x3)}; } }
        };
        loadE(0); loadV(0); stageE(0); loadE(1); stageV(0); loadV(1);
        GL_BARRIER();
        stageE(1); loadE(2); if (w == 4) stageA(0);
        GL_BARRIER();
        for (int c = 0; c < 34; ++c) {
            const unsigned long long tp0_ = (PROBE_PHASE == 42) ? __builtin_amdgcn_s_memrealtime() : 0ull;
            if (c + 2 < 32) stageE(c + 2);
            if (c + 3 < 32) loadE(c + 3);
            if (c + 1 < 32) stageV(c + 1);
            if (c + 2 < 32) loadV(c + 2);
            if (c >= 2) stageW(c - 2);
            if (c >= 1 && c - 1 < 32) loadR(c - 1);
            if (w == 4 && c + 1 < 32) stageA(c + 1);
            GL_AMP(42, tp0_);
            GL_BARRIER();
        }
    } else {
        const int n = w, r = lane & 31, hl = lane >> 5, g16 = lane >> 4, i16 = lane & 15;
        const int tro = (i16 >> 2) * 64 + (16 * (g16 & 1) + 4 * (i16 & 3)) * 2;
        f32x16 S[2], o[2]; u32x2 op[2][4];
#pragma unroll
        for (int i = 0; i < 16; ++i) { S[0][i] = 0.f; S[1][i] = 0.f; }
        LAS float* SSb = (LAS float*)(L + GL_SS); const LAS float* GN = (const LAS float*)(L + GL_GN) + 32 * n + 4 * hl;
        GL_BARRIER();
        GL_BARRIER();
        for (int c = 0; c < 34; ++c) {
            const unsigned long long tp0_ = (PROBE_PHASE == 41) ? __builtin_amdgcn_s_memrealtime() : 0ull;
            if (c >= 1 && c <= 32) {
                const int par = (c - 1) & 1;
#pragma unroll
                for (int tt = 0; tt < 2; ++tt) { const int t_ = 32 * tt + r; const float tot = SSb[par * 256 + t_] + SSb[par * 256 + 64 + t_] + SSb[par * 256 + 128 + t_] + SSb[par * 256 + 192 + t_];
                    const float rn = rsqrtf(tot * (1.0f / 128.0f) + EPS);
#pragma unroll
                    for (int g = 0; g < 4; ++g) { const u32x2 ov = op[tt][g]; const f32x4 gn = *(const LAS f32x4*)(GN + 8 * g);
                        *(LAS u32x2*)(L + GL_YL + par * 16896 + t_ * 264 + (32 * n + 8 * g + 4 * hl) * 2) = (u32x2){cvtpk(bflo(ov.x) * rn * gn[0], bfhi(ov.x) * rn * gn[1]), cvtpk(bflo(ov.y) * rn * gn[2], bfhi(ov.y) * rn * gn[3])}; } }
            }
            if (c < 32) {
                const LAS unsigned char* Qb_ = L + GL_QT + (c % 3) * 8704; const LAS unsigned char* Hb_ = L + GL_KH + (c % 3) * 8192; const LAS unsigned char* Ab_ = L + GL_AT + (c & 1) * 8192;
                const LAS unsigned char* Vb_ = L + GL_V + (c & 1) * 16384; const LAS unsigned char* Db_ = L + GL_D + (c & 1) * 256;
                bf16x8 sp[2][2];
#pragma unroll
                for (int dkt = 0; dkt < 2; ++dkt) { sp[dkt][0] = pack_step(S[dkt], 0); sp[dkt][1] = pack_step(S[dkt], 1); }
#pragma unroll
                for (int tt = 0; tt < 2; ++tt) {
                    f32x16 acc;
#pragma unroll
                    for (int i = 0; i < 16; ++i) acc[i] = 0.f;
#pragma unroll
                    for (int dkt = 0; dkt < 2; ++dkt)
#pragma unroll
                        for (int s = 0; s < 2; ++s) { const LAS unsigned char* qp_ = Qb_ + (32 * tt + r) * 136 + (32 * dkt + 16 * s + 4 * hl) * 2;
                            const u32x2 lo = *(const LAS u32x2*)qp_, hi = *(const LAS u32x2*)(qp_ + 16); const u32x4 qv = (u32x4){lo.x, lo.y, hi.x, hi.y};
                            acc = MFMA32(sp[dkt][s], __builtin_bit_cast(bf16x8, qv), acc); }
                    o[tt] = acc;
                }
                bf16x8 vf[4];
#pragma unroll
                for (int s = 0; s < 4; ++s) { const LAS unsigned char* vp_ = Vb_ + ((2 * s + hl) * 4 + n) * 512 + tro; const s16x4 lo = tr_read(vp_), hi = tr_read(vp_ + 256); vf[s] = __builtin_shufflevector(lo, hi, 0, 1, 2, 3, 4, 5, 6, 7); }
#pragma unroll
                for (int tt = 0; tt < 2; ++tt)
#pragma unroll
                    for (int s = 0; s < 4; ++s) { if (tt == 0 && s >= 2) continue;
                        const int i_ = 32 * tt + r; const bf16x8 af = *(const LAS bf16x8*)(Ab_ + i_ * 128 + (((2 * s + hl) ^ ((i_ >> 1) & 7)) << 4));
                        o[tt] = MFMA32(vf[s], af, o[tt]); }
#pragma unroll
                for (int dkt = 0; dkt < 2; ++dkt) {
#pragma unroll
                    for (int g = 0; g < 4; ++g) { const f32x4 d4 = *(const LAS f32x4*)(Db_ + (32 * dkt + 8 * g + 4 * hl) * 4);
                        S[dkt][4 * g] *= d4[0]; S[dkt][4 * g + 1] *= d4[1]; S[dkt][4 * g + 2] *= d4[2]; S[dkt][4 * g + 3] *= d4[3]; }
#pragma unroll
                    for (int s = 0; s < 4; ++s) { const LAS unsigned char* kp_ = Hb_ + ((2 * s + hl) * 2 + dkt) * 512 + tro; const s16x4 lo = tr_read(kp_), hi = tr_read(kp_ + 256);
                        S[dkt] = MFMA32(__builtin_shufflevector(lo, hi, 0, 1, 2, 3, 4, 5, 6, 7), vf[s], S[dkt]); }
                }
#pragma unroll
                for (int tt = 0; tt < 2; ++tt) { float q = 0.f;
#pragma unroll
                    for (int i = 0; i < 16; ++i) q += o[tt][i] * o[tt][i];
                    q += __shfl_xor(q, 32);
                    if (hl == 0) SSb[(c & 1) * 256 + n * 64 + 32 * tt + r] = q;
#pragma unroll
                    for (int g = 0; g < 4; ++g) op[tt][g] = (u32x2){cvtpk(o[tt][4 * g], o[tt][4 * g + 1]), cvtpk(o[tt][4 * g + 2], o[tt][4 * g + 3])}; }
            }
            GL_AMP(41, tp0_);
            GL_BARRIER();
        }
    }
    __syncthreads();
}
__device__ __forceinline__ void phase_gla(const Frame& F, ArgsP a, int l) {
    const int bx = blockIdx.x;
    if ((bx & 3) == 0) for (int u = bx >> 2; u < 64; u += (F.G + 3) >> 2) gla_unit(F, a, l, u);
}

typedef float f32x4_t __attribute__((ext_vector_type(4)));
constexpr int RT_LG = 0, RT_RS = 8 * 16 * 48 * 4;
__device__ __forceinline__ void phase_router(const Frame& F, ArgsP a, int l) {
    volatile LAS unsigned* lcnt = (volatile LAS unsigned*)(F.lds + LC_LCNT); volatile LAS unsigned* lbase = (volatile LAS unsigned*)(F.lds + LC_LBASE);
    LAS unsigned* rec = (LAS unsigned*)(F.lds + LC_REC); LAS float* recw = (LAS float*)(F.lds + LC_RECW); LAS float* recrs = (LAS float*)(F.lds + LC_RECRS);
    unsigned* gcnt = F.ctl + CW_GCNT + l * 64; unsigned* TREC = (unsigned*)(F.ws + WS_TREC); int* TOKL = (int*)(F.ws + WS_TOKL); float* TWL = (float*)(F.ws + WS_TWL); float* RSLL = (float*)(F.ws + WS_RSLL);
    const bf16* WRh = (const bf16*)(F.ws + WS_WR); const bf16* WRl = WRh + 48 * D;
    const float* bg = a->in[14] + l * 4; const float* br = a->in[16] + l * 32; const int lane = F.lane, row = lane & 15, kq = lane >> 4;
    LAS float* LG = (LAS float*)(F.lds + RT_LG) + F.wave * 16 * 48; LAS float* RSL = (LAS float*)(F.lds + RT_RS) + F.wave * 16;
    for (int blk = F.vcu; blk < T / 128; blk += F.G) {
        __syncthreads();
        if (F.tid < 32) lcnt[F.tid] = 0u;
        __syncthreads();
        const int t0 = blk * 128 + F.wave * 16;
        const bf16* xr = (const bf16*)(F.ws + WS_XB) + (size_t)(t0 + row) * D + 8 * kq; const bf16* wh = WRh + (size_t)row * D + 8 * kq; const bf16* wl = WRl + (size_t)row * D + 8 * kq;
        f32x4 acc[3]; float ss = 0.f;
#pragma unroll
        for (int nt = 0; nt < 3; ++nt) acc[nt] = (f32x4){0.f, 0.f, 0.f, 0.f};
#pragma unroll 4
        for (int ks = 0; ks < 32; ++ks) {
            const u32x4 hp = *(const u32x4*)(xr + 32 * ks); f32x4 x0, x1; unpack8(hp, x0, x1);
            ss += (x0[0] * x0[0] + x0[1] * x0[1]) + (x0[2] * x0[2] + x0[3] * x0[3]) + (x1[0] * x1[0] + x1[1] * x1[1]) + (x1[2] * x1[2] + x1[3] * x1[3]);
            const bf16x8 ah = __builtin_bit_cast(bf16x8, hp);
#pragma unroll
            for (int nt = 0; nt < 3; ++nt) { const bf16x8 bh = *(const bf16x8*)(wh + (size_t)nt * 16 * D + 32 * ks), bl = *(const bf16x8*)(wl + (size_t)nt * 16 * D + 32 * ks);
                acc[nt] = __builtin_amdgcn_mfma_f32_16x16x32_bf16(ah, bh, acc[nt], 0, 0, 0); acc[nt] = __builtin_amdgcn_mfma_f32_16x16x32_bf16(ah, bl, acc[nt], 0, 0, 0); }
        }
        ss += __shfl_xor(ss, 16); ss += __shfl_xor(ss, 32);
        if (kq == 0) RSL[row] = rsqrtf(ss * (1.0f / D) + EPS);
#pragma unroll
        for (int nt = 0; nt < 3; ++nt)
#pragma unroll
            for (int e = 0; e < 4; ++e) LG[(4 * kq + e) * 48 + 16 * nt + row] = acc[nt][e];
        LDS_WAIT(); asm volatile("" ::: "memory");
        if (lane < 16) {
            const int tl = F.wave * 16 + lane, t = t0 + lane; const float rs = RSL[lane]; const LAS float* lg = LG + lane * 48;
            float gl[4];
#pragma unroll
            for (int g = 0; g < 4; ++g) gl[g] = lg[g] * rs + bg[g];
            int gi = 0; float gm = gl[0];
#pragma unroll
            for (int g = 1; g < 4; ++g) if (gl[g] > gm) { gm = gl[g]; gi = g; }
            float Z = 0.f;
#pragma unroll
            for (int g = 0; g < 4; ++g) Z += __expf(gl[g] - gm);
            const float gtop = 1.0f / Z;
            float el[8];
#pragma unroll
            for (int i = 0; i < 8; ++i) el[i] = lg[4 + 8 * gi + i] * rs + br[8 * gi + i];
            int i1 = 0; float m1 = el[0];
#pragma unroll
            for (int i = 1; i < 8; ++i) if (el[i] > m1) { m1 = el[i]; i1 = i; }
            int i2 = -1; float m2 = -3.0e38f;
#pragma unroll
            for (int i = 0; i < 8; ++i) if (i != i1 && el[i] > m2) { m2 = el[i]; i2 = i; }
            const float w1 = 1.0f / (1.0f + __expf(m2 - m1)), w2 = 1.0f - w1;
            const int e1 = gi * 8 + i1, e2 = gi * 8 + i2;
            const unsigned p1 = __hip_atomic_fetch_add((LAS unsigned*)(F.lds + LC_LCNT) + e1, 1u, __ATOMIC_RELAXED, __HIP_MEMORY_SCOPE_WORKGROUP), p2 = __hip_atomic_fetch_add((LAS unsigned*)(F.lds + LC_LCNT) + e2, 1u, __ATOMIC_RELAXED, __HIP_MEMORY_SCOPE_WORKGROUP);
            rec[2 * tl] = ((unsigned)e1 << 16) | p1; rec[2 * tl + 1] = ((unsigned)e2 << 16) | p2; recw[2 * tl] = w1 * gtop; recw[2 * tl + 1] = w2 * gtop;
            recrs[tl] = rs;
        }
        __syncthreads();
        if (F.tid < 32) lbase[F.tid] = __hip_atomic_fetch_add(gcnt + F.tid, lcnt[F.tid], RLX_AGENT);
        __syncthreads();
        if (F.tid < 256) { const unsigned rc = rec[F.tid], e = rc >> 16, pos = (rc & 0xffffu) + lbase[e]; TREC[(size_t)blk * 256 + F.tid] = (e << 16) | pos;
            const size_t li = (size_t)e * 32768 + pos; TOKL[li] = blk * 128 + (F.tid >> 1); TWL[li] = recw[F.tid]; RSLL[li] = recrs[F.tid >> 1]; }
    }
}
__device__ __forceinline__ void build_tiles(const Frame& F, int l) {
    volatile LAS int* tbase = (volatile LAS int*)(F.lds + LC_TBASE); volatile LAS int* tile_e = (volatile LAS int*)(F.lds + LC_TILEE);
    __syncthreads();
    if (F.tid == 0) { int s = 0; for (int e = 0; e < NE; ++e) { tbase[e] = s; const int n = (int)__hip_atomic_load(F.ctl + CW_GCNT + l * 64 + e, RLX_AGENT); s += (n + 255) >> 8; } tbase[NE] = s; }
    __syncthreads();
    if (F.tid < NE) { const int t0 = tbase[F.tid], t1 = tbase[F.tid + 1]; for (int t = t0; t < t1 && t < MAXTILES; ++t) tile_e[t] = F.tid; }
    __syncthreads();
}
constexpr int GT_OFF = 131072;
__device__ __forceinline__ void build_gather(const Frame& F, int l, int NPN) {
    const volatile LAS int* tbase = (const volatile LAS int*)(F.lds + LC_TBASE); const volatile LAS int* tile_e = (const volatile LAS int*)(F.lds + LC_TILEE);
    LAS unsigned* tab = (LAS unsigned*)(F.lds + GT_OFF); const int* TOKL = (const int*)(F.ws + WS_TOKL);
    const int ntiles = tbase[NE];
    for (int i = 0; i < 4; ++i) { const long L = (long)i * F.G + blockIdx.x; if (L >= (long)ntiles * NPN) break;
        const int tile = (int)(L / NPN), e = tile_e[tile], k = tile - tbase[e]; const int ne = (int)__hip_atomic_load(F.ctl + CW_GCNT + l * 64 + e, RLX_AGENT);
        if (F.tid < 256) { const int pos = 256 * k + F.tid; tab[i * 256 + F.tid] = pos < ne ? (unsigned)TOKL[(size_t)e * 32768 + pos] * (unsigned)(D * 2) : 0u; } }
    __syncthreads();
}
__device__ __forceinline__ void phase_final(const Frame& F, float* out, bool make_xb, int lprev) {
    build_tiles(F, lprev);
    const volatile LAS int* tbase = (const volatile LAS int*)(F.lds + LC_TBASE);
    const unsigned* TREC = (const unsigned*)(F.ws + WS_TREC); const bf16* Y = (const bf16*)(F.ws + WS_Y); bf16* XB = (bf16*)(F.ws + WS_XB); float* RS = (float*)(F.ws + WS_RS1);
    const int gw = F.vcu * 8 + F.wave, NGW = F.G * 8;
    for (int t = gw; t < T; t += NGW) {
        const unsigned r0 = TREC[2 * t], r1 = TREC[2 * t + 1];
        const int s0 = 256 * tbase[r0 >> 16] + (int)(r0 & 0xffffu), s1 = 256 * tbase[r1 >> 16] + (int)(r1 & 0xffffu);
        u32x4* xr = (u32x4*)(XB + (size_t)t * D) + F.lane; const u32x4* y0 = (const u32x4*)(Y + (size_t)s0 * D) + F.lane; const u32x4* y1 = (const u32x4*)(Y + (size_t)s1 * D) + F.lane;
        f32x4 v[2][2]; float s = 0.f;
#pragma unroll
        for (int j = 0; j < 2; ++j) { f32x4 xa, xc, a0, a1, c0, c1; unpack8(xr[64 * j], xa, xc); unpack8(y0[64 * j], a0, a1); unpack8(y1[64 * j], c0, c1);
            v[j][0] = xa + a0 + c0; v[j][1] = xc + a1 + c1;
#pragma unroll
            for (int e = 0; e < 4; ++e) s += v[j][0][e] * v[j][0][e] + v[j][1][e] * v[j][1][e]; }
        if (make_xb) {
            s = wave_sum(s);
#pragma unroll
            for (int j = 0; j < 2; ++j) xr[64 * j] = pack8c(v[j][0], v[j][1]);
            if (F.lane == 0) RS[t] = rsqrtf(s * (1.0f / D) + EPS);
        } else {
            f32x4* o = (f32x4*)(out + (size_t)t * D) + 2 * F.lane;
#pragma unroll
            for (int j = 0; j < 2; ++j) { o[128 * j] = v[j][0]; o[128 * j + 1] = v[j][1]; }
        }
    }
}

constexpr int PH_PER_LAYER = 16, NPH = DEPTH * PH_PER_LAYER;
#ifndef PH_MASK
#define PH_MASK 0x1ffff
#endif
#ifndef DUP_MASK
#define DUP_MASK 0
#endif
#define PB(k) const unsigned long long pb_t0_ = (PROBE_PHASE == (k)) ? __builtin_amdgcn_s_memrealtime() : 0ull
#define PE(k) do { if (PROBE_PHASE == (k)) { const unsigned long long t1_ = __builtin_amdgcn_s_memrealtime(); const unsigned long long dt_ = t1_ - pb_t0_; while (__builtin_amdgcn_s_memrealtime() - t1_ < dt_) __builtin_amdgcn_s_sleep(8); } } while (0)
#define REP(k) for (int rep_ = 0; rep_ < 1 + ((DUP_MASK >> (k)) & 1); ++rep_)
__global__ void __launch_bounds__(512, 2) fwd_kernel(Args args_unused) {
    extern __shared__ __attribute__((aligned(16))) unsigned char lds_raw[];
    const int wave0 = __builtin_amdgcn_readfirstlane((int)threadIdx.x >> 6);
    {
        LAS unsigned char* lds0 = (LAS unsigned char*)lds_raw;
        for (int u = threadIdx.x; u < (LDS_BYTES - LC_OFF) / 4; u += 512) ((LAS unsigned*)(lds0 + LC_OFF))[u] = 0u;
        __syncthreads();
    }
#if MK_ONE_LAUNCH
    XcdBarrier bar; { ArgsP ap = get_args(); bar = xcd_barrier_post((unsigned*)(ap->ws + WS_CTL) + CW_BAR, (volatile LAS unsigned*)((LAS unsigned char*)lds_raw + LC_MISC) + 8); }
#define GRID_BAR() do { PB(14); xcd_barrier(bar); PE(14); } while (0)
#else
#define GRID_BAR() do { } while (0)
#endif
    int lo, hi; { ArgsP ap = get_args(); lo = ap->ph_lo; hi = ap->ph_hi; }
#define IN(k) (((PH_MASK >> ((k) % PH_PER_LAYER)) & 1) && lo <= (k) && (k) < hi)
#define SEAM(k) GRID_BAR()
    for (int l = 0; l < DEPTH; ++l) {
        const int P = l * PH_PER_LAYER;
        if (IN(P + 0)) REP(0) { PB(0); ArgsP ap = get_args(); const Frame F = make_frame(ap, wave0); if (l == 0) phase_x_to_xb(F, ap->in[0]); else phase_final(F, ap->out, true, l - 1); phase_weights(F, ap, l); PE(0); }
        SEAM(P + 0);
        if (IN(P + 1)) REP(1) { PB(1);
            ArgsP ap = get_args(); const Frame F = make_frame(ap, wave0);
            pg8::DenseOrder S; S.init(T, NIN, D, F.G, (int)blockIdx.x, F.ws + WS_XB, F.ws + WS_WIN);
            EpiIn E{(const float*)(F.ws + WS_RS1), (bf16*)(F.ws + WS_Q), (bf16*)(F.ws + WS_K), (bf16*)(F.ws + WS_V), (bf16*)(F.ws + WS_BQ), (bf16*)(F.ws + WS_BK), (bf16*)(F.ws + WS_BV), (bf16*)(F.ws + WS_BR),
                    (bf16*)(F.ws + WS_R), (bf16*)(F.ws + WS_GB), (float*)(F.ws + WS_LA), ap->in[3] + l * 512, ap->in[4] + l * 512, ap->in[7] + l * 256};
            pg8::gemm_phase<EpiIn, pg8::DenseOrder, PG8_ALIGN, PG8_SP2>(F.lds, D, S, E, F.tid); PE(1);
        }
        SEAM(P + 1);
        if (IN(P + 2)) { PB(2); REP(11) { PB(11); ArgsP ap = get_args(); const Frame F = make_frame(ap, wave0); phase_gla(F, ap, l); PE(11); } if (PH_MASK & 0x10000) REP(12) { PB(12); ArgsP ap = get_args(); const Frame F = make_frame(ap, wave0); phase_attn(F, ap, l); PE(12); } PE(2); }
        SEAM(P + 2);
        if (IN(P + 3)) REP(3) { PB(3);
            ArgsP ap = get_args(); const Frame F = make_frame(ap, wave0);
            pg8::ChainOrder S; S.d0.init(T, D, 512, F.G, (int)blockIdx.x, F.yab, F.ws + WS_PA); S.d1.init(T, D, 512, F.G, (int)blockIdx.x, F.yab + YB_OFF, F.ws + WS_PB);
            EpiMerge E{(const bf16*)(F.ws + WS_R), (const bf16*)(F.ws + WS_GB), (bf16*)(F.ws + WS_MRG)};
            pg8::gemm_phase<EpiMerge, pg8::ChainOrder, PG8_ALIGN, PG8_SP2>(F.lds, 512, S, E, F.tid); PE(3);
        }
        SEAM(P + 3);
        if (IN(P + 5)) { PB(5);
            ArgsP ap = get_args(); const Frame F = make_frame(ap, wave0);
            pg8::DenseOrder S; S.init(T, D, D, F.G, (int)blockIdx.x, F.ws + WS_MRG, F.ws + WS_WOUT);
            EpiOut E{(bf16*)(F.ws + WS_XB)};
            pg8::gemm_phase<EpiOut, pg8::DenseOrder, PG8_ALIGN, PG8_SP2>(F.lds, D, S, E, F.tid); PE(5);
        }
        SEAM(P + 5);
        if (IN(P + 6)) { PB(6); ArgsP ap = get_args(); const Frame F = make_frame(ap, wave0); phase_router(F, ap, l); PE(6); }
        SEAM(P + 6);
        if (IN(P + 8)) REP(8) { PB(8);
            ArgsP ap = get_args(); const Frame F = make_frame(ap, wave0);
            build_tiles(F, l); build_gather(F, l, 2);
            pg8::ExpertOrderT<true> S; S.tile_e = (const LAS int*)(F.lds + LC_TILEE); S.tbase = (const LAS int*)(F.lds + LC_TBASE); S.tab = (const LAS unsigned*)(F.lds + GT_OFF);
            S.ntiles = __builtin_amdgcn_readfirstlane(*(const LAS int*)(F.lds + LC_TBASE + 4 * NE)); S.NPN = 2; S.G = F.G; S.c = (int)blockIdx.x;
            S.A = (const char*)(F.ws + WS_XB); S.B = (const char*)(F.ws + WS_WGU); S.a_tile = 0; S.b_exp = (size_t)512 * D * 2; S.b_pn = (size_t)256 * D * 2;
            EpiGU E{(const float*)(F.ws + WS_RSLL), (bf16*)(F.ws + WS_H)};
            pg8::gemm_phase<EpiGU, pg8::ExpertOrderT<true>, PG8_ALIGN, PG8_SP2>(F.lds, D, S, E, F.tid); PE(8);
        }
        SEAM(P + 8);
        if (IN(P + 9)) REP(9) { PB(9);
            ArgsP ap = get_args(); const Frame F = make_frame(ap, wave0);
            build_tiles(F, l);
            pg8::ExpertOrderT<false> S; S.tile_e = (const LAS int*)(F.lds + LC_TILEE); S.tbase = (const LAS int*)(F.lds + LC_TBASE); S.tab = nullptr;
            S.ntiles = __builtin_amdgcn_readfirstlane(*(const LAS int*)(F.lds + LC_TBASE + 4 * NE)); S.NPN = 4; S.G = F.G; S.c = (int)blockIdx.x;
            S.A = (const char*)(F.ws + WS_H); S.B = (const char*)(F.ws + WS_WD); S.a_tile = (size_t)256 * DE * 2; S.b_exp = (size_t)D * DE * 2; S.b_pn = (size_t)256 * DE * 2;
            EpiDown E{(const float*)(F.ws + WS_TWL), (bf16*)(F.ws + WS_Y)};
            pg8::gemm_phase<EpiDown, pg8::ExpertOrderT<false>, PG8_ALIGN, PG8_SP2>(F.lds, DE, S, E, F.tid); PE(9);
        }
        GRID_BAR();
    }
    { PB(15); ArgsP ap = get_args(); const Frame F = make_frame(ap, wave0); phase_final(F, ap->out, false, DEPTH - 1); PE(15); }
#undef IN
#undef SEAM
}

extern "C" void kernel_launch(void* const* d_in, const int* in_sizes, int n_in, void* d_out, int out_size, void* d_ws, size_t ws_size, hipStream_t stream) {
    static int grid = 0;
    if (grid == 0) {
        if (n_in != 20 || in_sizes[0] != T * D || out_size != T * D || ws_size < WS_END) { fprintf(stderr, "kernel_launch: unexpected shapes (n_in %d, in0 %d, out %d, ws %zu); nothing launched\n", n_in, n_in > 0 ? in_sizes[0] : -1, out_size, ws_size); grid = -1; return; }
        int dev = 0, cus = 0;
        if (hipGetDevice(&dev) != hipSuccess || hipDeviceGetAttribute(&cus, hipDeviceAttributeMultiprocessorCount, dev) != hipSuccess) { grid = -1; return; }
        if (hipFuncSetAttribute((const void*)fwd_kernel, hipFuncAttributeMaxDynamicSharedMemorySize, LDS_BYTES) != hipSuccess) { fprintf(stderr, "kernel_launch: hipFuncSetAttribute failed\n"); grid = -1; return; }
        grid = cus;
    }
    if (grid < 0) return;
    (void)hipMemsetAsync((char*)d_ws + WS_CTL, 0, CTL_ZERO_BYTES, stream);
    Args a{};
    for (int i = 0; i < 20; ++i) a.in[i] = (const float*)d_in[i];
    a.out = (float*)d_out; a.ws = (unsigned char*)d_ws;
#if MK_ONE_LAUNCH
    a.ph_lo = 0; a.ph_hi = NPH;
    hipLaunchKernelGGL(fwd_kernel, dim3(grid), dim3(512), LDS_BYTES, stream, a);
#else
    for (int l = 0; l < DEPTH; ++l)
        for (int p = 0; p <= 10; ++p) { a.ph_lo = l * PH_PER_LAYER + p; a.ph_hi = a.ph_lo + 1; hipLaunchKernelGGL(fwd_kernel, dim3(grid), dim3(512), LDS_BYTES, stream, a); }
#endif
}
```

```cpp
#include <hip/hip_runtime.h>
#include <cstdio>
#include <cstdint>

#ifndef PROBE_PHASE
#define PROBE_PHASE -1
#endif
#ifndef MK_ONE_LAUNCH
#define MK_ONE_LAUNCH 1
#endif

#define LAS __attribute__((address_space(3)))
#define GAS __attribute__((address_space(1)))
typedef unsigned short bf16;
typedef short bf16x8 __attribute__((ext_vector_type(8)));
typedef float f32x4 __attribute__((ext_vector_type(4)));
typedef float f32x2 __attribute__((ext_vector_type(2)));
typedef unsigned u32x4 __attribute__((ext_vector_type(4)));
typedef unsigned u32x2 __attribute__((ext_vector_type(2)));

constexpr int T = 32768, D = 1024, SEQ = 2048, DEPTH = 2;
constexpr int IN_COLS = 5136, NIN = 5632;
constexpr int NE = 32, DE = 256;
constexpr int MAXTILES = 288;
constexpr float EPS = 1e-6f, LOG2E = 1.4426950408889634f;

namespace pg8 {
constexpr int BM = 256, BK = 64, HALF = 128, HTB = HALF * BK * 2  , STAGE_BYTES = 8 * HTB, NXCD = 8, WGM = 8;
__host__ __device__ __forceinline__ int lds_byte(int r, int c) { const int st = (r >> 4) * 2 + (c >> 5), rr = r & 15, cc = c & 31, ob = rr * 64 + cc * 2; return st * 1024 + (ob ^ (((ob >> 9) & 1) << 5)); }
__host__ __device__ __forceinline__ void stage_rc(int b, int& R, int& C) { const int st = b / 1024, sb = b % 1024, swz = sb ^ (((sb >> 9) & 1) << 5); R = (st >> 1) * 16 + swz / 64; C = (st & 1) * 32 + (swz % 64) / 2; }
__host__ __device__ __forceinline__ int perm32(int rho) { const int n = rho >> 4, i = rho & 15; return 8 * (i >> 2) + 4 * n + (i & 3); }

struct Unit { int pm, pn; const char* A; const char* B; int sub, aux; };

struct DenseOrder {
    static constexpr bool GATHER = false;
    int nM, nN, nwg, G, c; const char* A; const char* Bt; size_t tstep;
    __device__ void init(int M, int N, int K, int G_, int c_, const void* A_, const void* Bt_) { nM = M / BM; nN = N / BM; nwg = nM * nN; G = G_; c = c_; A = (const char*)A_; Bt = (const char*)Bt_; tstep = (size_t)BM * K * 2; }
    __device__ bool next(int i, Unit& u) const {
        const long L = (long)i * G + c; if (L >= nwg) return false;
        int wgid = (int)L; { const int q = nwg / NXCD, r = nwg % NXCD, xcd = wgid % NXCD, off = wgid / NXCD; wgid = (xcd < r ? xcd * (q + 1) : r * (q + 1) + (xcd - r) * q) + off; }
        const int nig = WGM * nN, gid = wgid / nig, fm = gid * WGM, gsz = (nM - fm) < WGM ? (nM - fm) : WGM;
        u.pm = fm + ((wgid % nig) % gsz); u.pn = (wgid % nig) / gsz; u.A = A + (size_t)u.pm * tstep; u.B = Bt + (size_t)u.pn * tstep; u.sub = 0; return true;
    }
    __device__ __forceinline__ void a_ready(const Unit&) const {}
    __device__ __forceinline__ void done(const Unit&) const {}
};
struct ChainOrder {
    static constexpr bool GATHER = false;
    DenseOrder d0, d1;
    __device__ bool next(int i, Unit& u) const { const bool ok = (i & 1) ? d1.next(i >> 1, u) : d0.next(i >> 1, u); u.sub = i & 1; return ok; }
    __device__ __forceinline__ void a_ready(const Unit&) const {}
    __device__ __forceinline__ void done(const Unit&) const {}
};
template <bool GATHER_> struct ExpertOrderT {
    static constexpr bool GATHER = GATHER_;
    const LAS int* tile_e; const LAS int* tbase; const LAS unsigned* tab; int ntiles, NPN, G, c; const char* A; const char* B; size_t a_tile, b_exp, b_pn;
    __device__ bool next(int i, Unit& u) const {
        const long L = (long)i * G + c; if (L >= (long)ntiles * NPN) return false;
        const int tile = (int)(L / NPN), pn = (int)(L % NPN); const int e = __builtin_amdgcn_readfirstlane(tile_e[tile]); const int k = tile - __builtin_amdgcn_readfirstlane(tbase[e]);
        u.pm = tile; u.pn = pn; u.A = GATHER_ ? A : A + (size_t)tile * a_tile; u.B = B + (size_t)e * b_exp + (size_t)pn * b_pn; u.sub = 0; u.aux = e * 32768 + 256 * k; return true;
    }
    __device__ __forceinline__ unsigned row_off(int i, int row) const { return tab[i * 256 + row]; }
    __device__ __forceinline__ void a_ready(const Unit&) const {}
    __device__ __forceinline__ void done(const Unit&) const {}
};
__device__ __forceinline__ unsigned cvt_pk_bf16(float lo, float hi) { unsigned r; asm volatile("v_cvt_pk_bf16_f32 %0, %1, %2" : "=v"(r) : "v"(lo), "v"(hi)); return r; }

template <class Epi, class Sched, bool ALIGN_EPI = false, bool SP2 = false>
__device__ __forceinline__ void gemm_phase(LAS unsigned char* lds, const int K, const Sched& S, const Epi& E, int tid_) {
    asm volatile("" : "+v"(tid_));
    const int tid = tid_, wid = __builtin_amdgcn_readfirstlane(tid >> 6), lane = tid & 63, wr = wid >> 2, wc = wid & 3, fr = lane & 15, fq = lane >> 4;
    const int nt = K / BK;
    unsigned voffA[2], voffB[2];
#pragma unroll
    for (int i = 0; i < 2; ++i) { int R, C; stage_rc(tid * 16 + i * 8192, R, C); const int Rb = Epi::PERM ? ((R & ~31) + perm32(R & 31)) : R;
        voffA[i] = (unsigned)(R * K + C) * 2u; voffB[i] = (unsigned)(Rb * K + C) * 2u; }
    const size_t kstep = (size_t)(BK * 2);
    const size_t hstep = (size_t)HALF * K * 2;
    const unsigned ldsw = (unsigned)wid * 1024u;
    unsigned gc[2][2] = {{0u, 0u}, {0u, 0u}}, gn[2][2] = {{0u, 0u}, {0u, 0u}}; int gR[2] = {0, 0}; unsigned gC[2] = {0u, 0u};
    if constexpr (Sched::GATHER) {
#pragma unroll
        for (int i = 0; i < 2; ++i) { int R, C; stage_rc(tid * 16 + i * 8192, R, C); gR[i] = R; gC[i] = (unsigned)C * 2u; }
    }
    const int aoff = lds_byte(wr * 64 + fr, fq * 8), boff = lds_byte(wc * 32 + fr, fq * 8);
#define PG8_SA(b, h) (((b) * 2 + (h)) * HTB)
#define PG8_SB(b, h) ((4 + (b) * 2 + (h)) * HTB)
#define PG8_STAGE(bufoff, gbase, voff) do { _Pragma("unroll") for (int _i = 0; _i < 2; ++_i) \
        __builtin_amdgcn_global_load_lds((const unsigned*)((const char*)(gbase) + (voff)[_i]), (LAS unsigned*)(lds + (bufoff) + ldsw + _i * 8192), 16, 0, 0); } while (0)
#define PG8_STAGE_A(bufoff, gbase, half, nx) do { if constexpr (Sched::GATHER) { _Pragma("unroll") for (int _i = 0; _i < 2; ++_i) \
        __builtin_amdgcn_global_load_lds((const unsigned*)((const char*)(gbase) + ((nx) ? gn[half][_i] : gc[half][_i])), (LAS unsigned*)(lds + (bufoff) + ldsw + _i * 8192), 16, 0, 0); } \
        else { PG8_STAGE(bufoff, (gbase) + (half) * hstep, voffA); } } while (0)
#define PG8_LDA(dst, b, h) do { _Pragma("unroll") for (int m = 0; m < 4; ++m) _Pragma("unroll") for (int k = 0; k < 2; ++k) dst[m][k] = *(const LAS bf16x8*)(lds + PG8_SA(b, h) + aoff + m * 2048 + k * 1024); } while (0)
#define PG8_LDB(dst, b, h) do { _Pragma("unroll") for (int n = 0; n < 2; ++n) _Pragma("unroll") for (int k = 0; k < 2; ++k) dst[n][k] = *(const LAS bf16x8*)(lds + PG8_SB(b, h) + boff + n * 2048 + k * 1024); } while (0)
#define PG8_MMA(ai, bj, At, Bt) do { __builtin_amdgcn_s_setprio(1); _Pragma("unroll") for (int m = 0; m < 4; ++m) _Pragma("unroll") for (int n = 0; n < 2; ++n) _Pragma("unroll") for (int k = 0; k < 2; ++k) \
        acc[ai][bj][m][n] = __builtin_amdgcn_mfma_f32_16x16x32_bf16(Bt[n][k], At[m][k], acc[ai][bj][m][n], 0, 0, 0); __builtin_amdgcn_s_setprio(0); } while (0)
#define PG8_WAIT_V(n) asm volatile("s_waitcnt vmcnt(" #n ")" ::: "memory")
#define PG8_WAIT_L(n) asm volatile("s_waitcnt lgkmcnt(" #n ")" ::: "memory")
#define PG8_BAR __builtin_amdgcn_s_barrier()
#define PG8_SCHED __builtin_amdgcn_sched_barrier(0)
    Unit cur, nxt; int ui = 0;
    if (!S.next(0, cur)) return;
    f32x4 acc[2][2][4][2];
#pragma unroll
    for (int a = 0; a < 2; ++a)
#pragma unroll
        for (int b = 0; b < 2; ++b)
#pragma unroll
            for (int m = 0; m < 4; ++m)
#pragma unroll
                for (int n = 0; n < 2; ++n) acc[a][b][m][n] = (f32x4){0.f, 0.f, 0.f, 0.f};
    bf16x8 At[4][2], B0[2][2], B1[2][2];
    const char* cA = cur.A; const char* cB = cur.B;
    if constexpr (Sched::GATHER) {
#pragma unroll
        for (int h = 0; h < 2; ++h)
#pragma unroll
            for (int i = 0; i < 2; ++i) gc[h][i] = S.row_off(0, 128 * h + gR[i]) + gC[i];
    }
    S.a_ready(cur);
    if constexpr (SP2) {
        PG8_STAGE(PG8_SB(0, 0), cB, voffB); PG8_STAGE(PG8_SB(0, 1), cB + hstep, voffB); PG8_STAGE_A(PG8_SA(0, 0), cA, 0, false); PG8_STAGE_A(PG8_SA(0, 1), cA, 1, false);
        if (wr == 1) PG8_BAR;
        PG8_WAIT_V(2); PG8_BAR;
        PG8_STAGE(PG8_SB(1, 0), cB + kstep, voffB); PG8_STAGE_A(PG8_SA(1, 0), cA + kstep, 0, false); PG8_STAGE(PG8_SB(1, 1), cB + hstep + kstep, voffB);
        PG8_WAIT_V(6); PG8_BAR;
    } else {
        PG8_STAGE(PG8_SB(0, 0), cB, voffB); PG8_STAGE_A(PG8_SA(0, 0), cA, 0, false); PG8_STAGE(PG8_SB(0, 1), cB + hstep, voffB); PG8_STAGE_A(PG8_SA(0, 1), cA, 1, false);
        if (wr == 1) PG8_BAR;
        PG8_WAIT_V(4); PG8_BAR;
        PG8_STAGE(PG8_SB(1, 0), cB + kstep, voffB); PG8_STAGE_A(PG8_SA(1, 0), cA + kstep, 0, false); PG8_STAGE(PG8_SB(1, 1), cB + hstep + kstep, voffB);
        PG8_WAIT_V(6); PG8_BAR;
    }
    for (;;) {
        const bool has_next = S.next(ui + 1, nxt);
        const char* nA = has_next ? nxt.A : cA; const char* nB = has_next ? nxt.B : cB;
        if constexpr (Sched::GATHER) {
#pragma unroll
            for (int h = 0; h < 2; ++h)
#pragma unroll
                for (int i = 0; i < 2; ++i) gn[h][i] = has_next ? S.row_off(ui + 1, 128 * h + gR[i]) + gC[i] : gc[h][i];
        }
        for (int t = 0; t < nt; t += 2) {
            const bool last = (t == nt - 2);
            const char* a1 = cA + (size_t)(t + 1) * kstep;
            const char* a2 = last ? nA : cA + (size_t)(t + 2) * kstep; const char* b2 = last ? nB : cB + (size_t)(t + 2) * kstep;
            const char* a3 = a2 + kstep; const char* b3 = b2 + kstep;
            if (last && has_next) S.a_ready(nxt);
            if constexpr (SP2) {
            PG8_LDB(B0, 0, 0); PG8_LDB(B1, 0, 1); PG8_SCHED; PG8_LDA(At, 0, 0); PG8_STAGE_A(PG8_SA(1, 1), a1, 1, false);
            PG8_WAIT_V(8); PG8_WAIT_L(0); PG8_BAR; PG8_MMA(0, 0, At, B0); PG8_MMA(0, 1, At, B1); PG8_BAR; PG8_SCHED;
            PG8_LDA(At, 0, 1); PG8_STAGE(PG8_SB(0, 0), b2, voffB); PG8_STAGE(PG8_SB(0, 1), b2 + hstep, voffB); PG8_STAGE_A(PG8_SA(0, 0), a2, 0, last);
            PG8_WAIT_V(8); PG8_WAIT_L(0); PG8_BAR; PG8_MMA(1, 0, At, B0); PG8_MMA(1, 1, At, B1); PG8_BAR; PG8_SCHED;
            PG8_LDB(B0, 1, 0); PG8_LDB(B1, 1, 1); PG8_SCHED; PG8_LDA(At, 1, 0); PG8_STAGE_A(PG8_SA(0, 1), a2, 1, last);
            PG8_WAIT_V(8); PG8_WAIT_L(0); PG8_BAR; PG8_MMA(0, 0, At, B0); PG8_MMA(0, 1, At, B1); PG8_BAR; PG8_SCHED;
            PG8_LDA(At, 1, 1); PG8_STAGE(PG8_SB(1, 0), b3, voffB); PG8_STAGE(PG8_SB(1, 1), b3 + hstep, voffB); PG8_STAGE_A(PG8_SA(1, 0), a3, 0, last);
            PG8_WAIT_V(8); PG8_WAIT_L(0); PG8_BAR; PG8_MMA(1, 0, At, B0); PG8_MMA(1, 1, At, B1); PG8_BAR; PG8_SCHED;
            } else {
            PG8_LDB(B0, 0, 0); PG8_SCHED; PG8_LDA(At, 0, 0); PG8_STAGE_A(PG8_SA(1, 1), a1, 1, false);
            PG8_WAIT_L(8); PG8_BAR; PG8_WAIT_L(0); PG8_MMA(0, 0, At, B0); PG8_BAR; PG8_SCHED;
            PG8_LDB(B1, 0, 1); PG8_STAGE(PG8_SB(0, 0), b2, voffB);
            PG8_BAR; PG8_WAIT_L(0); PG8_MMA(0, 1, At, B1); PG8_BAR;
            PG8_LDA(At, 0, 1); PG8_STAGE_A(PG8_SA(0, 0), a2, 0, last);
            PG8_BAR; PG8_WAIT_L(0); PG8_MMA(1, 0, At, B0); PG8_BAR; PG8_SCHED;
            PG8_STAGE(PG8_SB(0, 1), b2 + hstep, voffB);
            PG8_WAIT_V(6); PG8_BAR; PG8_MMA(1, 1, At, B1); PG8_BAR;
            PG8_LDB(B0, 1, 0); PG8_SCHED; PG8_LDA(At, 1, 0); PG8_STAGE_A(PG8_SA(0, 1), a2, 1, last);
            PG8_WAIT_L(8); PG8_BAR; PG8_WAIT_L(0); PG8_MMA(0, 0, At, B0); PG8_BAR; PG8_SCHED;
            PG8_LDB(B1, 1, 1); PG8_STAGE(PG8_SB(1, 0), b3, voffB);
            PG8_BAR; PG8_WAIT_L(0); PG8_MMA(0, 1, At, B1); PG8_BAR;
            PG8_LDA(At, 1, 1); PG8_STAGE_A(PG8_SA(1, 0), a3, 0, last);
            PG8_BAR; PG8_WAIT_L(0); PG8_MMA(1, 0, At, B0); PG8_BAR; PG8_SCHED;
            PG8_STAGE(PG8_SB(1, 1), b3 + hstep, voffB);
            PG8_WAIT_V(6); PG8_BAR; PG8_MMA(1, 1, At, B1); PG8_BAR;
            }
        }
        if constexpr (ALIGN_EPI) { if (wr == 0) PG8_BAR; }
        E(acc, cur, wr, wc, fr, fq); S.done(cur);
        if (!has_next) break;
        if (!(Epi::CHAIN && cur.sub == 0)) {
#pragma unroll
        for (int a = 0; a < 2; ++a)
#pragma unroll
            for (int b = 0; b < 2; ++b)
#pragma unroll
                for (int m = 0; m < 4; ++m)
#pragma unroll
                    for (int n = 0; n < 2; ++n) acc[a][b][m][n] = (f32x4){0.f, 0.f, 0.f, 0.f};
        }
        cur = nxt; cA = nA; cB = nB; ++ui;
        if constexpr (Sched::GATHER) {
#pragma unroll
            for (int h = 0; h < 2; ++h)
#pragma unroll
                for (int i = 0; i < 2; ++i) gc[h][i] = gn[h][i];
        }
        if constexpr (ALIGN_EPI) { if (wr == 1) PG8_BAR; }
    }
    PG8_WAIT_V(0);
    if constexpr (!ALIGN_EPI) { if (wr == 0) PG8_BAR; }
    PG8_BAR;
#undef PG8_SA
#undef PG8_SB
#undef PG8_STAGE
#undef PG8_STAGE_A
#undef PG8_LDA
#undef PG8_LDB
#undef PG8_MMA
#undef PG8_WAIT_V
#undef PG8_WAIT_L
#undef PG8_BAR
#undef PG8_SCHED
}
}

#define PG8_SP2 true
#define PG8_ALIGN true
#define AL_G1 true
#define AL_MG true
#define AL_OUT true
#define AL_GU true
#define AL_DN true

constexpr size_t MiB = 1u << 20;
constexpr size_t WS_CTL = 0, CTL_ZERO_BYTES = 256 * 1024;
constexpr size_t WS_WIN = 1 * MiB;
constexpr size_t WS_WR = 256 * 1024;
constexpr size_t WS_PA = 12 * MiB, WS_PB = 13 * MiB, WS_WOUT = 14 * MiB, WS_WGU = 16 * MiB, WS_WD = 48 * MiB;
constexpr size_t WS_XB2 = 64 * MiB;
constexpr size_t WS_XB = 64 * MiB;
constexpr size_t YB_OFF = 32 * MiB;
constexpr size_t WS_SMALL = 128 * MiB;
constexpr size_t WS_RS1 = WS_SMALL, WS_RS2 = WS_SMALL + 128 * 1024, WS_TREC = WS_SMALL + 256 * 1024, WS_TW = WS_SMALL + 512 * 1024, WS_TSLOT = WS_SMALL + 768 * 1024, WS_SW = WS_SMALL + 1024 * 1024, WS_SRS = WS_SMALL + 1024 * 1024 + 512 * 1024;
constexpr size_t WS_Q = 130 * MiB, WS_K = 162 * MiB, WS_V = 194 * MiB, WS_BQ = 226 * MiB, WS_BK = 242 * MiB, WS_BV = 258 * MiB, WS_BR = 290 * MiB, WS_LA = 322 * MiB, WS_R = 354 * MiB, WS_GB = 418 * MiB;
constexpr size_t WS_TMP = 130 * MiB, WS_MRG = 194 * MiB;
constexpr size_t WS_KH = WS_LA, WS_DEC = WS_LA + 16 * MiB;
constexpr size_t WS_TOKL = 130 * MiB, WS_TWL = 134 * MiB, WS_RSLL = 138 * MiB;
constexpr size_t WS_H = 274 * MiB, WS_Y = 310 * MiB;
constexpr size_t WS_END = 482 * MiB;
constexpr int CW_TMO = 0, CW_CODE = 1, CW_BAR = 4096, CW_GCNT = 8192;

constexpr int SCR_BYTES = 155648;
constexpr int LC_OFF = SCR_BYTES;
constexpr int LC_MISC = LC_OFF, LC_TBASE = LC_OFF + 128, LC_TILEE = LC_OFF + 512, LC_LCNT = LC_OFF + 1792, LC_LBASE = LC_OFF + 1920, LC_REC = LC_OFF + 2048, LC_RECW = LC_OFF + 3072, LC_RECRS = LC_OFF + 4096, LC_CNT = LC_OFF + 4608;
constexpr int LDS_BYTES = 163840;

#define RLX_AGENT __ATOMIC_RELAXED, __HIP_MEMORY_SCOPE_AGENT
#define LDS_WAIT() asm volatile("s_waitcnt lgkmcnt(0)" ::: "memory")
__device__ __forceinline__ unsigned f2bf(float f) { unsigned u = __builtin_bit_cast(unsigned, f); return (u + 0x7fffu + ((u >> 16) & 1u)) >> 16; }
__device__ __forceinline__ unsigned pk2(float lo, float hi) { return f2bf(lo) | (f2bf(hi) << 16); }
__device__ __forceinline__ float bflo(unsigned w) { return __uint_as_float(w << 16); }
__device__ __forceinline__ float bfhi(unsigned w) { return __uint_as_float(w & 0xffff0000u); }
__device__ __forceinline__ float bf2f(bf16 b) { return __uint_as_float(((unsigned)b) << 16); }
__device__ __forceinline__ float wave_sum(float v) {
#pragma unroll
    for (int o = 1; o < 64; o <<= 1) v += __shfl_xor(v, o);
    return v;
}
__device__ __forceinline__ float rdlane(float v, int i) { return __uint_as_float((unsigned)__builtin_amdgcn_readlane((int)__float_as_uint(v), i)); }
__device__ __forceinline__ float wave_max(float v) {
#pragma unroll
    for (int o = 1; o < 64; o <<= 1) v = fmaxf(v, __shfl_xor(v, o));
    return v;
}

#define XB_TMO      128
#define XB_XCNT(j)  (256  + 64 * (j))
#define XB_XSUB(j)  (1280 + 64 * (j))
#define XB_XGEN(j)  (2304 + 64 * (j))
#define XB_TOP      3328
#define XB_TOPGEN   3392
#define XCD_BAR_WORDS 3456
#define XB_SPIN_CAP (1u << 18)
__device__ __forceinline__ unsigned xb_ld(unsigned* p)              { return __hip_atomic_load(p, __ATOMIC_RELAXED, __HIP_MEMORY_SCOPE_AGENT); }
__device__ __forceinline__ unsigned xb_add(unsigned* p, unsigned v) { return __hip_atomic_fetch_add(p, v, __ATOMIC_RELAXED, __HIP_MEMORY_SCOPE_AGENT); }
__device__ __forceinline__ unsigned xb_xcc_id() { return (unsigned)__builtin_amdgcn_s_getreg((3 << 11) | 20) & 0xFu; }
#define XB_SPIN(cond, bar) do { unsigned _sp = 0; while (cond) { __builtin_amdgcn_s_sleep(1); \
    if ((++_sp & 255u) == 0u) { if (xb_ld(&(bar)[XB_TMO])) break; if (_sp > XB_SPIN_CAP) { atomicAdd(&(bar)[XB_TMO], 1u); break; } } } } while (0)
struct XcdBarrier { unsigned* bar; unsigned x; volatile LAS unsigned* st; };
__device__ __forceinline__ XcdBarrier xcd_barrier_post(unsigned* bar, volatile LAS unsigned* st) {
    XcdBarrier b; b.bar = bar; b.x = xb_xcc_id(); b.st = st;
    if (threadIdx.x == 0) (void)xb_add(&bar[XB_XCNT(b.x)], 1u);
    return b;
}
__device__ __forceinline__ void xcd_barrier_complete(unsigned* bar, unsigned x, unsigned& nloc, unsigned& nx) {
    const unsigned G = gridDim.x * gridDim.y * gridDim.z;
    unsigned sum, cnt, mine, sp = 0u;
    for (;;) {
        sum = 0u; cnt = 0u; mine = 0u;
#pragma unroll
        for (unsigned j = 0; j < 16; ++j) { const unsigned c = xb_ld(&bar[XB_XCNT(j)]); sum += c; cnt += (c > 0u) ? 1u : 0u; mine = (j == x) ? c : mine; }
        if (sum == G) break;
        __builtin_amdgcn_s_sleep(1);
        if ((++sp & 255u) == 0u) { if (xb_ld(&bar[XB_TMO])) break; if (sp > XB_SPIN_CAP) { atomicAdd(&bar[XB_TMO], 1u); break; } }
    }
    nloc = mine > 0u ? mine : 1u; nx = cnt > 0u ? cnt : 1u;
}
__device__ __forceinline__ void xcd_barrier(const XcdBarrier& b) {
    asm volatile("s_waitcnt vmcnt(0)" ::: "memory");
    __syncthreads();
    if (threadIdx.x == 0) {
        unsigned* bar = b.bar;
        __builtin_amdgcn_s_waitcnt(0);
        unsigned nloc = b.st[0], nx = b.st[1];
        if (nloc == 0u) { xcd_barrier_complete(bar, b.x, nloc, nx); b.st[0] = nloc; b.st[1] = nx; }
        const unsigned old = xb_add(&bar[XB_XSUB(b.x)], 1u);
        const unsigned gen = old / nloc;
        if (old + 1u == (gen + 1u) * nloc) {
            __builtin_amdgcn_fence(__ATOMIC_RELEASE, "agent");
            asm volatile("s_waitcnt vmcnt(0)" ::: "memory");
            const unsigned og = xb_add(&bar[XB_TOP], 1u);
            const unsigned tg = og / nx;
            if (og + 1u == (tg + 1u) * nx) xb_add(&bar[XB_TOPGEN], 1u);
            else XB_SPIN(xb_ld(&bar[XB_TOPGEN]) == tg, bar);
            __builtin_amdgcn_fence(__ATOMIC_ACQUIRE, "agent");
            xb_add(&bar[XB_XGEN(b.x)], 1u);
            asm volatile("s_waitcnt vmcnt(0)" ::: "memory");
        } else {
            XB_SPIN(xb_ld(&bar[XB_XGEN(b.x)]) == gen, bar);
            __builtin_amdgcn_fence(__ATOMIC_ACQUIRE, "agent");
            asm volatile("s_waitcnt vmcnt(0)" ::: "memory");
        }
    }
    __syncthreads();
}

struct Args { const float* in[20]; float* out; unsigned char* ws; int ph_lo, ph_hi; };
typedef const __attribute__((address_space(4))) Args* ArgsP;
struct Frame {
    LAS unsigned char* lds; unsigned* ctl; unsigned char* ws; unsigned char* yab;
    int tid, lane, wave, vcu, G;
};
__device__ __forceinline__ ArgsP get_args() { ArgsP p = (ArgsP)__builtin_amdgcn_kernarg_segment_ptr(); asm volatile("" : "+s"(p)); return p; }
__device__ __forceinline__ Frame make_frame(ArgsP ap, int wave0) {
    extern __shared__ __attribute__((aligned(16))) unsigned char lds_raw[];
    Frame F; F.lds = (LAS unsigned char*)lds_raw; F.ws = ap->ws; F.ctl = (unsigned*)(F.ws + WS_CTL); F.yab = (unsigned char*)ap->out;
    unsigned z = 0u; asm volatile("" : "+v"(z));
    int t = wave0 * 64 + (int)__builtin_amdgcn_mbcnt_hi(~0u, __builtin_amdgcn_mbcnt_lo(~0u, z)); asm volatile("" : "+v"(t));
    F.tid = t; F.lane = t & 63; F.wave = __builtin_amdgcn_readfirstlane(t >> 6);
    F.G = gridDim.x; { const int bx = blockIdx.x; F.vcu = (F.G % 8 == 0) ? (bx % 8) * (F.G / 8) + bx / 8 : bx; }
    return F;
}

using pg8::cvt_pk_bf16;
__device__ __forceinline__ u32x4 pack8(f32x4 a, f32x4 b) { u32x4 w; w.x = cvt_pk_bf16(a[0], a[1]); w.y = cvt_pk_bf16(a[2], a[3]); w.z = cvt_pk_bf16(b[0], b[1]); w.w = cvt_pk_bf16(b[2], b[3]); return w; }
__device__ __forceinline__ void unpack8(u32x4 w, f32x4& a, f32x4& b) { a = (f32x4){bflo(w.x), bfhi(w.x), bflo(w.y), bfhi(w.y)}; b = (f32x4){bflo(w.z), bfhi(w.z), bflo(w.w), bfhi(w.w)}; }
__device__ __forceinline__ float sigmoidf_(float z) { return __builtin_amdgcn_rcpf(1.0f + __builtin_amdgcn_exp2f(-LOG2E * z)); }

struct EpiIn {
    static constexpr bool PERM = true, CHAIN = false;
    const float* rowscale; unsigned char* wsb; bf16 *Q, *K, *QT, *KT, *KH, *R, *GB; float* DEC; const float *qg, *kg, *lbias;
    __device__ __forceinline__ void operator()(f32x4 (&acc)[2][2][4][2], const pg8::Unit& u, int wr, int wc, int fr, int fq) const {
        const int pn = u.pn, row0 = u.pm * 256 + wr * 64 + fr;
        if (pn < 4) {
            const bool isq = pn < 2; const int hh = 4 * (pn & 1) + wc;
            const float* g = (isq ? qg : kg) + hh * 64 + 8 * fq;
            f32x4 g0[2], g1[2];
#pragma unroll
            for (int bj = 0; bj < 2; ++bj) { g0[bj] = *(const f32x4*)(g + 32 * bj); g1[bj] = *(const f32x4*)(g + 32 * bj + 4); }
            const float sc = isq ? 0.125f * LOG2E : 1.0f; bf16* O = isq ? Q : K;
#pragma unroll
            for (int ai = 0; ai < 2; ++ai)
#pragma unroll
                for (int m = 0; m < 4; ++m) {
                    const int row = row0 + ai * 128 + m * 16; const float rs = rowscale[row];
                    f32x4 v[2][2]; float ss = 0.f;
#pragma unroll
                    for (int bj = 0; bj < 2; ++bj)
#pragma unroll
                        for (int n = 0; n < 2; ++n) { v[bj][n] = acc[ai][bj][m][n] * rs; const f32x4 q = v[bj][n] * v[bj][n]; ss += (q[0] + q[1]) + (q[2] + q[3]); }
                    ss += __shfl_xor(ss, 16); ss += __shfl_xor(ss, 32);
                    const float rn = rsqrtf(ss * (1.0f / 64.0f) + EPS) * sc;
#pragma unroll
                    for (int bj = 0; bj < 2; ++bj) *(u32x4*)(O + (size_t)row * 512 + hh * 64 + 32 * bj + 8 * fq) = pack8(v[bj][0] * g0[bj] * rn, v[bj][1] * g1[bj] * rn);
                }
        } else if (pn < 6 || pn >= 10) {
          if (pn < 14) {
            const bool act = pn >= 12; const int cb = 256 * (pn & 1);
            const size_t ooff = pn < 6 ? WS_V : pn < 12 ? WS_BV : WS_BR; bf16* O = (bf16*)(wsb + ooff);
#pragma unroll
            for (int ai = 0; ai < 2; ++ai)
#pragma unroll
                for (int m = 0; m < 4; ++m) {
                    const int row = row0 + ai * 128 + m * 16; const float rs = rowscale[row];
#pragma unroll
                    for (int bj = 0; bj < 2; ++bj) {
                        f32x4 a = acc[ai][bj][m][0] * rs, b = acc[ai][bj][m][1] * rs;
                        if (act) {
#pragma unroll
                            for (int e = 0; e < 4; ++e) { a[e] = a[e] * sigmoidf_(a[e]); b[e] = b[e] * sigmoidf_(b[e]); }
                        }
                        *(u32x4*)(O + (size_t)row * 512 + cb + 64 * wc + 32 * bj + 8 * fq) = pack8(a, b);
                    }
                }
          } else {
            const int cb = 128 * (pn - 14) + 32 * wc + 8 * fq;
#pragma unroll
            for (int ai = 0; ai < 2; ++ai)
#pragma unroll
                for (int m = 0; m < 4; ++m) {
                    const int row = row0 + ai * 128 + m * 16; const float rs = rowscale[row];
                    f32x4 ra, rb_, ga, gb_;
#pragma unroll
                    for (int e = 0; e < 4; ++e) {
                        float za = fminf(fmaxf(acc[ai][0][m][0][e] * rs, -30.f), 30.f), zb = fminf(fmaxf(acc[ai][1][m][0][e] * rs, -30.f), 30.f);
                        float ea = __builtin_amdgcn_exp2f(-LOG2E * za), eb = __builtin_amdgcn_exp2f(-LOG2E * zb); ga[e] = __builtin_amdgcn_rcpf(1.0f + eb); ra[e] = (1.0f + eb) * __builtin_amdgcn_rcpf(1.0f + ea);
                        za = fminf(fmaxf(acc[ai][0][m][1][e] * rs, -30.f), 30.f); zb = fminf(fmaxf(acc[ai][1][m][1][e] * rs, -30.f), 30.f);
                        ea = __builtin_amdgcn_exp2f(-LOG2E * za); eb = __builtin_amdgcn_exp2f(-LOG2E * zb); gb_[e] = __builtin_amdgcn_rcpf(1.0f + eb); rb_[e] = (1.0f + eb) * __builtin_amdgcn_rcpf(1.0f + ea);
                    }
                    *(u32x4*)(R + (size_t)row * 1024 + cb) = pack8(ra, rb_);
                    *(u32x4*)(GB + (size_t)row * 1024 + cb) = pack8(ga, gb_);
                }
          }
        } else {
            const int hh = pn - 6, ch0 = hh * 64 + 32 * (wc & 1) + 8 * fq; const bool isq = wc < 2;
            const f32x4 lb0 = *(const f32x4*)(lbias + ch0), lb1 = *(const f32x4*)(lbias + ch0 + 4);
            const int l15 = ((fq << 4) | 15);
#pragma unroll
            for (int ai = 0; ai < 2; ++ai)
#pragma unroll
                for (int n = 0; n < 2; ++n) {
                    f32x4 v[4]; float rsm[4];
#pragma unroll
                    for (int m = 0; m < 4; ++m) { rsm[m] = rowscale[row0 + ai * 128 + m * 16];
                        f32x4 z = acc[ai][1][m][n] * rsm[m] + (n ? lb1 : lb0);
#pragma unroll
                        for (int e = 0; e < 4; ++e) z[e] = (fminf(z[e], 0.f) - __logf(1.0f + __expf(-fabsf(z[e])))) * 0.0625f;
                        v[m] = z; }
                    f32x4 bl;
#pragma unroll
                    for (int e = 0; e < 4; ++e) {
                        float x[4];
#pragma unroll
                        for (int m = 0; m < 4; ++m) { float t = v[m][e];
                            t += __uint_as_float(__builtin_amdgcn_update_dpp(0, (int)__float_as_uint(t), 0x111, 0xf, 0xf, true));
                            t += __uint_as_float(__builtin_amdgcn_update_dpp(0, (int)__float_as_uint(t), 0x112, 0xf, 0xf, true));
                            t += __uint_as_float(__builtin_amdgcn_update_dpp(0, (int)__float_as_uint(t), 0x114, 0xf, 0xf, true));
                            t += __uint_as_float(__builtin_amdgcn_update_dpp(0, (int)__float_as_uint(t), 0x118, 0xf, 0xf, true));
                            x[m] = t; }
                        x[1] += __shfl(x[0], l15); x[2] += __shfl(x[1], l15); x[3] += __shfl(x[2], l15);
                        bl[e] = __shfl(x[3], l15);
#pragma unroll
                        for (int m = 0; m < 4; ++m) v[m][e] = x[m];
                    }
#pragma unroll
                    for (int m = 0; m < 4; ++m) { const size_t off = (size_t)(row0 + ai * 128 + m * 16) * 256 + ch0 + 4 * n; const f32x4 val = acc[ai][0][m][n] * rsm[m];
                        if (isq) { f32x4 o;
#pragma unroll
                            for (int e = 0; e < 4; ++e) o[e] = val[e] * 0.125f * __expf(v[m][e]);
                            *(u32x2*)(QT + off) = (u32x2){cvt_pk_bf16(o[0], o[1]), cvt_pk_bf16(o[2], o[3])}; }
                        else { f32x4 o, p;
#pragma unroll
                            for (int e = 0; e < 4; ++e) { o[e] = val[e] * __expf(-v[m][e]); p[e] = val[e] * __expf(bl[e] - v[m][e]); }
                            *(u32x2*)(KT + off) = (u32x2){cvt_pk_bf16(o[0], o[1]), cvt_pk_bf16(o[2], o[3])}; *(u32x2*)(KH + off) = (u32x2){cvt_pk_bf16(p[0], p[1]), cvt_pk_bf16(p[2], p[3])}; } }
                    if (!isq && fr == 0) { f32x4 d;
#pragma unroll
                        for (int e = 0; e < 4; ++e) d[e] = __expf(bl[e]);
                        *(f32x4*)(DEC + (size_t)((row0 - fr + ai * 128) >> 6) * 256 + ch0 + 4 * n) = d; }
                }
        }
    }
};
struct EpiMerge {
    static constexpr bool PERM = true, CHAIN = true;
    const bf16* R; const bf16* GB; bf16* MRG;
    __device__ __forceinline__ void operator()(f32x4 (&acc)[2][2][4][2], const pg8::Unit& u, int wr, int wc, int fr, int fq) const {
        const int row0 = u.pm * 256 + wr * 64 + fr, col0 = u.pn * 256 + wc * 32 + 8 * fq;
        if (u.sub == 0) {
#pragma unroll
            for (int ai = 0; ai < 2; ++ai)
#pragma unroll
                for (int m = 0; m < 4; ++m)
#pragma unroll
                    for (int bj = 0; bj < 2; ++bj) {
                        const size_t off = (size_t)(row0 + ai * 128 + m * 16) * 1024 + col0 + bj * 128;
                        f32x4 ra, rb_; unpack8(*(const u32x4*)(R + off), ra, rb_);
                        acc[ai][bj][m][0] *= ra; acc[ai][bj][m][1] *= rb_;
                    }
        } else {
#pragma unroll
            for (int ai = 0; ai < 2; ++ai)
#pragma unroll
                for (int m = 0; m < 4; ++m)
#pragma unroll
                    for (int bj = 0; bj < 2; ++bj) {
                        const size_t off = (size_t)(row0 + ai * 128 + m * 16) * 1024 + col0 + bj * 128;
                        f32x4 ga, gb_; unpack8(*(const u32x4*)(GB + off), ga, gb_);
                        *(u32x4*)(MRG + off) = pack8(acc[ai][bj][m][0] * ga, acc[ai][bj][m][1] * gb_);
                    }
        }
    }
};
struct EpiOut {
    static constexpr bool PERM = true, CHAIN = false;
    bf16* xb;
    __device__ __forceinline__ void operator()(f32x4 (&acc)[2][2][4][2], const pg8::Unit& u, int wr, int wc, int fr, int fq) const {
        const int row0 = u.pm * 256 + wr * 64 + fr, col0 = u.pn * 256 + wc * 32 + 8 * fq;
#pragma unroll
        for (int ai = 0; ai < 2; ++ai)
#pragma unroll
            for (int m = 0; m < 4; ++m)
#pragma unroll
                for (int bj = 0; bj < 2; ++bj) {
                    const size_t off = (size_t)(row0 + ai * 128 + m * 16) * 1024 + col0 + bj * 128;
                    f32x4 xa, xc; unpack8(*(const u32x4*)(xb + off), xa, xc);
                    *(u32x4*)(xb + off) = pack8(xa + acc[ai][bj][m][0], xc + acc[ai][bj][m][1]);
                }
    }
};
struct EpiGU {
    static constexpr bool PERM = true, CHAIN = false;
    const float* srs; bf16* H;
    __device__ __forceinline__ void operator()(f32x4 (&acc)[2][2][4][2], const pg8::Unit& u, int wr, int wc, int fr, int fq) const {
        const int row0 = u.pm * 256 + wr * 64 + fr, col0 = u.pn * 128 + wc * 32 + 8 * fq;
#pragma unroll
        for (int ai = 0; ai < 2; ++ai)
#pragma unroll
            for (int m = 0; m < 4; ++m) {
                const int row = row0 + ai * 128 + m * 16; const float rs = srs[u.aux + (row - u.pm * 256)];
                f32x4 a, b;
#pragma unroll
                for (int e = 0; e < 4; ++e) { const float g0 = acc[ai][0][m][0][e] * rs, g1 = acc[ai][0][m][1][e] * rs; a[e] = g0 * sigmoidf_(g0) * (acc[ai][1][m][0][e] * rs); b[e] = g1 * sigmoidf_(g1) * (acc[ai][1][m][1][e] * rs); }
                *(u32x4*)(H + (size_t)row * 256 + col0) = pack8(a, b);
            }
    }
};
struct EpiDown {
    static constexpr bool PERM = true, CHAIN = false;
    const float* sw; bf16* Y;
    __device__ __forceinline__ void operator()(f32x4 (&acc)[2][2][4][2], const pg8::Unit& u, int wr, int wc, int fr, int fq) const {
        const int row0 = u.pm * 256 + wr * 64 + fr, col0 = u.pn * 256 + wc * 32 + 8 * fq;
#pragma unroll
        for (int ai = 0; ai < 2; ++ai)
#pragma unroll
            for (int m = 0; m < 4; ++m) {
                const int row = row0 + ai * 128 + m * 16; const float w = sw[u.aux + (row - u.pm * 256)];
#pragma unroll
                for (int bj = 0; bj < 2; ++bj) *(u32x4*)(Y + (size_t)row * 1024 + col0 + bj * 128) = pack8(acc[ai][bj][m][0] * w, acc[ai][bj][m][1] * w);
            }
    }
};

__device__ __forceinline__ void cvt_item(const float* src, int ldn, const float* kscale, bf16* dst, int Kd, int drow0, int k0, LAS float* scr, int lane) {
    const int kl = lane >> 3, n4 = (lane & 7) * 4;
    f32x4 v[8];
#pragma unroll
    for (int i = 0; i < 8; ++i) v[i] = *(const f32x4*)(src + (size_t)(k0 + kl + 8 * i) * ldn + n4);
    if (kscale) {
#pragma unroll
        for (int i = 0; i < 8; ++i) v[i] = v[i] * kscale[k0 + kl + 8 * i];
    }
#pragma unroll
    for (int i = 0; i < 8; ++i) { LAS float* d = scr + (kl + 8 * i) * 33 + n4; d[0] = v[i][0]; d[1] = v[i][1]; d[2] = v[i][2]; d[3] = v[i][3]; }
    LDS_WAIT(); asm volatile("" ::: "memory");
    const int c = lane & 7;
#pragma unroll
    for (int j = 0; j < 4; ++j) { const int n = (lane >> 3) + 8 * j; const LAS float* s = scr + (8 * c) * 33 + n;
        u32x4 o; o.x = pk2(s[0 * 33], s[1 * 33]); o.y = pk2(s[2 * 33], s[3 * 33]); o.z = pk2(s[4 * 33], s[5 * 33]); o.w = pk2(s[6 * 33], s[7 * 33]);
        *(u32x4*)(dst + (size_t)(drow0 + n) * Kd + k0 + 8 * c) = o; }
    LDS_WAIT(); asm volatile("" ::: "memory");
}
__device__ __forceinline__ void cvt_item_lr(const float* win, const float* gup, int c0, const float* kscale, bf16* dst, int drow0, int k0, LAS float* scr, int lane) {
    float gu[16];
#pragma unroll
    for (int r = 0; r < 16; ++r) gu[r] = gup[r * 256 + c0 + (lane & 31)];
#pragma unroll 4
    for (int i = 0; i < 32; ++i) { const int kk = 2 * i + (lane >> 5); const float* wr_ = win + (size_t)(k0 + kk) * IN_COLS + 3072; float v = 0.f;
#pragma unroll
        for (int r = 0; r < 16; ++r) v += wr_[r] * gu[r];
        scr[kk * 33 + (lane & 31)] = v * kscale[k0 + kk]; }
    LDS_WAIT(); asm volatile("" ::: "memory");
    const int c = lane & 7;
#pragma unroll
    for (int j = 0; j < 4; ++j) { const int n = (lane >> 3) + 8 * j; const LAS float* s = scr + (8 * c) * 33 + n;
        u32x4 o; o.x = pk2(s[0 * 33], s[1 * 33]); o.y = pk2(s[2 * 33], s[3 * 33]); o.z = pk2(s[4 * 33], s[5 * 33]); o.w = pk2(s[6 * 33], s[7 * 33]);
        *(u32x4*)(dst + (size_t)(drow0 + n) * D + k0 + 8 * c) = o; }
    LDS_WAIT(); asm volatile("" ::: "memory");
}
__device__ __forceinline__ void phase_weights(const Frame& F, ArgsP a, int l) {
    LAS float* scr = (LAS float*)(F.lds + F.wave * 16384);
    const int gw = F.vcu * 8 + F.wave, NGW = F.G * 8, lane = F.lane;
    const float* win = a->in[2] + (size_t)l * D * IN_COLS; const float* gmix = a->in[1] + l * D; const float* gup = a->in[6] + l * 16 * 256;
    bf16* WIN = (bf16*)(F.ws + WS_WIN); bf16* PA = (bf16*)(F.ws + WS_PA); bf16* PB = (bf16*)(F.ws + WS_PB); bf16* WOUT = (bf16*)(F.ws + WS_WOUT); bf16* WGU = (bf16*)(F.ws + WS_WGU); bf16* WD = (bf16*)(F.ws + WS_WD);
    constexpr int I0 = (NIN / 32) * 16, I1 = 32 * 8, I2 = 32 * 8, I3 = 32 * 16, I4 = NE * 16 * 16, I5 = NE * 32 * 4;
    for (int it = gw; it < I0 + I1 + I2 + I3 + I4 + I5; it += NGW) {
        int r = it;
        if (r < I0) { const int nb = r >> 4, kb = r & 15, P = nb * 32, pn = P >> 8, p = P & 255;
            const int bj_ = p >> 7, wc_ = (p >> 5) & 3, Lp = 64 * wc_ + 32 * bj_;
            if (pn >= 6 && pn < 10) { const int hh = pn - 6;
                if (bj_ == 1) cvt_item_lr(win, gup, hh * 64 + 32 * (wc_ & 1), gmix, WIN, P, kb * 64, scr, lane);
                else cvt_item(win + (wc_ < 2 ? 1536 : 1792) + hh * 64 + 32 * (wc_ & 1), IN_COLS, gmix, WIN, D, P, kb * 64, scr, lane); }
            else { const int src = pn < 6 ? 256 * pn + Lp : pn < 12 ? 2048 + 256 * (pn - 10) + Lp : pn < 14 ? 2560 + 256 * (pn - 12) + Lp : 3088 + 1024 * bj_ + 128 * (pn - 14) + (p & 127);
                   cvt_item(win + src, IN_COLS, gmix, WIN, D, P, kb * 64, scr, lane); }
            continue; } r -= I0;
        if (r < I1) { const int nb = r >> 3, kb = r & 7; cvt_item(a->in[9] + (size_t)l * 512 * D + nb * 32, D, nullptr, PA, 512, nb * 32, kb * 64, scr, lane); continue; } r -= I1;
        if (r < I2) { const int nb = r >> 3, kb = r & 7; cvt_item(a->in[10] + (size_t)l * 512 * D + nb * 32, D, nullptr, PB, 512, nb * 32, kb * 64, scr, lane); continue; } r -= I2;
        if (r < I3) { const int nb = r >> 4, kb = r & 15; cvt_item(a->in[11] + (size_t)l * D * D + nb * 32, D, nullptr, WOUT, D, nb * 32, kb * 64, scr, lane); continue; } r -= I3;
        if (r < I4) { const int e = r >> 8, nb = (r >> 4) & 15, kb = r & 15, p0 = nb * 32; const int j0 = 128 * (p0 >> 8) + (p0 & 127);
            const float* src = ((p0 >> 7) & 1 ? a->in[18] : a->in[17]) + ((size_t)(l * NE + e) * D) * DE + j0;
            cvt_item(src, DE, a->in[12] + l * D, WGU + (size_t)e * 512 * D, D, p0, kb * 64, scr, lane); continue; } r -= I4;
        { const int e = r >> 7, nb = (r >> 2) & 31, kb = r & 3;
            cvt_item(a->in[19] + ((size_t)(l * NE + e) * DE) * D + nb * 32, D, nullptr, WD + (size_t)e * D * DE, DE, nb * 32, kb * 64, scr, lane); }
    }
    bf16* WRh = (bf16*)(F.ws + WS_WR); const float* gf = a->in[12] + l * D; const float* wg = a->in[13] + (size_t)l * D * 4; const float* wrt = a->in[15] + (size_t)l * D * 32;
    for (int i = (F.vcu * 512 + F.tid); i < 40 * D; i += F.G * 512) { const int n = i >> 10, k = i & 1023; const float v = n < 36 ? gf[k] * (n < 4 ? wg[k * 4 + n] : wrt[k * 32 + n - 4]) : 0.f; WRh[i] = (bf16)f2bf(v); }
}
__device__ __forceinline__ void phase_x_to_xb(const Frame& F, const float* x) {
    bf16* XB = (bf16*)(F.ws + WS_XB); float* RS = (float*)(F.ws + WS_RS1);
    const int gw = F.vcu * 8 + F.wave, NGW = F.G * 8;
    for (int m = gw; m < T; m += NGW) {
        const f32x4* xr = (const f32x4*)(x + (size_t)m * D) + F.lane; f32x4 v[4]; float s = 0.f;
#pragma unroll
        for (int j = 0; j < 4; ++j) { v[j] = xr[64 * j]; s += (v[j][0] * v[j][0] + v[j][1] * v[j][1]) + (v[j][2] * v[j][2] + v[j][3] * v[j][3]); }
        s = wave_sum(s);
        u32x2* o = (u32x2*)(XB + (size_t)m * D) + F.lane;
#pragma unroll
        for (int j = 0; j < 4; ++j) { u32x2 w; w.x = pk2(v[j][0], v[j][1]); w.y = pk2(v[j][2], v[j][3]); o[64 * j] = w; }
        if (F.lane == 0) RS[m] = rsqrtf(s * (1.0f / D) + EPS);
    }
}

typedef float f32x16 __attribute__((ext_vector_type(16)));
typedef short s16x4 __attribute__((ext_vector_type(4)));
#define MFMA32(a, b, c) __builtin_amdgcn_mfma_f32_32x32x16_bf16((a), (b), (c), 0, 0, 0)
__device__ __forceinline__ unsigned cvtpk(float lo, float hi) { typedef float f2_ __attribute__((ext_vector_type(2))); typedef __bf16 b2_ __attribute__((ext_vector_type(2))); f2_ v = {lo, hi}; b2_ b = __builtin_convertvector(v, b2_); return __builtin_bit_cast(unsigned, b); }
__device__ __forceinline__ u32x4 pack8c(f32x4 a, f32x4 b) { u32x4 w; w.x = cvtpk(a[0], a[1]); w.y = cvtpk(a[2], a[3]); w.z = cvtpk(b[0], b[1]); w.w = cvtpk(b[2], b[3]); return w; }
__device__ __forceinline__ s16x4 tr_read(const LAS unsigned char* p) { return __builtin_amdgcn_ds_read_tr16_b64_v4i16((LAS s16x4*)p); }
__device__ __forceinline__ bf16x8 pack_step(const f32x16& x, int s) {
    u32x4 p; p.x = cvtpk(x[8 * s], x[8 * s + 1]); p.y = cvtpk(x[8 * s + 2], x[8 * s + 3]); p.z = cvtpk(x[8 * s + 4], x[8 * s + 5]); p.w = cvtpk(x[8 * s + 6], x[8 * s + 7]);
    return __builtin_bit_cast(bf16x8, p);
}
#define ATT_BARRIER() do { asm volatile("s_waitcnt lgkmcnt(0)" ::: "memory"); __builtin_amdgcn_s_barrier(); asm volatile("" ::: "memory"); } while (0)
constexpr int ATT_K = 0, ATT_V = 16384, ATT_TBL = 32768, ATT_BT = 34816;
__device__ __forceinline__ void attn_setup(const Frame& F, ArgsP a, int l, int h) {
    const int lane = F.lane; LAS float* tbl = (LAS float*)(F.lds + ATT_TBL); const float* rb = a->in[5];
    const float mq = wave_max(fabsf(a->in[3][(l * 8 + h) * 64 + lane])), mk = wave_max(fabsf(a->in[4][(l * 8 + h) * 64 + lane]));
    float mb = 0.f; for (int i = lane; i < 257; i += 64) mb = fmaxf(mb, fabsf(rb[i * 8 + h])); mb = wave_max(mb);
    const float M2 = LOG2E * (8.0f * mq * mk + mb);
    __syncthreads();
    for (int i = F.tid; i < 257; i += 512) tbl[i] = rb[i * 8 + h] * LOG2E - M2;
    __syncthreads();
    for (int i = F.tid; i < 2 * 3 * 2 * 4 * 64; i += 512) {
        const int ln = i & 63, g = (i >> 6) & 3, kh = (i >> 8) & 1, jq = (i >> 9) % 3, qh = i / 1536;
        const int qi = 32 * qh + (ln & 31), ki0 = 32 * kh + 8 * g + 4 * (ln >> 5); f32x4 v;
#pragma unroll
        for (int e = 0; e < 4; ++e) { int d = 64 * (2 - jq) + qi - (ki0 + e); d = (d > 128 ? 128 : d) + 128; v[e] = tbl[d]; }
        *(LAS f32x4*)(F.lds + ATT_BT + i * 16) = v;
    }
    __syncthreads();
}
__device__ __forceinline__ void attn_unit(const Frame& F, int b, int h, int cq) {
    int lane = F.lane; asm volatile("" : "+v"(lane));
    const int w = F.wave, r = lane & 31, hl = lane >> 5;
    const int ci = (w < 4) ? (w >> 1) : (3 - ((w - 4) >> 1));
    const int qh = w & 1;
    const int c0 = 4 * cq, t0 = b * SEQ + c0 * 64;
    const bf16* Qb = (const bf16*)(F.ws + WS_Q); const bf16* Kb = (const bf16*)(F.ws + WS_K); const bf16* Vb = (const bf16*)(F.ws + WS_V); bf16* YA = (bf16*)(F.yab);
    LAS unsigned char* Ks = F.lds + ATT_K; LAS unsigned char* Vs = F.lds + ATT_V; const LAS float* tbl = (const LAS float*)(F.lds + ATT_TBL);
    const int qrow = t0 + ci * 64 + qh * 32 + r;
    bf16x8 qf[4];
#pragma unroll
    for (int s = 0; s < 4; ++s) qf[s] = *(const bf16x8*)(Qb + (size_t)qrow * 512 + h * 64 + 16 * s + 8 * hl);
    const int jmin = (8 - c0) > 0 ? (8 - c0) : 0;
    const int key = F.tid >> 3, ch = F.tid & 7;
    const long g0 = (long)(t0 - 512 + key) * 512 + h * 64 + ch * 8;
    const int kst = key * 128 + ((ch ^ ((key >> 1) & 7)) << 4);
    const int vst = ((key >> 3) * 2 + (ch >> 2)) * 512 + (key & 7) * 64 + (ch & 3) * 16;
    u32x4 kA = *(const u32x4*)(Kb + g0 + (long)jmin * 64 * 512), vA = *(const u32x4*)(Vb + g0 + (long)jmin * 64 * 512);
    u32x4 kB = *(const u32x4*)(Kb + g0 + (long)(jmin + 1) * 64 * 512), vB = *(const u32x4*)(Vb + g0 + (long)(jmin + 1) * 64 * 512);
    __syncthreads();
    *(LAS u32x4*)(Ks + kst) = kA; *(LAS u32x4*)(Vs + vst) = vA;
    ATT_BARRIER();
    f32x16 bc; { const float cb = tbl[256];
#pragma unroll
      for (int i = 0; i < 16; ++i) bc[i] = cb; }
    bf16x8 ones; { const u32x4 o1 = (u32x4){0x3f803f80u, 0x3f803f80u, 0x3f803f80u, 0x3f803f80u}; ones = __builtin_bit_cast(bf16x8, o1); }
    const LAS unsigned char* btb = F.lds + ATT_BT + qh * 24576 + lane * 16;
    const int kro = r * 128, ksw = (r >> 1) & 7;
    const int g16 = lane >> 4, i16 = lane & 15;
    const int vro = (4 * (g16 >> 1) + (i16 >> 2)) * 64 + (16 * (g16 & 1) + 4 * (i16 & 3)) * 2;
    f32x16 o[2], ol;
#pragma unroll
    for (int i = 0; i < 16; ++i) { o[0][i] = 0.f; o[1][i] = 0.f; ol[i] = 0.f; }
    auto tile = [&](int j, int cur) {
        const LAS unsigned char* Kt = Ks + cur * 8192; const LAS unsigned char* Vt = Vs + cur * 8192;
        const int jp = j - ci;
        bf16x8 kf[2][4];
#pragma unroll
        for (int kh = 0; kh < 2; ++kh)
#pragma unroll
            for (int s = 0; s < 4; ++s) kf[kh][s] = *(const LAS bf16x8*)(Kt + kh * 4096 + kro + (((2 * s + hl) ^ ksw) << 4));
        f32x16 pr[2];
        if (jp <= 5) { pr[0] = bc; pr[1] = bc; }
        else {
#pragma unroll
            for (int kh = 0; kh < 2; ++kh) { const LAS unsigned char* bp = btb + (jp - 6) * 8192 + kh * 4096;
#pragma unroll
                for (int g = 0; g < 4; ++g) { const f32x4 v = *(const LAS f32x4*)(bp + g * 1024); pr[kh][4 * g] = v[0]; pr[kh][4 * g + 1] = v[1]; pr[kh][4 * g + 2] = v[2]; pr[kh][4 * g + 3] = v[3]; } } }
        asm volatile("" : "+v"(kf[0][0]), "+v"(kf[0][1]), "+v"(kf[0][2]), "+v"(kf[0][3]), "+v"(kf[1][0]), "+v"(kf[1][1]), "+v"(kf[1][2]), "+v"(kf[1][3]));
#pragma unroll
        for (int s = 0; s < 4; ++s) { pr[0] = MFMA32(kf[0][s], qf[s], pr[0]); pr[1] = MFMA32(kf[1][s], qf[s], pr[1]); }
        s16x4 vl[4][2], vh[4][2];
#pragma unroll
        for (int s16 = 0; s16 < 4; ++s16)
#pragma unroll
            for (int dh = 0; dh < 2; ++dh) { vl[s16][dh] = tr_read(Vt + vro + dh * 512 + (2 * s16) * 1024); vh[s16][dh] = tr_read(Vt + vro + dh * 512 + (2 * s16 + 1) * 1024); }
#pragma unroll
        for (int kh = 0; kh < 2; ++kh)
#pragma unroll
            for (int i = 0; i < 16; ++i) pr[kh][i] = __builtin_amdgcn_exp2f(pr[kh][i]);
        asm volatile("" : "+v"(vl[0][0]), "+v"(vl[0][1]), "+v"(vl[1][0]), "+v"(vl[1][1]), "+v"(vl[2][0]), "+v"(vl[2][1]), "+v"(vl[3][0]), "+v"(vl[3][1]),
                          "+v"(vh[0][0]), "+v"(vh[0][1]), "+v"(vh[1][0]), "+v"(vh[1][1]), "+v"(vh[2][0]), "+v"(vh[2][1]), "+v"(vh[3][0]), "+v"(vh[3][1]));
#pragma unroll
        for (int s16 = 0; s16 < 4; ++s16) {
            const bf16x8 pb = pack_step(pr[s16 >> 1], s16 & 1);
            ol = MFMA32(ones, pb, ol);
#pragma unroll
            for (int dh = 0; dh < 2; ++dh) o[dh] = MFMA32(__builtin_shufflevector(vl[s16][dh], vh[s16][dh], 0, 1, 2, 3, 4, 5, 6, 7), pb, o[dh]);
        }
    };
    for (int j = jmin; j < 12; j += 2) {
        if (j + 2 < 12) { kA = *(const u32x4*)(Kb + g0 + (long)(j + 2) * 64 * 512); vA = *(const u32x4*)(Vb + g0 + (long)(j + 2) * 64 * 512); }
        if (j >= ci && j <= ci + 8) tile(j, 0);
        *(LAS u32x4*)(Ks + 8192 + kst) = kB; *(LAS u32x4*)(Vs + 8192 + vst) = vB;
        ATT_BARRIER();
        if (j + 3 < 12) { kB = *(const u32x4*)(Kb + g0 + (long)(j + 3) * 64 * 512); vB = *(const u32x4*)(Vb + g0 + (long)(j + 3) * 64 * 512); }
        if (j + 1 >= ci && j + 1 <= ci + 8) tile(j + 1, 1);
        if (j + 2 < 12) { *(LAS u32x4*)(Ks + kst) = kA; *(LAS u32x4*)(Vs + vst) = vA; }
        ATT_BARRIER();
    }
    const float inv = 1.0f / ol[0];
    bf16* yo = YA + (size_t)qrow * 512 + h * 64 + 4 * hl;
#pragma unroll
    for (int dh = 0; dh < 2; ++dh)
#pragma unroll
        for (int g = 0; g < 4; ++g) { u32x2 wv; wv.x = cvtpk(o[dh][4 * g] * inv, o[dh][4 * g + 1] * inv); wv.y = cvtpk(o[dh][4 * g + 2] * inv, o[dh][4 * g + 3] * inv); *(u32x2*)(yo + 32 * dh + 8 * g) = wv; }
}
#ifndef ATT_PER_GLA
#define ATT_PER_GLA 0
#endif
__device__ __forceinline__ void phase_attn(const Frame& F, ArgsP a, int l) {
    const int bx = blockIdx.x;
    if (F.G == 256) {
        if ((bx & 3) == 0) return;
        const int xl = bx & 7, a_ = (xl - 1 - (xl > 4 ? 1 : 0)) * 32 + (bx >> 3), h = (a_ >> 3) & 7;
        attn_setup(F, a, l, h);
        for (int u = a_; u < 1024; u += 192) attn_unit(F, u >> 6, h, u & 7);
    } else {
        for (int h = 0; h < 8; ++h) { attn_setup(F, a, l, h); for (int v = bx; v < 128; v += F.G) attn_unit(F, v >> 3, h, v & 7); }
    }
}

constexpr int GL_QT = 0, GL_KT = 26112, GL_KH = 43520, GL_AT = 68096, GL_V = 84480, GL_D = 117248, GL_SS = 117760, GL_GN = 119808, GL_YL = 120320, GL_END = GL_YL + 2 * 64 * 264;
static_assert(GL_END <= SCR_BYTES, "GLA LDS map");
#define GL_BARRIER() do { asm volatile("s_waitcnt lgkmcnt(0)" ::: "memory"); __builtin_amdgcn_s_barrier(); asm volatile("" ::: "memory"); } while (0)
#define GL_AMP(k, t0) do { if (PROBE_PHASE == (k)) { const unsigned long long t1_ = __builtin_amdgcn_s_memrealtime(); const unsigned long long dt_ = t1_ - (t0); while (__builtin_amdgcn_s_memrealtime() - t1_ < dt_) __builtin_amdgcn_s_sleep(2); } } while (0)
__device__ __forceinline__ void gla_unit(const Frame& F, ArgsP a, int l, int u) {
    int lane = F.lane, tid = F.tid; asm volatile("" : "+v"(lane), "+v"(tid));
    const int w = __builtin_amdgcn_readfirstlane(F.wave), h = u & 3, b = u >> 2;
    const bf16* BQ = (const bf16*)(F.ws + WS_BQ); const bf16* BK = (const bf16*)(F.ws + WS_BK); const bf16* BV = (const bf16*)(F.ws + WS_BV); const bf16* BR = (const bf16*)(F.ws + WS_BR);
    const bf16* KHg = (const bf16*)(F.ws + WS_KH); const float* DEC = (const float*)(F.ws + WS_DEC); bf16* YB = (bf16*)(F.yab + YB_OFF);
    LAS unsigned char* L = F.lds;
    __syncthreads();
    if (tid < 128) *(LAS float*)(L + GL_GN + 4 * tid) = a->in[8][l * 512 + h * 128 + tid];
    if (w >= 4) {
        const int te = tid - 256, r = lane & 31, hl = lane >> 5;
        u32x4 eraw[2][3][2], vraw[2][4], rraw[2][4]; float draw[2] = {0.f, 0.f};
        const unsigned voffE = (unsigned)(((te >> 3) * 256 + (te & 7) * 8) * 2), voffV = (unsigned)(((te >> 4) * 512 + (te & 15) * 8) * 2);
#define GL_LOADE(c, S_) do { const size_t tb_ = (size_t)b * SEQ + (size_t)(c) * 64; _Pragma("unroll") for (int k = 0; k < 2; ++k) { const size_t ub = ((tb_ + 32 * k) * 256 + h * 64) * 2; \
            eraw[S_][0][k] = *(const u32x4*)((const char*)BQ + ub + voffE); eraw[S_][1][k] = *(const u32x4*)((const char*)BK + ub + voffE); eraw[S_][2][k] = *(const u32x4*)((const char*)KHg + ub + voffE); } } while (0)
#define GL_STAGEE(c, S_) do { _Pragma("unroll") for (int k = 0; k < 2; ++k) { const int pi = te + 256 * k, t_ = pi >> 3, c8 = pi & 7; \
            LAS unsigned char* qd = L + GL_QT + ((c) % 3) * 8704 + t_ * 136 + c8 * 16; *(LAS u32x2*)qd = (u32x2){eraw[S_][0][k].x, eraw[S_][0][k].y}; *(LAS u32x2*)(qd + 8) = (u32x2){eraw[S_][0][k].z, eraw[S_][0][k].w}; \
            LAS unsigned char* kd = L + GL_KT + ((c) & 1) * 8704 + t_ * 136 + c8 * 16; *(LAS u32x2*)kd = (u32x2){eraw[S_][1][k].x, eraw[S_][1][k].y}; *(LAS u32x2*)(kd + 8) = (u32x2){eraw[S_][1][k].z, eraw[S_][1][k].w}; \
            *(LAS u32x4*)(L + GL_KH + ((c) % 3) * 8192 + ((t_ >> 3) * 2 + (c8 >> 2)) * 512 + (t_ & 7) * 64 + (c8 & 3) * 16) = eraw[S_][2][k]; } } while (0)
#define GL_LOADV(c, S_) do { const size_t tb_ = (size_t)b * SEQ + (size_t)(c) * 64; _Pragma("unroll") for (int k = 0; k < 4; ++k) { const size_t ub = ((tb_ + 16 * k) * 512 + h * 128) * 2; vraw[S_][k] = *(const u32x4*)((const char*)BV + ub + voffV); } \
            if (te < 64) draw[S_] = DEC[((size_t)b * 32 + (c)) * 256 + h * 64 + te]; } while (0)
#define GL_STAGEV(c, S_) do { _Pragma("unroll") for (int k = 0; k < 4; ++k) { const int pi = te + 256 * k, t_ = pi >> 4, c16 = pi & 15; \
            *(LAS u32x4*)(L + GL_V + ((c) & 1) * 16384 + ((t_ >> 3) * 4 + (c16 >> 2)) * 512 + (t_ & 7) * 64 + (c16 & 3) * 16) = vraw[S_][k]; } \
            if (te < 64) *(LAS float*)(L + GL_D + ((c) & 1) * 256 + 4 * te) = draw[S_]; } while (0)
#define GL_LOADR(c, S_) do { const size_t tb_ = (size_t)b * SEQ + (size_t)(c) * 64; _Pragma("unroll") for (int k = 0; k < 4; ++k) { const size_t ub = ((tb_ + 16 * k) * 512 + h * 128) * 2; rraw[S_][k] = *(const u32x4*)((const char*)BR + ub + voffV); } } while (0)
#define GL_STAGEW(c, S_) do { const size_t tb_ = (size_t)b * SEQ + (size_t)(c) * 64; _Pragma("unroll") for (int k = 0; k < 4; ++k) { const int pi = te + 256 * k, t_ = pi >> 4, c16 = pi & 15; \
            const LAS unsigned char* yp = L + GL_YL + ((c) & 1) * 16896 + t_ * 264 + c16 * 16; const u32x2 y0 = *(const LAS u32x2*)yp, y1 = *(const LAS u32x2*)(yp + 8); \
            f32x4 ya, yc, ra, rc; unpack8((u32x4){y0.x, y0.y, y1.x, y1.y}, ya, yc); unpack8(rraw[S_][k], ra, rc); *(u32x4*)((char*)YB + ((tb_ + 16 * k) * 512 + h * 128) * 2 + voffV) = pack8c(ya * ra, yc * rc); } } while (0)
        auto stageA = [&](int c) {
            const LAS unsigned char* Qb_ = L + GL_QT + (c % 3) * 8704; const LAS unsigned char* Kb_ = L + GL_KT + (c & 1) * 8704; LAS unsigned char* Ab_ = L + GL_AT + (c & 1) * 8192;
            bf16x8 qf[4], kf[4];
            auto ldf = [&](bf16x8 (&f)[4], const LAS unsigned char* B_, int tI) {
#pragma unroll
                for (int s = 0; s < 4; ++s) { const int off = (32 * tI + r) * 136 + (16 * s + 8 * hl) * 2; const u32x2 x0 = *(const LAS u32x2*)(B_ + off), x1 = *(const LAS u32x2*)(B_ + off + 8); f[s] = __builtin_bit_cast(bf16x8, (u32x4){x0.x, x0.y, x1.x, x1.y}); } };
            auto tileA = [&](int it, int jt) {
                f32x16 at_;
#pragma unroll
                for (int i = 0; i < 16; ++i) at_[i] = 0.f;
#pragma unroll
                for (int s = 0; s < 4; ++s) at_ = MFMA32(kf[s], qf[s], at_);
                const int i_ = 32 * it + r;
#pragma unroll
                for (int g = 0; g < 4; ++g) { float x0 = at_[4 * g], x1 = at_[4 * g + 1], x2 = at_[4 * g + 2], x3 = at_[4 * g + 3];
                    if (it == jt) { const int j0 = 8 * g + 4 * hl; x0 = (r >= j0) ? x0 : 0.f; x1 = (r >= j0 + 1) ? x1 : 0.f; x2 = (r >= j0 + 2) ? x2 : 0.f; x3 = (r >= j0 + 3) ? x3 : 0.f; }
                    *(LAS u32x2*)(Ab_ + i_ * 128 + (((4 * jt + g) ^ ((i_ >> 1) & 7)) << 4) + 8 * hl) = (u32x2){cvtpk(x0, x1), cvtpk(x2, x3)}; } };
            ldf(kf, Kb_, 0); ldf(qf, Qb_, 0); tileA(0, 0);
            ldf(qf, Qb_, 1); tileA(1, 0);
            ldf(kf, Kb_, 1); tileA(1, 1);
        };
        GL_LOADE(0, 0); GL_LOADE(1, 1); GL_LOADV(0, 0); GL_LOADV(1, 1);
        GL_STAGEE(0, 0); GL_LOADE(2, 0); GL_STAGEV(0, 0); GL_LOADV(2, 0);
        GL_BARRIER();
        GL_STAGEE(1, 1); GL_LOADE(3, 1); if (w == 4) stageA(0);
        GL_BARRIER();
#define GL_LSTEP(c, SE, SV) do { if ((c) + 2 < 32) GL_STAGEE((c) + 2, SE); if ((c) + 4 < 32) GL_LOADE((c) + 4, SE); \
            if ((c) + 1 < 32) GL_STAGEV((c) + 1, SV); if ((c) + 3 < 32) GL_LOADV((c) + 3, SV); \
            if ((c) >= 2) GL_STAGEW((c) - 2, SE); if ((c) < 32) GL_LOADR((c), SE); \
            if (w == 4 && (c) + 1 < 32) stageA((c) + 1); \
            GL_BARRIER(); } while (0)
        for (int c = 0; c < 34; c += 2) {
            GL_LSTEP(c, 0, 1);
            GL_LSTEP(c + 1, 1, 0);
        }
#undef GL_LSTEP
#undef GL_LOADE
#undef GL_STAGEE
#undef GL_LOADV
#undef GL_STAGEV
#undef GL_LOADR
#undef GL_STAGEW
    } else {
        const int n = w, r = lane & 31, hl = lane >> 5, g16 = lane >> 4, i16 = lane & 15;
        const int tro = (i16 >> 2) * 64 + (16 * (g16 & 1) + 4 * (i16 & 3)) * 2;
        f32x16 S[2], o[2]; u32x2 op[2][4];
#pragma unroll
        for (int i = 0; i < 16; ++i) { S[0][i] = 0.f; S[1][i] = 0.f; }
        LAS float* SSb = (LAS float*)(L + GL_SS); const LAS float* GN = (const LAS float*)(L + GL_GN) + 32 * n + 4 * hl;
        GL_BARRIER();
        GL_BARRIER();
        for (int c = 0; c < 34; ++c) {
            const unsigned long long tp0_ = (PROBE_PHASE == 41) ? __builtin_amdgcn_s_memrealtime() : 0ull;
            if (c >= 1 && c <= 32) {
                const int par = (c - 1) & 1;
#pragma unroll
                for (int tt = 0; tt < 2; ++tt) { const int t_ = 32 * tt + r; const float tot = SSb[par * 256 + t_] + SSb[par * 256 + 64 + t_] + SSb[par * 256 + 128 + t_] + SSb[par * 256 + 192 + t_];
                    const float rn = rsqrtf(tot * (1.0f / 128.0f) + EPS);
#pragma unroll
                    for (int g = 0; g < 4; ++g) { const u32x2 ov = op[tt][g]; const f32x4 gn = *(const LAS f32x4*)(GN + 8 * g);
                        *(LAS u32x2*)(L + GL_YL + par * 16896 + t_ * 264 + (32 * n + 8 * g + 4 * hl) * 2) = (u32x2){cvtpk(bflo(ov.x) * rn * gn[0], bfhi(ov.x) * rn * gn[1]), cvtpk(bflo(ov.y) * rn * gn[2], bfhi(ov.y) * rn * gn[3])}; } }
            }
            if (c < 32) {
                const LAS unsigned char* Qb_ = L + GL_QT + (c % 3) * 8704; const LAS unsigned char* Hb_ = L + GL_KH + (c % 3) * 8192; const LAS unsigned char* Ab_ = L + GL_AT + (c & 1) * 8192;
                const LAS unsigned char* Vb_ = L + GL_V + (c & 1) * 16384; const LAS unsigned char* Db_ = L + GL_D + (c & 1) * 256;
                u32x2 ql[2][2][2], qh_[2][2][2];
#pragma unroll
                for (int tt = 0; tt < 2; ++tt)
#pragma unroll
                    for (int dkt = 0; dkt < 2; ++dkt)
#pragma unroll
                        for (int s = 0; s < 2; ++s) { const LAS unsigned char* qp_ = Qb_ + (32 * tt + r) * 136 + (32 * dkt + 16 * s + 4 * hl) * 2; ql[tt][dkt][s] = *(const LAS u32x2*)qp_; qh_[tt][dkt][s] = *(const LAS u32x2*)(qp_ + 16); }
                s16x4 vlo[4], vhi[4];
#pragma unroll
                for (int s = 0; s < 4; ++s) { const LAS unsigned char* vp_ = Vb_ + ((2 * s + hl) * 4 + n) * 512 + tro; vlo[s] = tr_read(vp_); vhi[s] = tr_read(vp_ + 256); }
                bf16x8 af[2][4];
#pragma unroll
                for (int tt = 0; tt < 2; ++tt)
#pragma unroll
                    for (int s = 0; s < 4; ++s) { if (tt == 0 && s >= 2) { af[tt][s] = af[0][0]; continue; }
                        const int i_ = 32 * tt + r; af[tt][s] = *(const LAS bf16x8*)(Ab_ + i_ * 128 + (((2 * s + hl) ^ ((i_ >> 1) & 7)) << 4)); }
                bf16x8 sp[2][2];
#pragma unroll
                for (int dkt = 0; dkt < 2; ++dkt) { sp[dkt][0] = pack_step(S[dkt], 0); sp[dkt][1] = pack_step(S[dkt], 1); }
                asm volatile("" : "+v"(ql[0][0][0]), "+v"(ql[0][0][1]), "+v"(ql[0][1][0]), "+v"(ql[0][1][1]), "+v"(ql[1][0][0]), "+v"(ql[1][0][1]), "+v"(ql[1][1][0]), "+v"(ql[1][1][1]),
                                  "+v"(qh_[0][0][0]), "+v"(qh_[0][0][1]), "+v"(qh_[0][1][0]), "+v"(qh_[0][1][1]), "+v"(qh_[1][0][0]), "+v"(qh_[1][0][1]), "+v"(qh_[1][1][0]), "+v"(qh_[1][1][1]));
                asm volatile("" : "+v"(vlo[0]), "+v"(vlo[1]), "+v"(vlo[2]), "+v"(vlo[3]), "+v"(vhi[0]), "+v"(vhi[1]), "+v"(vhi[2]), "+v"(vhi[3]),
                                  "+v"(af[0][0]), "+v"(af[0][1]), "+v"(af[1][0]), "+v"(af[1][1]), "+v"(af[1][2]), "+v"(af[1][3]));
                f32x4 d4[2][4]; s16x4 klo[2][4], khi[2][4];
#pragma unroll
                for (int dkt = 0; dkt < 2; ++dkt) {
#pragma unroll
                    for (int g = 0; g < 4; ++g) d4[dkt][g] = *(const LAS f32x4*)(Db_ + (32 * dkt + 8 * g + 4 * hl) * 4);
#pragma unroll
                    for (int s = 0; s < 4; ++s) { const LAS unsigned char* kp_ = Hb_ + ((2 * s + hl) * 2 + dkt) * 512 + tro; klo[dkt][s] = tr_read(kp_); khi[dkt][s] = tr_read(kp_ + 256); } }
                bf16x8 vf[4];
#pragma unroll
                for (int s = 0; s < 4; ++s) vf[s] = __builtin_shufflevector(vlo[s], vhi[s], 0, 1, 2, 3, 4, 5, 6, 7);
#pragma unroll
                for (int tt = 0; tt < 2; ++tt) {
                    f32x16 acc;
#pragma unroll
                    for (int i = 0; i < 16; ++i) acc[i] = 0.f;
#pragma unroll
                    for (int dkt = 0; dkt < 2; ++dkt)
#pragma unroll
                        for (int s = 0; s < 2; ++s) { const u32x4 qv = (u32x4){ql[tt][dkt][s].x, ql[tt][dkt][s].y, qh_[tt][dkt][s].x, qh_[tt][dkt][s].y}; acc = MFMA32(sp[dkt][s], __builtin_bit_cast(bf16x8, qv), acc); }
#pragma unroll
                    for (int s = 0; s < 4; ++s) { if (tt == 0 && s >= 2) continue; acc = MFMA32(vf[s], af[tt][s], acc); }
                    o[tt] = acc;
                }
                asm volatile("" : "+v"(d4[0][0]), "+v"(d4[0][1]), "+v"(d4[0][2]), "+v"(d4[0][3]), "+v"(d4[1][0]), "+v"(d4[1][1]), "+v"(d4[1][2]), "+v"(d4[1][3]));
                asm volatile("" : "+v"(klo[0][0]), "+v"(klo[0][1]), "+v"(klo[0][2]), "+v"(klo[0][3]), "+v"(klo[1][0]), "+v"(klo[1][1]), "+v"(klo[1][2]), "+v"(klo[1][3]),
                                  "+v"(khi[0][0]), "+v"(khi[0][1]), "+v"(khi[0][2]), "+v"(khi[0][3]), "+v"(khi[1][0]), "+v"(khi[1][1]), "+v"(khi[1][2]), "+v"(khi[1][3]));
#pragma unroll
                for (int dkt = 0; dkt < 2; ++dkt) {
#pragma unroll
                    for (int g = 0; g < 4; ++g) { S[dkt][4 * g] *= d4[dkt][g][0]; S[dkt][4 * g + 1] *= d4[dkt][g][1]; S[dkt][4 * g + 2] *= d4[dkt][g][2]; S[dkt][4 * g + 3] *= d4[dkt][g][3]; }
#pragma unroll
                    for (int s = 0; s < 4; ++s) S[dkt] = MFMA32(__builtin_shufflevector(klo[dkt][s], khi[dkt][s], 0, 1, 2, 3, 4, 5, 6, 7), vf[s], S[dkt]);
                }
#pragma unroll
                for (int tt = 0; tt < 2; ++tt) { float q = 0.f;
#pragma unroll
                    for (int i = 0; i < 16; ++i) q += o[tt][i] * o[tt][i];
                    q += __shfl_xor(q, 32);
                    if (hl == 0) SSb[(c & 1) * 256 + n * 64 + 32 * tt + r] = q;
#pragma unroll
                    for (int g = 0; g < 4; ++g) op[tt][g] = (u32x2){cvtpk(o[tt][4 * g], o[tt][4 * g + 1]), cvtpk(o[tt][4 * g + 2], o[tt][4 * g + 3])}; }
            }
            GL_AMP(41, tp0_);
            GL_BARRIER();
        }
    }
    __syncthreads();
}
__device__ __forceinline__ void phase_gla(const Frame& F, ArgsP a, int l) {
    const int bx = blockIdx.x;
    if ((bx & 3) == 0) for (int u = bx >> 2; u < 64; u += (F.G + 3) >> 2) gla_unit(F, a, l, u);
}

constexpr int RT_W = 0, RT_LG = 40 * 2048, RT_RS = RT_LG + 8 * 16 * 48 * 4;
__device__ __forceinline__ void phase_router(const Frame& F, ArgsP a, int l) {
    volatile LAS unsigned* lcnt = (volatile LAS unsigned*)(F.lds + LC_LCNT); volatile LAS unsigned* lbase = (volatile LAS unsigned*)(F.lds + LC_LBASE);
    LAS unsigned* rec = (LAS unsigned*)(F.lds + LC_REC); LAS float* recw = (LAS float*)(F.lds + LC_RECW); LAS float* recrs = (LAS float*)(F.lds + LC_RECRS);
    unsigned* gcnt = F.ctl + CW_GCNT + l * 64; unsigned* TREC = (unsigned*)(F.ws + WS_TREC); int* TOKL = (int*)(F.ws + WS_TOKL); float* TWL = (float*)(F.ws + WS_TWL); float* RSLL = (float*)(F.ws + WS_RSLL);
    const bf16* WRh = (const bf16*)(F.ws + WS_WR);
    const float* bg = a->in[14] + l * 4; const float* br = a->in[16] + l * 32; const int lane = F.lane, row = lane & 15, kq = lane >> 4;
    LAS float* LG = (LAS float*)(F.lds + RT_LG) + F.wave * 16 * 48; LAS float* RSL = (LAS float*)(F.lds + RT_RS) + F.wave * 16;
    __syncthreads();
    for (int i = F.tid; i < 40 * 128; i += 512) { const int n = i >> 7, ch = i & 127; *(LAS u32x4*)(F.lds + RT_W + n * 2048 + ((ch ^ (n & 15)) << 4)) = *(const u32x4*)(WRh + (size_t)n * D + ch * 8); }
    int wro[3], wsw[3];
#pragma unroll
    for (int nt = 0; nt < 3; ++nt) { int n = 16 * nt + row; n = n < 40 ? n : 36; wro[nt] = RT_W + n * 2048; wsw[nt] = n & 15; }
    for (int blk = F.vcu; blk < T / 128; blk += F.G) {
        __syncthreads();
        if (F.tid < 32) lcnt[F.tid] = 0u;
        __syncthreads();
        const int t0 = blk * 128 + F.wave * 16;
        const bf16* xr = (const bf16*)(F.ws + WS_XB) + (size_t)(t0 + row) * D + 8 * kq;
        f32x4 acc[3]; float ss = 0.f;
#pragma unroll
        for (int nt = 0; nt < 3; ++nt) acc[nt] = (f32x4){0.f, 0.f, 0.f, 0.f};
#pragma unroll 8
        for (int ks = 0; ks < 32; ++ks) {
            const u32x4 hp = *(const u32x4*)(xr + 32 * ks); f32x4 x0, x1; unpack8(hp, x0, x1);
            ss += (x0[0] * x0[0] + x0[1] * x0[1]) + (x0[2] * x0[2] + x0[3] * x0[3]) + (x1[0] * x1[0] + x1[1] * x1[1]) + (x1[2] * x1[2] + x1[3] * x1[3]);
            const bf16x8 ah = __builtin_bit_cast(bf16x8, hp);
#pragma unroll
            for (int nt = 0; nt < 3; ++nt) { const bf16x8 bh = *(const LAS bf16x8*)(F.lds + wro[nt] + (((4 * ks + kq) ^ wsw[nt]) << 4)); acc[nt] = __builtin_amdgcn_mfma_f32_16x16x32_bf16(ah, bh, acc[nt], 0, 0, 0); }
        }
        ss += __shfl_xor(ss, 16); ss += __shfl_xor(ss, 32);
        if (kq == 0) RSL[row] = rsqrtf(ss * (1.0f / D) + EPS);
#pragma unroll
        for (int nt = 0; nt < 3; ++nt)
#pragma unroll
            for (int e = 0; e < 4; ++e) LG[(4 * kq + e) * 48 + 16 * nt + row] = acc[nt][e];
        LDS_WAIT(); asm volatile("" ::: "memory");
        if (lane < 16) {
            const int tl = F.wave * 16 + lane, t = t0 + lane; const float rs = RSL[lane]; const LAS float* lg = LG + lane * 48;
            float gl[4];
#pragma unroll
            for (int g = 0; g < 4; ++g) gl[g] = lg[g] * rs + bg[g];
            int gi = 0; float gm = gl[0];
#pragma unroll
            for (int g = 1; g < 4; ++g) if (gl[g] > gm) { gm = gl[g]; gi = g; }
            float Z = 0.f;
#pragma unroll
            for (int g = 0; g < 4; ++g) Z += __expf(gl[g] - gm);
            const float gtop = 1.0f / Z;
            float el[8];
#pragma unroll
            for (int i = 0; i < 8; ++i) el[i] = lg[4 + 8 * gi + i] * rs + br[8 * gi + i];
            int i1 = 0; float m1 = el[0];
#pragma unroll
            for (int i = 1; i < 8; ++i) if (el[i] > m1) { m1 = el[i]; i1 = i; }
            int i2 = -1; float m2 = -3.0e38f;
#pragma unroll
            for (int i = 0; i < 8; ++i) if (i != i1 && el[i] > m2) { m2 = el[i]; i2 = i; }
            const float w1 = 1.0f / (1.0f + __expf(m2 - m1)), w2 = 1.0f - w1;
            const int e1 = gi * 8 + i1, e2 = gi * 8 + i2;
            const unsigned p1 = __hip_atomic_fetch_add((LAS unsigned*)(F.lds + LC_LCNT) + e1, 1u, __ATOMIC_RELAXED, __HIP_MEMORY_SCOPE_WORKGROUP), p2 = __hip_atomic_fetch_add((LAS unsigned*)(F.lds + LC_LCNT) + e2, 1u, __ATOMIC_RELAXED, __HIP_MEMORY_SCOPE_WORKGROUP);
            rec[2 * tl] = ((unsigned)e1 << 16) | p1; rec[2 * tl + 1] = ((unsigned)e2 << 16) | p2; recw[2 * tl] = w1 * gtop; recw[2 * tl + 1] = w2 * gtop;
            recrs[tl] = rs;
        }
        __syncthreads();
        if (F.tid < 32) lbase[F.tid] = __hip_atomic_fetch_add(gcnt + F.tid, lcnt[F.tid], RLX_AGENT);
        __syncthreads();
        if (F.tid < 256) { const unsigned rc = rec[F.tid], e = rc >> 16, pos = (rc & 0xffffu) + lbase[e]; TREC[(size_t)blk * 256 + F.tid] = (e << 16) | pos;
            const size_t li = (size_t)e * 32768 + pos; TOKL[li] = blk * 128 + (F.tid >> 1); TWL[li] = recw[F.tid]; RSLL[li] = recrs[F.tid >> 1]; }
    }
}
__device__ __forceinline__ void build_tiles(const Frame& F, int l) {
    volatile LAS int* tbase = (volatile LAS int*)(F.lds + LC_TBASE); volatile LAS int* tile_e = (volatile LAS int*)(F.lds + LC_TILEE);
    __syncthreads();
    if (F.tid < 64) {
        const int e = F.tid & 31; const int n = (int)__hip_atomic_load(F.ctl + CW_GCNT + l * 64 + e, RLX_AGENT); const int nt = (n + 255) >> 8; int incl = nt;
#pragma unroll
        for (int o = 1; o < 32; o <<= 1) { const int t = __shfl_up(incl, o, 32); if ((F.tid & 31) >= o) incl += t; }
        if (F.tid < 32) { tbase[e] = incl - nt; ((volatile LAS int*)(F.lds + LC_CNT))[e] = n; if (e == 31) tbase[NE] = incl; }
    }
    __syncthreads();
    if (F.tid < NE) { const int t0 = tbase[F.tid], t1 = tbase[F.tid + 1]; for (int t = t0; t < t1 && t < MAXTILES; ++t) tile_e[t] = F.tid; }
    __syncthreads();
}
constexpr int GT_OFF = 131072;
__device__ __forceinline__ void build_gather(const Frame& F, int l, int NPN) {
    const volatile LAS int* tbase = (const volatile LAS int*)(F.lds + LC_TBASE); const volatile LAS int* tile_e = (const volatile LAS int*)(F.lds + LC_TILEE);
    LAS unsigned* tab = (LAS unsigned*)(F.lds + GT_OFF); const int* TOKL = (const int*)(F.ws + WS_TOKL);
    const int ntiles = tbase[NE];
    for (int i = 0; i < 4; ++i) { const long L = (long)i * F.G + blockIdx.x; if (L >= (long)ntiles * NPN) break;
        const int tile = (int)(L / NPN), e = tile_e[tile], k = tile - tbase[e]; const int ne = ((const volatile LAS int*)(F.lds + LC_CNT))[e];
        if (F.tid < 256) { const int pos = 256 * k + F.tid; tab[i * 256 + F.tid] = pos < ne ? (unsigned)TOKL[(size_t)e * 32768 + pos] * (unsigned)(D * 2) : 0u; } }
    __syncthreads();
}
__device__ __forceinline__ void phase_final(const Frame& F, float* out, bool make_xb, int lprev) {
    build_tiles(F, lprev);
    const volatile LAS int* tbase = (const volatile LAS int*)(F.lds + LC_TBASE);
    const unsigned* TREC = (const unsigned*)(F.ws + WS_TREC); const bf16* Y = (const bf16*)(F.ws + WS_Y); bf16* XB = (bf16*)(F.ws + WS_XB); float* RS = (float*)(F.ws + WS_RS1);
    const int gw = F.vcu * 8 + F.wave, NGW = F.G * 8;
    for (int t = gw; t < T; t += NGW) {
        const unsigned r0 = TREC[2 * t], r1 = TREC[2 * t + 1];
        const int s0 = 256 * tbase[r0 >> 16] + (int)(r0 & 0xffffu), s1 = 256 * tbase[r1 >> 16] + (int)(r1 & 0xffffu);
        u32x4* xr = (u32x4*)(XB + (size_t)t * D) + F.lane; const u32x4* y0 = (const u32x4*)(Y + (size_t)s0 * D) + F.lane; const u32x4* y1 = (const u32x4*)(Y + (size_t)s1 * D) + F.lane;
        f32x4 v[2][2]; float s = 0.f;
#pragma unroll
        for (int j = 0; j < 2; ++j) { f32x4 xa, xc, a0, a1, c0, c1; unpack8(xr[64 * j], xa, xc); unpack8(y0[64 * j], a0, a1); unpack8(y1[64 * j], c0, c1);
            v[j][0] = xa + a0 + c0; v[j][1] = xc + a1 + c1;
#pragma unroll
            for (int e = 0; e < 4; ++e) s += v[j][0][e] * v[j][0][e] + v[j][1][e] * v[j][1][e]; }
        if (make_xb) {
            s = wave_sum(s);
#pragma unroll
            for (int j = 0; j < 2; ++j) xr[64 * j] = pack8c(v[j][0], v[j][1]);
            if (F.lane == 0) RS[t] = rsqrtf(s * (1.0f / D) + EPS);
        } else {
            f32x4* o = (f32x4*)(out + (size_t)t * D) + 2 * F.lane;
#pragma unroll
            for (int j = 0; j < 2; ++j) { o[128 * j] = v[j][0]; o[128 * j + 1] = v[j][1]; }
        }
    }
}

constexpr int PH_PER_LAYER = 16, NPH = DEPTH * PH_PER_LAYER;
#ifndef PH_MASK
#define PH_MASK 0x1ffff
#endif
#ifndef DUP_MASK
#define DUP_MASK 0
#endif
#define PB(k) const unsigned long long pb_t0_ = (PROBE_PHASE == (k)) ? __builtin_amdgcn_s_memrealtime() : 0ull
#define PE(k) do { if (PROBE_PHASE == (k)) { const unsigned long long t1_ = __builtin_amdgcn_s_memrealtime(); const unsigned long long dt_ = t1_ - pb_t0_; while (__builtin_amdgcn_s_memrealtime() - t1_ < dt_) __builtin_amdgcn_s_sleep(8); } } while (0)
#define REP(k) for (int rep_ = 0; rep_ < 1 + ((DUP_MASK >> (k)) & 1); ++rep_)
__global__ void __launch_bounds__(512, 2) fwd_kernel(Args args_unused) {
    extern __shared__ __attribute__((aligned(16))) unsigned char lds_raw[];
    const int wave0 = __builtin_amdgcn_readfirstlane((int)threadIdx.x >> 6);
    {
        LAS unsigned char* lds0 = (LAS unsigned char*)lds_raw;
        for (int u = threadIdx.x; u < (LDS_BYTES - LC_OFF) / 4; u += 512) ((LAS unsigned*)(lds0 + LC_OFF))[u] = 0u;
        __syncthreads();
    }
#if MK_ONE_LAUNCH
    XcdBarrier bar; { ArgsP ap = get_args(); bar = xcd_barrier_post((unsigned*)(ap->ws + WS_CTL) + CW_BAR, (volatile LAS unsigned*)((LAS unsigned char*)lds_raw + LC_MISC) + 8); }
#define GRID_BAR() do { PB(14); xcd_barrier(bar); PE(14); } while (0)
#else
#define GRID_BAR() do { } while (0)
#endif
    int lo, hi; { ArgsP ap = get_args(); lo = ap->ph_lo; hi = ap->ph_hi; }
#define IN(k) (((PH_MASK >> ((k) % PH_PER_LAYER)) & 1) && lo <= (k) && (k) < hi)
#define SEAM(k) GRID_BAR()
    for (int l = 0; l < DEPTH; ++l) {
        const int P = l * PH_PER_LAYER;
        if (IN(P + 0)) REP(0) { PB(0); ArgsP ap = get_args(); const Frame F = make_frame(ap, wave0); if (l == 0) phase_x_to_xb(F, ap->in[0]); else phase_final(F, ap->out, true, l - 1); phase_weights(F, ap, l); PE(0); }
        SEAM(P + 0);
        if (IN(P + 1)) REP(1) { PB(1);
            ArgsP ap = get_args(); const Frame F = make_frame(ap, wave0);
            pg8::DenseOrder S; S.init(T, NIN, D, F.G, (int)blockIdx.x, F.ws + WS_XB, F.ws + WS_WIN);
            EpiIn E{(const float*)(F.ws + WS_RS1), F.ws, (bf16*)(F.ws + WS_Q), (bf16*)(F.ws + WS_K), (bf16*)(F.ws + WS_BQ), (bf16*)(F.ws + WS_BK), (bf16*)(F.ws + WS_KH),
                    (bf16*)(F.ws + WS_R), (bf16*)(F.ws + WS_GB), (float*)(F.ws + WS_DEC), ap->in[3] + l * 512, ap->in[4] + l * 512, ap->in[7] + l * 256};
            pg8::gemm_phase<EpiIn, pg8::DenseOrder, AL_G1, PG8_SP2>(F.lds, D, S, E, F.tid); PE(1);
        }
        SEAM(P + 1);
        if (IN(P + 2)) { PB(2); REP(11) { PB(11); ArgsP ap = get_args(); const Frame F = make_frame(ap, wave0); phase_gla(F, ap, l); PE(11); } if (PH_MASK & 0x10000) REP(12) { PB(12); ArgsP ap = get_args(); const Frame F = make_frame(ap, wave0); phase_attn(F, ap, l); PE(12); } PE(2); }
        SEAM(P + 2);
        if (IN(P + 3)) REP(3) { PB(3);
            ArgsP ap = get_args(); const Frame F = make_frame(ap, wave0);
            pg8::ChainOrder S; S.d0.init(T, D, 512, F.G, (int)blockIdx.x, F.yab, F.ws + WS_PA); S.d1.init(T, D, 512, F.G, (int)blockIdx.x, F.yab + YB_OFF, F.ws + WS_PB);
            EpiMerge E{(const bf16*)(F.ws + WS_R), (const bf16*)(F.ws + WS_GB), (bf16*)(F.ws + WS_MRG)};
            pg8::gemm_phase<EpiMerge, pg8::ChainOrder, AL_MG, PG8_SP2>(F.lds, 512, S, E, F.tid); PE(3);
        }
        SEAM(P + 3);
        if (IN(P + 5)) { PB(5);
            ArgsP ap = get_args(); const Frame F = make_frame(ap, wave0);
            pg8::DenseOrder S; S.init(T, D, D, F.G, (int)blockIdx.x, F.ws + WS_MRG, F.ws + WS_WOUT);
            EpiOut E{(bf16*)(F.ws + WS_XB)};
            pg8::gemm_phase<EpiOut, pg8::DenseOrder, AL_OUT, PG8_SP2>(F.lds, D, S, E, F.tid); PE(5);
        }
        SEAM(P + 5);
        if (IN(P + 6)) { PB(6); ArgsP ap = get_args(); const Frame F = make_frame(ap, wave0); phase_router(F, ap, l); PE(6); }
        SEAM(P + 6);
        if (IN(P + 8)) REP(8) { PB(8);
            ArgsP ap = get_args(); const Frame F = make_frame(ap, wave0);
            build_tiles(F, l); build_gather(F, l, 2);
            pg8::ExpertOrderT<true> S; S.tile_e = (const LAS int*)(F.lds + LC_TILEE); S.tbase = (const LAS int*)(F.lds + LC_TBASE); S.tab = (const LAS unsigned*)(F.lds + GT_OFF);
            S.ntiles = __builtin_amdgcn_readfirstlane(*(const LAS int*)(F.lds + LC_TBASE + 4 * NE)); S.NPN = 2; S.G = F.G; S.c = (int)blockIdx.x;
            S.A = (const char*)(F.ws + WS_XB); S.B = (const char*)(F.ws + WS_WGU); S.a_tile = 0; S.b_exp = (size_t)512 * D * 2; S.b_pn = (size_t)256 * D * 2;
            EpiGU E{(const float*)(F.ws + WS_RSLL), (bf16*)(F.ws + WS_H)};
            pg8::gemm_phase<EpiGU, pg8::ExpertOrderT<true>, AL_GU, PG8_SP2>(F.lds, D, S, E, F.tid); PE(8);
        }
        SEAM(P + 8);
        if (IN(P + 9)) REP(9) { PB(9);
            ArgsP ap = get_args(); const Frame F = make_frame(ap, wave0);
            build_tiles(F, l);
            pg8::ExpertOrderT<false> S; S.tile_e = (const LAS int*)(F.lds + LC_TILEE); S.tbase = (const LAS int*)(F.lds + LC_TBASE); S.tab = nullptr;
            S.ntiles = __builtin_amdgcn_readfirstlane(*(const LAS int*)(F.lds + LC_TBASE + 4 * NE)); S.NPN = 4; S.G = F.G; S.c = (int)blockIdx.x;
            S.A = (const char*)(F.ws + WS_H); S.B = (const char*)(F.ws + WS_WD); S.a_tile = (size_t)256 * DE * 2; S.b_exp = (size_t)D * DE * 2; S.b_pn = (size_t)256 * DE * 2;
            EpiDown E{(const float*)(F.ws + WS_TWL), (bf16*)(F.ws + WS_Y)};
            pg8::gemm_phase<EpiDown, pg8::ExpertOrderT<false>, AL_DN, PG8_SP2>(F.lds, DE, S, E, F.tid); PE(9);
        }
        GRID_BAR();
    }
    { PB(15); ArgsP ap = get_args(); const Frame F = make_frame(ap, wave0); phase_final(F, ap->out, false, DEPTH - 1); PE(15); }
#undef IN
#undef SEAM
}

extern "C" void kernel_launch(void* const* d_in, const int* in_sizes, int n_in, void* d_out, int out_size, void* d_ws, size_t ws_size, hipStream_t stream) {
    static int grid = 0;
    if (grid == 0) {
        if (n_in != 20 || in_sizes[0] != T * D || out_size != T * D || ws_size < WS_END) { fprintf(stderr, "kernel_launch: unexpected shapes (n_in %d, in0 %d, out %d, ws %zu); nothing launched\n", n_in, n_in > 0 ? in_sizes[0] : -1, out_size, ws_size); grid = -1; return; }
        int dev = 0, cus = 0;
        if (hipGetDevice(&dev) != hipSuccess || hipDeviceGetAttribute(&cus, hipDeviceAttributeMultiprocessorCount, dev) != hipSuccess) { grid = -1; return; }
        if (hipFuncSetAttribute((const void*)fwd_kernel, hipFuncAttributeMaxDynamicSharedMemorySize, LDS_BYTES) != hipSuccess) { fprintf(stderr, "kernel_launch: hipFuncSetAttribute failed\n"); grid = -1; return; }
        grid = cus;
    }
    if (grid < 0) return;
    (void)hipMemsetAsync((char*)d_ws + WS_CTL, 0, CTL_ZERO_BYTES, stream);
    Args a{};
    for (int i = 0; i < 20; ++i) a.in[i] = (const float*)d_in[i];
    a.out = (float*)d_out; a.ws = (unsigned char*)d_ws;
#if MK_ONE_LAUNCH
    a.ph_lo = 0; a.ph_hi = NPH;
    hipLaunchKernelGGL(fwd_kernel, dim3(grid), dim3(512), LDS_BYTES, stream, a);
#else
    for (int l = 0; l < DEPTH; ++l)
        for (int p = 0; p <= 10; ++p) { a.ph_lo = l * PH_PER_LAYER + p; a.ph_hi = a.ph_lo + 1; hipLaunchKernelGGL(fwd_kernel, dim3(grid), dim3(512), LDS_BYTES, stream, a); }
#endif
}
```
